# Optimizing an MI355X kernel written in HIP

```python
import jax, jax.numpy as jnp
from jax import lax
import numpy as np

D_MODEL = 1024
BATCH = 4
SEQ = 4096
DEPTH = 4

CHUNK = 64
N_MEM = 256
N_BRANCH = 4
MIX_W = D_MODEL // 2
CONV_WIDTH = 31
GLA_H = 4
GLA_DK = MIX_W // (2 * GLA_H)
GLA_DV = MIX_W // GLA_H
GLA_LOWRANK = 16
GLA_TAU = 16.0
SB_DH = 64
SB_H = MIX_W // SB_DH
SB_BLOCK = 128
LRU_BLOCKS = 8
LRU_BW = MIX_W // LRU_BLOCKS
LRU_CONV = 4
LRU_C = 8.0
MEM_H = 4
MEM_DH = D_MODEL // MEM_H
N_EXPERTS = 32
TOP_K = 4
MOE_FF = D_MODEL
SWIGLU_LIMIT = 7.0
SWIGLU_ALPHA = 1.702
MOE_BLOCK = 128
LN_EPS = 1e-5
DEEPNORM_ALPHA = (2 * DEPTH) ** 0.25
DEEPNORM_BETA = (8 * DEPTH) ** -0.25
IN_SIZES = (MIX_W, MIX_W,
            GLA_H * GLA_DK, GLA_H * GLA_DK, GLA_H * GLA_DV, GLA_H * GLA_DV, GLA_LOWRANK,
            SB_H * SB_DH, SB_H * SB_DH, SB_H * SB_DH,
            MIX_W, MIX_W,
            N_BRANCH * D_MODEL)
IN_COLS = sum(IN_SIZES)
SPLIT_POINTS = tuple(int(v) for v in np.cumsum(IN_SIZES)[:-1])

kernel_name = "hybrid_streaming_encoder_deepnorm_moe"


def layer_norm(x, g, b):
    xf = x.astype(jnp.float32)
    mu = jnp.mean(xf, axis=-1, keepdims=True)
    var = jnp.mean(jnp.square(xf - mu), axis=-1, keepdims=True)
    return ((xf - mu) * lax.rsqrt(var + LN_EPS) * g + b).astype(x.dtype)


def causal_depthwise_conv(u, w, b):
    width = w.shape[0]
    y = lax.conv_general_dilated(u, w[:, None, :], window_strides=(1,), padding=[(width - 1, 0)],
                                 dimension_numbers=("NWC", "WIO", "NWC"),
                                 feature_group_count=u.shape[-1])
    return y + b


def gla_chunked(q, k, v, log_a):
    B, S, H, DK = q.shape
    DV = v.shape[-1]
    nc = S // CHUNK
    f32 = jnp.float32
    qf = q.astype(f32).reshape(B, nc, CHUNK, H, DK)
    kf = k.astype(f32).reshape(B, nc, CHUNK, H, DK)
    vf = v.astype(f32).reshape(B, nc, CHUNK, H, DV)
    b = jnp.cumsum(log_a.astype(f32).reshape(B, nc, CHUNK, H, DK), axis=2)
    b_last = b[:, :, -1:]
    q_dec = qf * jnp.exp(b)
    k_inv = kf * jnp.exp(-b)
    k_end = kf * jnp.exp(b_last - b)
    causal = jnp.tril(jnp.ones((CHUNK, CHUNK), bool))
    s_intra = jnp.where(causal, jnp.einsum("bcthk,bcshk->bchts", q_dec, k_inv), 0.0)
    o_intra = jnp.einsum("bchts,bcshv->bcthv", s_intra, vf)
    kv = jnp.einsum("bcshk,bcshv->bchkv", k_end, vf)
    decay = jnp.exp(b_last[:, :, 0])

    def step(state, inp):
        dec_c, kv_c = inp
        return dec_c[..., None] * state + kv_c, state

    init = jnp.zeros((B, H, DK, DV), f32)
    _, s_prev = lax.scan(step, init, (jnp.moveaxis(decay, 1, 0), jnp.moveaxis(kv, 1, 0)))
    s_prev = jnp.moveaxis(s_prev, 0, 1)
    o_inter = jnp.einsum("bcthk,bchkv->bcthv", q_dec, s_prev)
    return (o_intra + o_inter).reshape(B, S, H, DV)


def stick_breaking(q, k, v):
    B, S, H, DH = q.shape
    scale = DH ** -0.5
    outs = []
    for blk in range(S // SB_BLOCK):
        q0 = blk * SB_BLOCK
        end = q0 + SB_BLOCK
        z = jnp.einsum("bthd,bshd->bhts", q[:, q0:end], k[:, :end]).astype(jnp.float32) * scale
        t_pos = q0 + jnp.arange(SB_BLOCK)
        s_pos = jnp.arange(end)
        before = s_pos[None, :] < t_pos[:, None]
        log_keep = jnp.where(before, jax.nn.log_sigmoid(-z), 0.0)
        log_tail = lax.cumsum(log_keep, axis=3, reverse=True) - log_keep
        w = jnp.where(before, jnp.exp(jax.nn.log_sigmoid(z) + log_tail), 0.0)
        outs.append(jnp.einsum("bhts,bshd->bthd", w.astype(v.dtype), v[:, :end]))
    return jnp.concatenate(outs, axis=1)


def rg_lru(xc, wa, ba, wx, bx, lam):
    B, S, C = xc.shape
    xb = xc.reshape(B, S, LRU_BLOCKS, LRU_BW)
    r = jax.nn.sigmoid(jnp.einsum("bsnc,ncd->bsnd", xb, wa).reshape(B, S, C) + ba)
    i = jax.nn.sigmoid(jnp.einsum("bsnc,ncd->bsnd", xb, wx).reshape(B, S, C) + bx)
    log_a = LRU_C * r.astype(jnp.float32) * jax.nn.log_sigmoid(lam.astype(jnp.float32))
    a = jnp.exp(log_a)
    u = jnp.sqrt(-jnp.expm1(2.0 * log_a)) * (i * xc).astype(jnp.float32)

    def combine(c1, c2):
        a1, b1 = c1
        a2, b2 = c2
        return a1 * a2, a2 * b1 + b2

    _, h = lax.associative_scan(combine, (a, u), axis=1)
    return h.astype(xc.dtype)


def hybrid_mixer(h, w_in, b_in, conv_a_w, conv_a_b, ln_a_g, ln_a_b, gla_wa2, gla_ba, gla_norm_g,
                 conv_d_w, conv_d_b, lru_wa, lru_ba, lru_wx, lru_bx, lru_lambda, w_branch, w_out, b_out):
    B, S, D = h.shape
    z = h @ w_in + b_in
    (a_val, a_gate, b_q, b_k, b_v, b_r, b_lr, c_q, c_k, c_v, d_x, d_g, g_merge) = jnp.split(
        z, SPLIT_POINTS, axis=-1)
    u = a_val * jax.nn.sigmoid(a_gate)
    y_a = jax.nn.silu(layer_norm(causal_depthwise_conv(u, conv_a_w, conv_a_b), ln_a_g, ln_a_b))
    log_a = jax.nn.log_sigmoid((b_lr @ gla_wa2 + gla_ba).astype(jnp.float32)) / GLA_TAU
    o_b = gla_chunked(b_q.reshape(B, S, GLA_H, GLA_DK) * (GLA_DK ** -0.5),
                      b_k.reshape(B, S, GLA_H, GLA_DK),
                      b_v.reshape(B, S, GLA_H, GLA_DV),
                      log_a.reshape(B, S, GLA_H, GLA_DK))
    o_b = o_b * lax.rsqrt(jnp.mean(jnp.square(o_b), axis=-1, keepdims=True) + LN_EPS) * gla_norm_g
    y_b = o_b.reshape(B, S, MIX_W).astype(h.dtype) * jax.nn.silu(b_r)
    y_c = stick_breaking(c_q.reshape(B, S, SB_H, SB_DH), c_k.reshape(B, S, SB_H, SB_DH),
                         c_v.reshape(B, S, SB_H, SB_DH)).reshape(B, S, MIX_W)
    xc = causal_depthwise_conv(d_x, conv_d_w, conv_d_b)
    y_d = rg_lru(xc, lru_wa, lru_ba, lru_wx, lru_bx, lru_lambda) * jax.nn.gelu(d_g)
    ys = jnp.stack([y_a, y_b, y_c, y_d], axis=2)
    proj = jnp.einsum("bsnc,ncd->bsnd", ys, w_branch)
    gates = jax.nn.sigmoid(g_merge.reshape(B, S, N_BRANCH, D))
    merged = jnp.sum(gates * proj, axis=2)
    return merged @ w_out + b_out


def memory_cross_attention(h, mem, wq, wk, wv, wo):
    B, S, D = h.shape
    M = mem.shape[1]
    q = (h @ wq).reshape(B, S, MEM_H, MEM_DH)
    k = (mem @ wk).reshape(B, M, MEM_H, MEM_DH)
    v = (mem @ wv).reshape(B, M, MEM_H, MEM_DH)
    s = jnp.einsum("bshd,bmhd->bhsm", q, k).astype(jnp.float32) * (MEM_DH ** -0.5)
    p = jax.nn.softmax(s, axis=-1).astype(v.dtype)
    o = jnp.einsum("bhsm,bmhd->bshd", p, v).reshape(B, S, D)
    return o @ wo


def moe_ffn(x2, router_w, router_b, w1, b1, w2, b2):
    T, D = x2.shape
    logits = (x2 @ router_w).astype(jnp.float32) + router_b
    top_val, top_idx = lax.top_k(logits, TOP_K)
    gate = jax.nn.softmax(top_val, axis=-1)
    n_assign = T * TOP_K
    e_flat = top_idx.reshape(n_assign)
    tok_flat = jnp.arange(n_assign, dtype=jnp.int32) // TOP_K
    order = jnp.argsort(e_flat)
    e_sorted = e_flat[order]
    tok_sorted = tok_flat[order]
    g_sorted = gate.reshape(n_assign)[order]
    counts = jnp.bincount(e_flat, length=N_EXPERTS)
    start = jnp.cumsum(counts) - counts
    padded = ((counts + MOE_BLOCK - 1) // MOE_BLOCK) * MOE_BLOCK
    pend = jnp.cumsum(padded)
    pstart = pend - padded
    dest = pstart[e_sorted] + (jnp.arange(n_assign, dtype=jnp.int32) - start[e_sorted])
    n_blocks = (n_assign + MOE_BLOCK - 1) // MOE_BLOCK + N_EXPERTS
    n_slots = n_blocks * MOE_BLOCK
    slot_tok = jnp.full((n_slots,), T, jnp.int32).at[dest].set(tok_sorted)
    slot_gate = jnp.zeros((n_slots,), x2.dtype).at[dest].set(g_sorted.astype(x2.dtype))
    block_e = jnp.minimum(jnp.searchsorted(pend, jnp.arange(n_blocks, dtype=jnp.int32) * MOE_BLOCK,
                                           side="right"), N_EXPERTS - 1)
    x_pad = jnp.concatenate([x2, jnp.zeros((1, D), x2.dtype)], axis=0)
    xs = x_pad[slot_tok].reshape(n_blocks, MOE_BLOCK, D)

    def expert_block(args):
        xb, e = args
        hcat = xb @ w1[e] + b1[e]
        g = jnp.minimum(hcat[:, :MOE_FF], SWIGLU_LIMIT)
        lin = jnp.clip(hcat[:, MOE_FF:], -SWIGLU_LIMIT, SWIGLU_LIMIT)
        act = g * jax.nn.sigmoid(SWIGLU_ALPHA * g) * (lin + 1.0)
        return act @ w2[e] + b2[e]

    ys = lax.map(expert_block, (xs, block_e)).reshape(n_slots, D)
    out = jnp.zeros((T + 1, D), x2.dtype).at[slot_tok].add(ys * slot_gate[:, None])
    return out[:T]


def setup_inputs(seed: int = 0) -> dict:
    key = jax.random.key(seed)
    ks = iter(jax.random.split(key, 64))
    f32 = jnp.float32
    L, D = DEPTH, D_MODEL
    beta = DEEPNORM_BETA

    def nrm(shape, scale):
        return scale * jax.random.normal(next(ks), shape, f32)

    def gain(shape):
        return 1.0 + nrm(shape, 0.02)

    a0 = jax.random.uniform(next(ks), (L, MIX_W), f32, minval=0.9, maxval=0.999)
    p = a0 ** (1.0 / LRU_C)
    lru_lambda = jnp.log(p) - jnp.log1p(-p)
    return {
        "x": nrm((BATCH, SEQ, D), 1.0),
        "mem": nrm((BATCH, N_MEM, D), 1.0),
        "ln0_g": gain((D,)),
        "ln0_b": nrm((D,), 0.02),
        "w_in": nrm((L, D, IN_COLS), D ** -0.5),
        "b_in": nrm((L, IN_COLS), 0.02),
        "conv_a_w": nrm((L, CONV_WIDTH, MIX_W), CONV_WIDTH ** -0.5),
        "conv_a_b": nrm((L, MIX_W), 0.02),
        "ln_a_g": gain((L, MIX_W)),
        "ln_a_b": nrm((L, MIX_W), 0.02),
        "gla_wa2": nrm((L, GLA_LOWRANK, GLA_H * GLA_DK), GLA_LOWRANK ** -0.5),
        "gla_ba": nrm((L, GLA_H * GLA_DK), 0.02),
        "gla_norm_g": gain((L, GLA_DV)),
        "conv_d_w": nrm((L, LRU_CONV, MIX_W), LRU_CONV ** -0.5),
        "conv_d_b": nrm((L, MIX_W), 0.02),
        "lru_wa": nrm((L, LRU_BLOCKS, LRU_BW, LRU_BW), LRU_BW ** -0.5),
        "lru_ba": nrm((L, MIX_W), 0.02),
        "lru_wx": nrm((L, LRU_BLOCKS, LRU_BW, LRU_BW), LRU_BW ** -0.5),
        "lru_bx": nrm((L, MIX_W), 0.02),
        "lru_lambda": lru_lambda,
        "w_branch": nrm((L, N_BRANCH, MIX_W, D), beta * MIX_W ** -0.5),
        "w_out": nrm((L, D, D), beta * D ** -0.5),
        "b_out": nrm((L, D), 0.02),
        "ln1_g": gain((L, D)),
        "ln1_b": nrm((L, D), 0.02),
        "ca_wq": nrm((L, D, D), D ** -0.5),
        "ca_wk": nrm((L, D, D), D ** -0.5),
        "ca_wv": nrm((L, D, D), beta * D ** -0.5),
        "ca_wo": nrm((L, D, D), beta * D ** -0.5),
        "ln2_g": gain((L, D)),
        "ln2_b": nrm((L, D), 0.02),
        "router_w": nrm((L, D, N_EXPERTS), D ** -0.5),
        "router_b": nrm((L, N_EXPERTS), 0.01),
        "moe_w1": nrm((L, N_EXPERTS, D, 2 * MOE_FF), beta * D ** -0.5),
        "moe_b1": nrm((L, N_EXPERTS, 2 * MOE_FF), 0.02),
        "moe_w2": nrm((L, N_EXPERTS, MOE_FF, D), beta * MOE_FF ** -0.5),
        "moe_b2": nrm((L, N_EXPERTS, D), 0.02),
        "ln3_g": gain((L, D)),
        "ln3_b": nrm((L, D), 0.02),
    }


def reference(x, mem, ln0_g, ln0_b, w_in, b_in, conv_a_w, conv_a_b, ln_a_g, ln_a_b, gla_wa2, gla_ba,
              gla_norm_g, conv_d_w, conv_d_b, lru_wa, lru_ba, lru_wx, lru_bx, lru_lambda, w_branch,
              w_out, b_out, ln1_g, ln1_b, ca_wq, ca_wk, ca_wv, ca_wo, ln2_g, ln2_b, router_w, router_b,
              moe_w1, moe_b1, moe_w2, moe_b2, ln3_g, ln3_b):
    B, S, D = x.shape
    h = layer_norm(x, ln0_g, ln0_b)
    for l in range(DEPTH):
        mix = hybrid_mixer(h, w_in[l], b_in[l], conv_a_w[l], conv_a_b[l], ln_a_g[l], ln_a_b[l],
                           gla_wa2[l], gla_ba[l], gla_norm_g[l], conv_d_w[l], conv_d_b[l],
                           lru_wa[l], lru_ba[l], lru_wx[l], lru_bx[l], lru_lambda[l],
                           w_branch[l], w_out[l], b_out[l])
        h = layer_norm(DEEPNORM_ALPHA * h + mix, ln1_g[l], ln1_b[l])
        ca = memory_cross_attention(h, mem, ca_wq[l], ca_wk[l], ca_wv[l], ca_wo[l])
        h = layer_norm(DEEPNORM_ALPHA * h + ca, ln2_g[l], ln2_b[l])
        ff = moe_ffn(h.reshape(B * S, D), router_w[l], router_b[l], moe_w1[l], moe_b1[l],
                     moe_w2[l], moe_b2[l]).reshape(B, S, D)
        h = layer_norm(DEEPNORM_ALPHA * h + ff, ln3_g[l], ln3_b[l])
    return h
```

```cpp
#define MK_MULTI_LAUNCH 0
#include <hip/hip_runtime.h>
#include <stdint.h>
#include <stdio.h>

#define LAS __attribute__((address_space(3)))
typedef unsigned short bf16_t;
typedef short bf16x8 __attribute__((ext_vector_type(8)));
typedef float f32x4 __attribute__((ext_vector_type(4)));
typedef float f32x2 __attribute__((ext_vector_type(2)));
typedef unsigned u32x4 __attribute__((ext_vector_type(4)));
typedef unsigned u32x2 __attribute__((ext_vector_type(2)));

constexpr int T_ = 16384, D_ = 1024, NB_ = 4, SEQ_ = 4096, NL_ = 4;
constexpr int INC = 9232;
constexpr int ZC = 9216;
constexpr int LR_COL = 2560;
constexpr int Z_AVAL = 0, Z_AGATE = 512, Z_BQ = 1024, Z_BK = 1280, Z_BV = 1536, Z_BR = 2048, Z_CQ = 2560, Z_CK = 3072, Z_CV = 3584, Z_DX = 4096, Z_DG = 4608, Z_GM = 5120;
constexpr int NEXP = 32, TOPK = 4;
constexpr int NSLOT = 73728;
constexpr float LN_EPS = 1e-5f;
constexpr float DN_ALPHA = 1.6817928305074290f;

__device__ __forceinline__ float bf2f(unsigned v) { return __uint_as_float(v << 16); }
__device__ __forceinline__ float bflo(unsigned v) { return __uint_as_float(v << 16); }
__device__ __forceinline__ float bfhi(unsigned v) { return __uint_as_float(v & 0xffff0000u); }
__device__ __forceinline__ unsigned f2bf(float f) { unsigned u = __float_as_uint(f); u += 0x7FFFu + ((u >> 16) & 1u); return u >> 16; }
typedef __bf16 bf16x2_t __attribute__((ext_vector_type(2)));
__device__ __forceinline__ unsigned pk2(float lo, float hi) { const f32x2 v = {lo, hi}; return __builtin_bit_cast(unsigned, __builtin_convertvector(v, bf16x2_t)); }
__device__ __forceinline__ float wave_sum(float v) {
#pragma unroll
    for (int o = 1; o < 64; o <<= 1) v += __shfl_xor(v, o);
    return v;
}
__device__ __forceinline__ float sigmoidf_(float x) { return __builtin_amdgcn_rcpf(1.f + __expf(-x)); }
__device__ __forceinline__ float softplusf_(float x) { return fmaxf(x, 0.f) + __logf(1.f + __expf(-fabsf(x))); }
#define LDS_WAIT() asm volatile("s_waitcnt lgkmcnt(0)" ::: "memory")

namespace pg8 {
constexpr int BM = 256, BK = 64, HALF = 128, HTB = HALF * BK * 2, STAGE_BYTES = 8 * HTB;
__host__ __device__ __forceinline__ int lds_byte(int r, int c) { const int st = (r >> 4) * 2 + (c >> 5), rr = r & 15, cc = c & 31, ob = rr * 64 + cc * 2; return st * 1024 + (ob ^ (((ob >> 9) & 1) << 5)); }
__host__ __device__ __forceinline__ void stage_rc(int b, int& R, int& C) { const int st = b / 1024, sb = b % 1024, swz = sb ^ (((sb >> 9) & 1) << 5); R = (st >> 1) * 16 + swz / 64; C = (st & 1) * 32 + (swz % 64) / 2; }
__host__ __device__ __forceinline__ int perm32(int rho) { const int n = rho >> 4, i = rho & 15; return 8 * (i >> 2) + 4 * n + (i & 3); }

struct Unit { const char* a; const char* b; char* c; int ldc, row0, col0, aux, g0, g1, kind; };
struct Gemm { int lda, ldb, K; };

__device__ __forceinline__ void swz_tile(int L, int nM, int nN, int& pm, int& pn) {
    const int nwg = nM * nN; int wgid = L;
    { const int q = nwg / 8, r = nwg % 8, xcd = wgid % 8, off = wgid / 8; wgid = (xcd < r ? xcd * (q + 1) : r * (q + 1) + (xcd - r) * q) + off; }
    const int nig = 8 * nN, gid = wgid / nig, fm = gid * 8, gsz = (nM - fm) < 8 ? (nM - fm) : 8;
    pm = fm + ((wgid % nig) % gsz); pn = (wgid % nig) / gsz;
}

template <class Epi, class Sched>
__device__ __forceinline__ void gemm_phase(LAS unsigned char* lds, const Gemm g, const Sched& S, const Epi& E) {
    int tid_ = threadIdx.x; asm volatile("" : "+v"(tid_));
    const int tid = tid_, wid = __builtin_amdgcn_readfirstlane(tid >> 6), lane = tid & 63, wr = wid >> 2, wc = wid & 3, fr = lane & 15, fq = lane >> 4;
    const int K = g.K, nt = K / BK;
    unsigned voffA[2][2], nvoffA[2][2], voffB[2]; int RA[2], CA[2];
#pragma unroll
    for (int i = 0; i < 2; ++i) { int R, C; stage_rc(tid * 16 + i * 8192, R, C); const int Rb = Epi::PERM ? ((R & ~31) + perm32(R & 31)) : R; RA[i] = R; CA[i] = C;
        voffA[0][i] = (unsigned)(R * g.lda + C) * 2u; voffA[1][i] = (unsigned)((R + HALF) * g.lda + C) * 2u; voffB[i] = (unsigned)(Rb * g.ldb + C) * 2u; }
    const size_t kstep = (size_t)(BK * 2);
    const size_t hstepB = (size_t)HALF * g.ldb * 2;
    const unsigned ldsw = (unsigned)wid * 1024u;
    const int aoff = lds_byte(wr * 64 + fr, fq * 8), boff = lds_byte(wc * 32 + fr, fq * 8);
#define PG8_SA(b, h) (((b) * 2 + (h)) * HTB)
#define PG8_SB(b, h) ((4 + (b) * 2 + (h)) * HTB)
#define PG8_STAGE(bufoff, gbase, voff) do { _Pragma("unroll") for (int _i = 0; _i < 2; ++_i) \
        __builtin_amdgcn_global_load_lds((const unsigned*)((const char*)(gbase) + (voff)[_i]), (LAS unsigned*)(lds + (bufoff) + ldsw + _i * 8192), 16, 0, 0); } while (0)
#define PG8_STAGEA(b, h, gbase, vo) PG8_STAGE(PG8_SA(b, h), gbase, (vo)[h])
#define PG8_LDA(dst, b, h) do { _Pragma("unroll") for (int m = 0; m < 4; ++m) _Pragma("unroll") for (int k = 0; k < 2; ++k) dst[m][k] = *(const LAS bf16x8*)(lds + PG8_SA(b, h) + aoff + m * 2048 + k * 1024); } while (0)
#define PG8_LDB(dst, b, h) do { _Pragma("unroll") for (int n = 0; n < 2; ++n) _Pragma("unroll") for (int k = 0; k < 2; ++k) dst[n][k] = *(const LAS bf16x8*)(lds + PG8_SB(b, h) + boff + n * 2048 + k * 1024); } while (0)
#define PG8_MMA(ai, bj, At, Bt) do { __builtin_amdgcn_s_setprio(1); _Pragma("unroll") for (int m = 0; m < 4; ++m) _Pragma("unroll") for (int n = 0; n < 2; ++n) _Pragma("unroll") for (int k = 0; k < 2; ++k) \
        acc[ai][bj][m][n] = __builtin_amdgcn_mfma_f32_16x16x32_bf16(Bt[n][k], At[m][k], acc[ai][bj][m][n], 0, 0, 0); __builtin_amdgcn_s_setprio(0); } while (0)
#define PG8_WAIT_V(n) asm volatile("s_waitcnt vmcnt(" #n ")" ::: "memory")
#define PG8_WAIT_L(n) asm volatile("s_waitcnt lgkmcnt(" #n ")" ::: "memory")
#define PG8_BAR __builtin_amdgcn_s_barrier()
#define PG8_SCHED __builtin_amdgcn_sched_barrier(0)
    Unit cur, nxt; int ui = 0;
    if (!S.next(0, cur)) return;
    f32x4 acc[2][2][4][2];
#pragma unroll
    for (int a = 0; a < 2; ++a)
#pragma unroll
        for (int b = 0; b < 2; ++b)
#pragma unroll
            for (int m = 0; m < 4; ++m)
#pragma unroll
                for (int n = 0; n < 2; ++n) acc[a][b][m][n] = (f32x4){0.f, 0.f, 0.f, 0.f};
    bf16x8 At[4][2], B0[2][2], B1[2][2];
    const char* cA = cur.a; const char* cB = cur.b;
    int pend = -1;
    if constexpr (Sched::COUNTED) S.a_ready(cur);
    if constexpr (Sched::GATHER) {
#pragma unroll
        for (int h = 0; h < 2; ++h)
#pragma unroll
            for (int i = 0; i < 2; ++i) voffA[h][i] = S.rowoff(cur, h * HALF + RA[i]) + (unsigned)CA[i] * 2u; }
    PG8_STAGE(PG8_SB(0, 0), cB, voffB); PG8_STAGE(PG8_SB(0, 1), cB + hstepB, voffB); PG8_STAGEA(0, 0, cA, voffA); PG8_STAGEA(0, 1, cA, voffA);
    if (wr == 1) PG8_BAR;
    PG8_WAIT_V(2); PG8_BAR;
    PG8_STAGE(PG8_SB(1, 0), cB + kstep, voffB); PG8_STAGEA(1, 0, cA + kstep, voffA); PG8_STAGE(PG8_SB(1, 1), cB + hstepB + kstep, voffB);
    PG8_WAIT_V(6); PG8_BAR;
    for (;;) {
        const bool has_next = S.next(ui + 1, nxt);
        if constexpr (Sched::GATHER) { if (has_next) {
#pragma unroll
            for (int h = 0; h < 2; ++h)
#pragma unroll
                for (int i = 0; i < 2; ++i) nvoffA[h][i] = S.rowoff(nxt, h * HALF + RA[i]) + (unsigned)CA[i] * 2u; } }
        const char* nA = has_next ? nxt.a : cA; const char* nB = has_next ? nxt.b : cB;
#pragma unroll 1
        for (int t = 0; t < nt; t += 2) {
            const bool last = (t == nt - 2);
            if constexpr (Sched::COUNTED) { if (last) {
                if (pend >= 0) { S.publish(pend, lane); pend = -1; }
                if (has_next) S.a_ready(nxt); } }
            const char* a1 = cA + (size_t)(t + 1) * kstep;
            const char* a2 = last ? nA : cA + (size_t)(t + 2) * kstep; const char* b2 = last ? nB : cB + (size_t)(t + 2) * kstep;
            const char* a3 = a2 + kstep; const char* b3 = b2 + kstep;
            unsigned vo2[2][2];
#pragma unroll
            for (int h = 0; h < 2; ++h)
#pragma unroll
                for (int i = 0; i < 2; ++i) vo2[h][i] = (Sched::GATHER && last && has_next) ? nvoffA[h][i] : voffA[h][i];
            PG8_LDB(B0, 0, 0); PG8_LDB(B1, 0, 1); PG8_SCHED; PG8_LDA(At, 0, 0); PG8_STAGEA(1, 1, a1, voffA);
            PG8_WAIT_V(8); PG8_WAIT_L(0); PG8_BAR; PG8_MMA(0, 0, At, B0); PG8_MMA(0, 1, At, B1); PG8_BAR; PG8_SCHED;
            PG8_LDA(At, 0, 1); PG8_STAGE(PG8_SB(0, 0), b2, voffB); PG8_STAGE(PG8_SB(0, 1), b2 + hstepB, voffB); PG8_STAGEA(0, 0, a2, vo2);
            PG8_WAIT_V(8); PG8_WAIT_L(0); PG8_BAR; PG8_MMA(1, 0, At, B0); PG8_MMA(1, 1, At, B1); PG8_BAR; PG8_SCHED;
            PG8_LDB(B0, 1, 0); PG8_LDB(B1, 1, 1); PG8_SCHED; PG8_LDA(At, 1, 0); PG8_STAGEA(0, 1, a2, vo2);
            PG8_WAIT_V(8); PG8_WAIT_L(0); PG8_BAR; PG8_MMA(0, 0, At, B0); PG8_MMA(0, 1, At, B1); PG8_BAR; PG8_SCHED;
            PG8_LDA(At, 1, 1); PG8_STAGE(PG8_SB(1, 0), b3, voffB); PG8_STAGE(PG8_SB(1, 1), b3 + hstepB, voffB); PG8_STAGEA(1, 0, a3, vo2);
            PG8_WAIT_V(8); PG8_WAIT_L(0); PG8_BAR; PG8_MMA(1, 0, At, B0); PG8_MMA(1, 1, At, B1); PG8_BAR; PG8_SCHED;
            if constexpr (Epi::SEG > 0) {
                if (!last && ((t + 2) % Epi::SEG) == 0) { int fr_e = fr, fq_e = fq; asm volatile("" : "+v"(fr_e), "+v"(fq_e)); E.mid(acc, cur, (t + 2) / Epi::SEG - 1, wr, wc, fr_e, fq_e); } }
        }
        if (wr == 0) PG8_BAR;
        { int fr_e = fr, fq_e = fq; asm volatile("" : "+v"(fr_e), "+v"(fq_e));
          E(acc, cur, wr, wc, fr_e, fq_e); }
        if constexpr (Sched::COUNTED) pend = S.pending(cur);
        if (!has_next) break;
#pragma unroll
        for (int a = 0; a < 2; ++a)
#pragma unroll
            for (int b = 0; b < 2; ++b)
#pragma unroll
                for (int m = 0; m < 4; ++m)
#pragma unroll
                    for (int n = 0; n < 2; ++n) acc[a][b][m][n] = (f32x4){0.f, 0.f, 0.f, 0.f};
        cur = nxt; cA = nA; cB = nB; ++ui;
        if constexpr (Sched::GATHER) {
#pragma unroll
            for (int h = 0; h < 2; ++h)
#pragma unroll
                for (int i = 0; i < 2; ++i) voffA[h][i] = nvoffA[h][i]; }
        if (wr == 1) PG8_BAR;
    }
    PG8_WAIT_V(0);
    if constexpr (Sched::COUNTED) { if (pend >= 0) S.publish(pend, lane); }
    PG8_BAR;
#undef PG8_SA
#undef PG8_SB
#undef PG8_STAGE
#undef PG8_STAGEA
#undef PG8_LDA
#undef PG8_LDB
#undef PG8_MMA
#undef PG8_WAIT_V
#undef PG8_WAIT_L
#undef PG8_BAR
#undef PG8_SCHED
}
}

#define XB_TMO      128
#define XB_XCNT(j)  (256  + 64 * (j))
#define XB_XSUB(j)  (1280 + 64 * (j))
#define XB_XGEN(j)  (2304 + 64 * (j))
#define XB_TOP      3328
#define XB_TOPGEN   3392
#define XCD_BAR_WORDS 3456
#define XB_SPIN_CAP (1u << 18)
__device__ __forceinline__ unsigned xb_ld(unsigned* p)              { return __hip_atomic_load(p, __ATOMIC_RELAXED, __HIP_MEMORY_SCOPE_AGENT); }
__device__ __forceinline__ unsigned xb_add(unsigned* p, unsigned v) { return __hip_atomic_fetch_add(p, v, __ATOMIC_RELAXED, __HIP_MEMORY_SCOPE_AGENT); }
__device__ __forceinline__ unsigned xb_xcc_id() { return (unsigned)__builtin_amdgcn_s_getreg((3 << 11) | 20) & 0xFu; }
#define XB_SPIN(cond, bar) do { unsigned _sp = 0; while (cond) { __builtin_amdgcn_s_sleep(1); \
    if ((++_sp & 255u) == 0u) { if (xb_ld(&(bar)[XB_TMO])) break; if (_sp > XB_SPIN_CAP) { atomicAdd(&(bar)[XB_TMO], 1u); break; } } } } while (0)
struct XcdBarrier { unsigned* bar; unsigned x; volatile LAS unsigned* st; };
__device__ __forceinline__ XcdBarrier xcd_barrier_post(unsigned* bar, volatile LAS unsigned* st) {
    XcdBarrier b; b.bar = bar; b.x = xb_xcc_id(); b.st = st;
    if (threadIdx.x == 0) (void)xb_add(&bar[XB_XCNT(b.x)], 1u);
    return b;
}
__device__ __forceinline__ void xcd_barrier_complete(unsigned* bar, unsigned x, unsigned& nloc, unsigned& nx) {
    const unsigned G = gridDim.x * gridDim.y * gridDim.z;
    unsigned sum, cnt, mine, sp = 0u;
    for (;;) {
        sum = 0u; cnt = 0u; mine = 0u;
#pragma unroll
        for (unsigned j = 0; j < 16; ++j) { const unsigned c = xb_ld(&bar[XB_XCNT(j)]); sum += c; cnt += (c > 0u) ? 1u : 0u; mine = (j == x) ? c : mine; }
        if (sum == G) break;
        __builtin_amdgcn_s_sleep(1);
        if ((++sp & 255u) == 0u) { if (xb_ld(&bar[XB_TMO])) break; if (sp > XB_SPIN_CAP) { atomicAdd(&bar[XB_TMO], 1u); break; } }
    }
    nloc = mine > 0u ? mine : 1u; nx = cnt > 0u ? cnt : 1u;
}
__device__ __forceinline__ void xcd_barrier(const XcdBarrier& b) {
    asm volatile("s_waitcnt vmcnt(0)" ::: "memory");
    __syncthreads();
    if (threadIdx.x == 0) {
        unsigned* bar = b.bar;
        __builtin_amdgcn_s_waitcnt(0);
        unsigned nloc = b.st[0], nx = b.st[1];
        if (nloc == 0u) { xcd_barrier_complete(bar, b.x, nloc, nx); b.st[0] = nloc; b.st[1] = nx; }
        const unsigned old = xb_add(&bar[XB_XSUB(b.x)], 1u);
        const unsigned gen = old / nloc;
        if (old + 1u == (gen + 1u) * nloc) {
            __builtin_amdgcn_fence(__ATOMIC_RELEASE, "agent");
            asm volatile("s_waitcnt vmcnt(0)" ::: "memory");
            const unsigned og = xb_add(&bar[XB_TOP], 1u);
            const unsigned tg = og / nx;
            if (og + 1u == (tg + 1u) * nx) {
#pragma unroll
                for (unsigned j = 0; j < 16; ++j) xb_add(&bar[XB_XGEN(j)], 1u); }
            else XB_SPIN(xb_ld(&bar[XB_XGEN(b.x)]) == gen, bar);
            __builtin_amdgcn_fence(__ATOMIC_ACQUIRE, "agent");
            asm volatile("s_waitcnt vmcnt(0)" ::: "memory");
        } else {
            asm volatile("buffer_inv sc1" ::: "memory");
            XB_SPIN(xb_ld(&bar[XB_XGEN(b.x)]) == gen, bar);
            asm volatile("s_waitcnt vmcnt(0)" ::: "memory");
        }
    }
    __syncthreads();
}
constexpr size_t al256(size_t x) { return (x + 255) & ~(size_t)255; }
constexpr size_t WS_CTL = 0, CTL_BYTES = 256u << 10;
constexpr size_t SZ_WIN = (size_t)ZC * 1024 * 2, SZ_WBR = (size_t)4 * 1024 * 512 * 2, SZ_W1K = (size_t)1024 * 1024 * 2, SZ_WKV = 2 * SZ_W1K;
constexpr size_t SZ_W1 = (size_t)NEXP * 2048 * 1024 * 2, SZ_W2 = (size_t)NEXP * 1024 * 1024 * 2;
constexpr size_t LW_WIN = 0, LW_WBR = LW_WIN + SZ_WIN, LW_WOUT = LW_WBR + SZ_WBR, LW_WQ = LW_WOUT + SZ_W1K, LW_WKV = LW_WQ + SZ_W1K, LW_WO = LW_WKV + SZ_WKV,
                 LW_W1 = LW_WO + SZ_W1K, LW_W2 = LW_W1 + SZ_W1, LW_END = LW_W2 + SZ_W2;
constexpr size_t WS_W = WS_CTL + CTL_BYTES;
constexpr size_t WS_MEMB = WS_W + NL_ * LW_END;
constexpr size_t WS_KMEM = WS_MEMB + SZ_W1K;
constexpr size_t WS_MQT = WS_KMEM + NL_ * 2 * SZ_W1K;
constexpr size_t WS_VWT = WS_MQT + NL_ * 4 * SZ_W1K;
constexpr size_t WS_H = WS_VWT + NL_ * 4 * SZ_W1K;
constexpr size_t WS_HB = WS_H + (size_t)T_ * 1024 * 4;
constexpr size_t WS_Z = WS_HB + (size_t)T_ * 1024 * 2;
constexpr size_t WS_BCUM = WS_Z + (size_t)T_ * ZC * 2;
constexpr size_t WS_KVST = WS_BCUM + (size_t)T_ * 256 * 4;
constexpr size_t WS_SPREV = WS_KVST + (size_t)4 * 64 * 4 * 64 * 128 * 4;
constexpr size_t WS_LAGG = WS_SPREV + (size_t)4 * 64 * 4 * 64 * 128 * 4;
constexpr size_t WS_YS = WS_LAGG + (size_t)3 * 4 * 64 * 512 * 4;
constexpr size_t WS_MF = WS_YS + (size_t)T_ * 2048 * 2;
constexpr size_t WS_MB = WS_MF + (size_t)3 * T_ * 1024 * 2;
constexpr size_t WS_PRE = WS_MB + (size_t)T_ * 1024 * 2;
constexpr size_t WS_Q = WS_PRE + (size_t)T_ * 1024 * 4;
constexpr size_t WS_P = WS_Q + (size_t)T_ * 1024 * 2;
constexpr size_t WS_O = WS_P + (size_t)T_ * 1024 * 2;
constexpr size_t WS_TOKE = WS_O + (size_t)T_ * 1024 * 2;
constexpr size_t WS_TOKR = WS_TOKE + (size_t)T_ * 4 * 4;
constexpr size_t WS_TOKG = WS_TOKR + (size_t)T_ * 4 * 4;
constexpr size_t WS_TOKS = WS_TOKG + (size_t)T_ * 4 * 4;
constexpr size_t WS_SGATE = WS_TOKS + (size_t)T_ * 4 * 4;
constexpr size_t WS_XS = al256(WS_SGATE + (size_t)NSLOT * 4);
constexpr size_t WS_ACT = WS_XS + (size_t)NSLOT * 1024 * 2;
constexpr size_t WS_YSL = WS_ACT + (size_t)NSLOT * 1024 * 2;
constexpr size_t WS_ELIST = WS_YSL + (size_t)NSLOT * 1024 * 2;
constexpr size_t WS_XLN = WS_ELIST + (size_t)NEXP * T_ * 4;
constexpr size_t WS_LGW = WS_XLN + (size_t)64 * 4 * 256 * 8;
constexpr size_t WS_WLR = WS_LGW + (size_t)NL_ * 2 * 8 * 64 * 64 * 2;
constexpr size_t WS_RWS = WS_WLR + (size_t)NL_ * 16 * 1024 * 2;
constexpr size_t WS_XRT = WS_RWS + (size_t)NL_ * 2 * 32 * 1024 * 2;
constexpr size_t WS_END = WS_XRT + (size_t)64 * 4 * 256 * 32 * 4;

constexpr int CW_BAR = 0;
constexpr int CW_CNT = 8 * XCD_BAR_WORDS;
constexpr int CW_LN = CW_CNT + NL_ * 32 * 16;
constexpr int CW_RT = CW_LN + NL_ * 2 * 64 * 16;
constexpr int CW_MOE = CW_RT + NL_ * 64 * 16;
static_assert((CW_MOE + NL_ * 288 * 16) * 4 <= (int)CTL_BYTES, "control words");

constexpr int LDS_STAGE = 0, LDS_MISC = 131072, LDS_BYTES = 147456;
constexpr int MISC_XCH = 0;
constexpr int MISC_MOE = 8192;
constexpr int MISC_RED = 9216;
constexpr int MISC_STAT = 10240;
constexpr int MISC_R2E = 12288;
constexpr int MISC_BAR = 16368;

struct Params { const float* in[39]; float* out; unsigned char* ws; int ph_lo, ph_hi, li, pad; };
typedef const Params __attribute__((address_space(4)))* KP;

enum { I_X = 0, I_MEM, I_LN0G, I_LN0B, I_WIN, I_BIN, I_CAW, I_CAB, I_LNAG, I_LNAB, I_WA2, I_GBA, I_GNG, I_CDW, I_CDB, I_LWA, I_LBA, I_LWX, I_LBX, I_LLAM,
       I_WBR, I_WOUT, I_BOUT, I_LN1G, I_LN1B, I_WQ, I_WK, I_WV, I_WO, I_LN2G, I_LN2B, I_RW, I_RB, I_W1, I_B1, I_W2, I_B2, I_LN3G, I_LN3B };

using pg8::Unit;
typedef f32x4 (AccT)[2][2][4][2];

template <bool SIG = false>
struct EpiStoreBf16T {
    static constexpr bool PERM = true; static constexpr int SEG = 0;
    const float* bias; float scale;
    __device__ __forceinline__ void operator()(f32x4 (&acc)[2][2][4][2], const Unit& u, int wr, int wc, int fr, int fq) const {
        bf16_t* base = (bf16_t*)u.c;
        const int colb = wc * 32 + 8 * fq;
        f32x4 bv[2][2];
#pragma unroll
        for (int bj = 0; bj < 2; ++bj)
#pragma unroll
            for (int n = 0; n < 2; ++n) bv[bj][n] = bias ? *(const f32x4*)(bias + u.col0 + u.aux + colb + bj * 128 + 4 * n) : (f32x4){0.f, 0.f, 0.f, 0.f};
#pragma unroll
        for (int ai = 0; ai < 2; ++ai)
#pragma unroll
            for (int m = 0; m < 4; ++m) {
                bf16_t* rowp = base + (size_t)(ai * 128 + wr * 64 + m * 16 + fr) * u.ldc + colb;
#pragma unroll
                for (int bj = 0; bj < 2; ++bj) {
                    f32x4 v0 = (acc[ai][bj][m][0] + bv[bj][0]) * scale, v1 = (acc[ai][bj][m][1] + bv[bj][1]) * scale;
                    if (SIG && u.col0 >= Z_GM) {
#pragma unroll
                        for (int e4 = 0; e4 < 4; ++e4) { v0[e4] = fminf(1.f + __expf(-v0[e4]), 1048576.f); v1[e4] = fminf(1.f + __expf(-v1[e4]), 1048576.f); } }
                    u32x4 w; w.x = pk2(v0[0], v0[1]); w.y = pk2(v0[2], v0[3]); w.z = pk2(v1[0], v1[1]); w.w = pk2(v1[2], v1[3]);
                    *(u32x4*)(rowp + bj * 128) = w;
                }
            }
    }
};
typedef EpiStoreBf16T<false> EpiStoreBf16;

struct EpiMerge {
    static constexpr bool PERM = true; static constexpr int SEG = 8;
    const bf16_t* z; bf16_t* mb; int dbg;
    static __device__ __forceinline__ float gfl(float g) { return fmaxf(g, 9.5367431640625e-7f); }
    __device__ __forceinline__ void mid(f32x4 (&acc)[2][2][4][2], const Unit& u, int seg, int wr, int wc, int fr, int fq) const {
        const int colb = u.col0 + wc * 32 + 8 * fq;
#pragma unroll
        for (int ai = 0; ai < 2; ++ai) {
            u32x4 ga[4][2], gb[4][2];
#pragma unroll
            for (int m = 0; m < 4; ++m)
#pragma unroll
                for (int bj = 0; bj < 2; ++bj) { const bf16_t* gp = z + (size_t)(u.row0 + ai * 128 + wr * 64 + m * 16 + fr) * ZC + Z_GM + seg * 1024 + colb + bj * 128;
                    ga[m][bj] = *(const u32x4*)gp; gb[m][bj] = *(const u32x4*)(gp + 1024); }
#pragma unroll
            for (int m = 0; m < 4; ++m)
#pragma unroll
                for (int bj = 0; bj < 2; ++bj) { const u32x4 a = ga[m][bj], b = gb[m][bj];
                    const unsigned aw[4] = {a.x, a.y, a.z, a.w}, bw[4] = {b.x, b.y, b.z, b.w};
#pragma unroll
                    for (int e = 0; e < 4; ++e) { const float r0 = bflo(bw[e]) * __builtin_amdgcn_rcpf(bflo(aw[e])), r1 = bfhi(bw[e]) * __builtin_amdgcn_rcpf(bfhi(aw[e]));
                        acc[ai][bj][m][e >> 1][2 * (e & 1)] *= r0; acc[ai][bj][m][e >> 1][2 * (e & 1) + 1] *= r1; } }
        }
    }
    __device__ __forceinline__ void operator()(f32x4 (&acc)[2][2][4][2], const Unit& u, int wr, int wc, int fr, int fq) const {
        if (dbg & 16) return;
        const int colb = u.col0 + wc * 32 + 8 * fq;
#pragma unroll
        for (int ai = 0; ai < 2; ++ai) {
            u32x4 gz[4][2];
#pragma unroll
            for (int m = 0; m < 4; ++m)
#pragma unroll
                for (int bj = 0; bj < 2; ++bj) gz[m][bj] = *(const u32x4*)(z + (size_t)(u.row0 + ai * 128 + wr * 64 + m * 16 + fr) * ZC + Z_GM + 3 * 1024 + colb + bj * 128);
#pragma unroll
            for (int m = 0; m < 4; ++m)
#pragma unroll
                for (int bj = 0; bj < 2; ++bj) { const u32x4 g4 = gz[m][bj]; const f32x4 a0 = acc[ai][bj][m][0], a1 = acc[ai][bj][m][1];
                    u32x4 w; w.x = pk2(a0[0] * __builtin_amdgcn_rcpf(bflo(g4.x)), a0[1] * __builtin_amdgcn_rcpf(bfhi(g4.x))); w.y = pk2(a0[2] * __builtin_amdgcn_rcpf(bflo(g4.y)), a0[3] * __builtin_amdgcn_rcpf(bfhi(g4.y)));
                    w.z = pk2(a1[0] * __builtin_amdgcn_rcpf(bflo(g4.z)), a1[1] * __builtin_amdgcn_rcpf(bfhi(g4.z))); w.w = pk2(a1[2] * __builtin_amdgcn_rcpf(bflo(g4.w)), a1[3] * __builtin_amdgcn_rcpf(bfhi(g4.w)));
                    *(u32x4*)(mb + (size_t)(u.row0 + ai * 128 + wr * 64 + m * 16 + fr) * 1024 + colb + bj * 128) = w; }
        }
    }
};

struct EpiResid {
    static constexpr bool PERM = false; static constexpr int SEG = 0;
    const float* bias; const float* h; float* pre;
    __device__ __forceinline__ void operator()(f32x4 (&acc)[2][2][4][2], const Unit& u, int wr, int wc, int fr, int fq) const {
        const int colb = u.col0 + wc * 32 + 4 * fq;
        f32x4 bv[2][2];
#pragma unroll
        for (int bj = 0; bj < 2; ++bj)
#pragma unroll
            for (int n = 0; n < 2; ++n) bv[bj][n] = bias ? *(const f32x4*)(bias + colb + bj * 128 + n * 16) : (f32x4){0.f, 0.f, 0.f, 0.f};
#pragma unroll
        for (int ai = 0; ai < 2; ++ai)
#pragma unroll
            for (int mh = 0; mh < 2; ++mh) {
                f32x4 hv[2][2][2];
#pragma unroll
                for (int mm = 0; mm < 2; ++mm) { const int row = u.row0 + ai * 128 + wr * 64 + (2 * mh + mm) * 16 + fr;
#pragma unroll
                    for (int bj = 0; bj < 2; ++bj)
#pragma unroll
                        for (int n = 0; n < 2; ++n) hv[mm][bj][n] = *(const f32x4*)(h + (size_t)row * 1024 + colb + bj * 128 + n * 16); }
#pragma unroll
                for (int mm = 0; mm < 2; ++mm) { const int row = u.row0 + ai * 128 + wr * 64 + (2 * mh + mm) * 16 + fr;
#pragma unroll
                    for (int bj = 0; bj < 2; ++bj)
#pragma unroll
                        for (int n = 0; n < 2; ++n) *(f32x4*)(pre + (size_t)row * 1024 + colb + bj * 128 + n * 16) = acc[ai][bj][2 * mh + mm][n] + DN_ALPHA * hv[mm][bj][n] + bv[bj][n]; }
            }
    }
};

template <bool WF32  , bool ROUTE  >
struct EpiResidLNT {
    static constexpr bool PERM = true; static constexpr int SEG = 0;
    const float* bias; const float* g; const float* b; unsigned char* ws; LAS float* xch; LAS float* stats; unsigned* cnt;
    LAS char* sl; const float* rbias; int l;
    __device__ __forceinline__ void operator()(f32x4 (&acc)[2][2][4][2], const Unit& u, int wr, int wc, int fr, int fq) const {
        float* hf = (float*)(ws + WS_H); bf16_t* hb = (bf16_t*)(ws + WS_HB); unsigned long long* xbuf = (unsigned long long*)(ws + WS_XLN);
        const int tid = threadIdx.x, colb = u.col0 + wc * 32 + 8 * fq, panel = u.row0 >> 8, pn = u.col0 >> 8;
        const unsigned e0 = (unsigned)((u.row0 + wr * 64 + fr) * 1024 + colb);
#pragma unroll
        for (int bj = 0; bj < 2; ++bj) {
            u32x4 hv[2][4];
#pragma unroll
            for (int ai = 0; ai < 2; ++ai)
#pragma unroll
                for (int m = 0; m < 4; ++m) hv[ai][m] = *(const u32x4*)((const char*)hb + (size_t)((e0 + (unsigned)((ai * 128 + m * 16) * 1024 + bj * 128)) * 2u));
            const f32x4 bv0 = bias ? *(const f32x4*)(bias + colb + bj * 128) : (f32x4){0.f, 0.f, 0.f, 0.f}, bv1 = bias ? *(const f32x4*)(bias + colb + bj * 128 + 4) : (f32x4){0.f, 0.f, 0.f, 0.f};
#pragma unroll
            for (int ai = 0; ai < 2; ++ai) {
#pragma unroll
                for (int m = 0; m < 4; ++m) { const u32x4 x = hv[ai][m];
                    acc[ai][bj][m][0] = acc[ai][bj][m][0] + DN_ALPHA * (f32x4){bflo(x.x), bfhi(x.x), bflo(x.y), bfhi(x.y)} + bv0;
                    acc[ai][bj][m][1] = acc[ai][bj][m][1] + DN_ALPHA * (f32x4){bflo(x.z), bfhi(x.z), bflo(x.w), bfhi(x.w)} + bv1; }
                asm volatile("" : "+v"(acc[ai][bj][0][0]), "+v"(acc[ai][bj][1][0]), "+v"(acc[ai][bj][2][0]), "+v"(acc[ai][bj][3][0]), "+v"(acc[ai][bj][0][1]), "+v"(acc[ai][bj][1][1]), "+v"(acc[ai][bj][2][1]), "+v"(acc[ai][bj][3][1]) :: "memory"); }
        }
#pragma unroll
        for (int ai = 0; ai < 2; ++ai)
#pragma unroll
            for (int m = 0; m < 4; ++m) { float s1 = 0.f, s2 = 0.f;
#pragma unroll
                for (int bj = 0; bj < 2; ++bj)
#pragma unroll
                    for (int n = 0; n < 2; ++n) { const f32x4 a = acc[ai][bj][m][n]; s1 += (a[0] + a[1]) + (a[2] + a[3]); s2 += (a[0] * a[0] + a[1] * a[1]) + (a[2] * a[2] + a[3] * a[3]); }
                s1 += __shfl_xor(s1, 16); s1 += __shfl_xor(s1, 32); s2 += __shfl_xor(s2, 16); s2 += __shfl_xor(s2, 32);
                if (fq == 0) { const int r = ai * 128 + wr * 64 + m * 16 + fr; xch[wc * 256 + r] = s1; xch[1024 + wc * 256 + r] = s2; } }
        LDS_WAIT(); __builtin_amdgcn_s_barrier(); asm volatile("" ::: "memory");
        if (tid < 256) { const float s1 = (xch[tid] + xch[256 + tid]) + (xch[512 + tid] + xch[768 + tid]), s2 = (xch[1024 + tid] + xch[1280 + tid]) + (xch[1536 + tid] + xch[1792 + tid]);
            __hip_atomic_store(xbuf + ((size_t)panel * 4 + pn) * 256 + tid, ((unsigned long long)__float_as_uint(s2) << 32) | (unsigned long long)__float_as_uint(s1), __ATOMIC_RELAXED, __HIP_MEMORY_SCOPE_AGENT); }
        asm volatile("s_waitcnt vmcnt(0)" ::: "memory"); __builtin_amdgcn_s_barrier(); asm volatile("" ::: "memory");
        if (tid == 0) { unsigned* cp = cnt + panel * 16; __hip_atomic_fetch_add(cp, 1u, __ATOMIC_RELAXED, __HIP_MEMORY_SCOPE_AGENT);
            unsigned sp = 0; while (__hip_atomic_load(cp, __ATOMIC_RELAXED, __HIP_MEMORY_SCOPE_AGENT) < 4u && ++sp < (1u << 22)) __builtin_amdgcn_s_sleep(1); }
        asm volatile("s_waitcnt vmcnt(0) lgkmcnt(0)" ::: "memory"); __builtin_amdgcn_s_barrier(); asm volatile("" ::: "memory");
        if (tid < 256) { float S1 = 0.f, S2 = 0.f;
#pragma unroll
            for (int j = 0; j < 4; ++j) { const unsigned long long x = __hip_atomic_load(xbuf + ((size_t)panel * 4 + j) * 256 + tid, __ATOMIC_RELAXED, __HIP_MEMORY_SCOPE_AGENT); S1 += __uint_as_float((unsigned)x); S2 += __uint_as_float((unsigned)(x >> 32)); }
            const float mean = S1 * (1.f / 1024.f); stats[2 * tid] = mean; stats[2 * tid + 1] = 1.f / sqrtf(fmaxf(S2 * (1.f / 1024.f) - mean * mean, 0.f) + LN_EPS); }
        LDS_WAIT(); __builtin_amdgcn_s_barrier(); asm volatile("" ::: "memory");
        unsigned e2 = e0; asm volatile("" : "+v"(e2));
        const int col2 = (int)(e2 & 1023u);
        if (ROUTE) {
            const bf16_t* rwh = (const bf16_t*)(ws + WS_RWS) + (size_t)l * 2 * 32 * 1024; const bf16_t* rwl = rwh + 32 * 1024;
            bf16x8 Bh[2][2], Bl[2][2]; f32x4 gv[2][2], bb[2][2];
#pragma unroll
            for (int bj = 0; bj < 2; ++bj) { gv[bj][0] = *(const f32x4*)(g + col2 + bj * 128); gv[bj][1] = *(const f32x4*)(g + col2 + bj * 128 + 4); bb[bj][0] = *(const f32x4*)(b + col2 + bj * 128); bb[bj][1] = *(const f32x4*)(b + col2 + bj * 128 + 4);
#pragma unroll
                for (int eb = 0; eb < 2; ++eb) { Bh[bj][eb] = *(const bf16x8*)(rwh + (size_t)(16 * eb + fr) * 1024 + col2 + bj * 128); Bl[bj][eb] = *(const bf16x8*)(rwl + (size_t)(16 * eb + fr) * 1024 + col2 + bj * 128); } }
            LAS float* plog = (LAS float*)sl;
#pragma unroll
            for (int ai = 0; ai < 2; ++ai)
#pragma unroll
                for (int m = 0; m < 4; ++m) { const int r = ai * 128 + wr * 64 + m * 16 + fr; const float mean = stats[2 * r], rstd = stats[2 * r + 1];
                    f32x4 L0 = (f32x4){0.f, 0.f, 0.f, 0.f}, L1 = (f32x4){0.f, 0.f, 0.f, 0.f};
#pragma unroll
                    for (int bj = 0; bj < 2; ++bj) { const unsigned eo = e2 + (unsigned)((ai * 128 + m * 16) * 1024 + bj * 128);
                        const f32x4 y0 = (acc[ai][bj][m][0] - mean) * rstd * gv[bj][0] + bb[bj][0], y1 = (acc[ai][bj][m][1] - mean) * rstd * gv[bj][1] + bb[bj][1];
                        if (WF32) { *(f32x4*)((char*)hf + (size_t)(eo * 4u)) = y0; *(f32x4*)((char*)hf + (size_t)(eo * 4u) + 16) = y1; }
                        u32x4 w; w.x = pk2(y0[0], y0[1]); w.y = pk2(y0[2], y0[3]); w.z = pk2(y1[0], y1[1]); w.w = pk2(y1[2], y1[3]); *(u32x4*)((char*)hb + (size_t)(eo * 2u)) = w;
                        u32x4 lo; lo.x = pk2(y0[0] - bflo(w.x), y0[1] - bfhi(w.x)); lo.y = pk2(y0[2] - bflo(w.y), y0[3] - bfhi(w.y)); lo.z = pk2(y1[0] - bflo(w.z), y1[1] - bfhi(w.z)); lo.w = pk2(y1[2] - bflo(w.w), y1[3] - bfhi(w.w));
                        const bf16x8 ah = __builtin_bit_cast(bf16x8, w), al = __builtin_bit_cast(bf16x8, lo);
                        L0 = __builtin_amdgcn_mfma_f32_16x16x32_bf16(ah, Bh[bj][0], L0, 0, 0, 0); L0 = __builtin_amdgcn_mfma_f32_16x16x32_bf16(ah, Bl[bj][0], L0, 0, 0, 0); L0 = __builtin_amdgcn_mfma_f32_16x16x32_bf16(al, Bh[bj][0], L0, 0, 0, 0);
                        L1 = __builtin_amdgcn_mfma_f32_16x16x32_bf16(ah, Bh[bj][1], L1, 0, 0, 0); L1 = __builtin_amdgcn_mfma_f32_16x16x32_bf16(ah, Bl[bj][1], L1, 0, 0, 0); L1 = __builtin_amdgcn_mfma_f32_16x16x32_bf16(al, Bh[bj][1], L1, 0, 0, 0); }
                    const int rt = wc * 256 + ai * 128 + wr * 64 + m * 16 + 4 * fq;
#pragma unroll
                    for (int j = 0; j < 4; ++j) { plog[(rt + j) * 32 + fr] = L0[j]; plog[(rt + j) * 32 + 16 + fr] = L1[j]; } }
            LDS_WAIT(); __builtin_amdgcn_s_barrier(); asm volatile("" ::: "memory");
            int t2 = tid; asm volatile("" : "+v"(t2));
            unsigned long long* xrt = (unsigned long long*)(ws + WS_XRT);
            { unsigned long long* dst = xrt + ((size_t)panel * 4 + pn) * 4096;
#pragma unroll
                for (int k = 0; k < 8; ++k) { const int o = (k * 512 + t2) * 2;
                    const f32x2 s = (*(const LAS f32x2*)(plog + o) + *(const LAS f32x2*)(plog + 8192 + o)) + (*(const LAS f32x2*)(plog + 16384 + o) + *(const LAS f32x2*)(plog + 24576 + o));
                    __hip_atomic_store(dst + k * 512 + t2, ((unsigned long long)__float_as_uint(s[1]) << 32) | (unsigned long long)__float_as_uint(s[0]), __ATOMIC_RELAXED, __HIP_MEMORY_SCOPE_AGENT); } }
            asm volatile("s_waitcnt vmcnt(0) lgkmcnt(0)" ::: "memory"); __builtin_amdgcn_s_barrier(); asm volatile("" ::: "memory");
            LAS int* lcnt = (LAS int*)sl; LAS int* lbase = lcnt + 32;
            if (t2 < 32) lcnt[t2] = 0;
            if (t2 == 0) { unsigned* cp = (unsigned*)(ws + WS_CTL) + CW_RT + (l * 64 + panel) * 16; __hip_atomic_fetch_add(cp, 1u, __ATOMIC_RELAXED, __HIP_MEMORY_SCOPE_AGENT);
                unsigned sp = 0; while (__hip_atomic_load(cp, __ATOMIC_RELAXED, __HIP_MEMORY_SCOPE_AGENT) < 4u && ++sp < (1u << 22)) __builtin_amdgcn_s_sleep(1); }
            asm volatile("s_waitcnt vmcnt(0) lgkmcnt(0)" ::: "memory"); __builtin_amdgcn_s_barrier(); asm volatile("" ::: "memory");
            const int rowl = t2 >> 3, sub = t2 & 7, e4 = sub * 4;
            float v[4]; v[0] = rbias[e4]; v[1] = rbias[e4 + 1]; v[2] = rbias[e4 + 2]; v[3] = rbias[e4 + 3];
#pragma unroll
            for (int j = 0; j < 4; ++j) { const unsigned long long* src = xrt + ((((size_t)panel * 4 + j) * 256 + pn * 64 + rowl) * 32 + e4) / 2;
                const unsigned long long x0 = __hip_atomic_load(src, __ATOMIC_RELAXED, __HIP_MEMORY_SCOPE_AGENT), x1 = __hip_atomic_load(src + 1, __ATOMIC_RELAXED, __HIP_MEMORY_SCOPE_AGENT);
                v[0] += __uint_as_float((unsigned)x0); v[1] += __uint_as_float((unsigned)(x0 >> 32)); v[2] += __uint_as_float((unsigned)x1); v[3] += __uint_as_float((unsigned)(x1 >> 32)); }
            int ti[4]; float tv[4];
#pragma unroll
            for (int k = 0; k < 4; ++k) { float best = v[0]; int bi = e4;
#pragma unroll
                for (int i = 1; i < 4; ++i) { const bool ok = v[i] > best; best = ok ? v[i] : best; bi = ok ? e4 + i : bi; }
#pragma unroll
                for (int d = 1; d < 8; d <<= 1) { const float ob = __shfl_xor(best, d); const int oi = __shfl_xor(bi, d); const bool tk = (ob > best) || (ob == best && oi < bi); best = tk ? ob : best; bi = tk ? oi : bi; }
                tv[k] = best; ti[k] = bi;
#pragma unroll
                for (int i = 0; i < 4; ++i) v[i] = (bi == e4 + i) ? -3.0e38f : v[i]; }
            const float ev1 = __expf(tv[1] - tv[0]), ev2 = __expf(tv[2] - tv[0]), ev3 = __expf(tv[3] - tv[0]);
            const float inv = 1.f / (1.f + ev1 + ev2 + ev3);
            const int myi = sub == 0 ? ti[0] : sub == 1 ? ti[1] : sub == 2 ? ti[2] : ti[3]; const float myg = (sub == 0 ? 1.f : sub == 1 ? ev1 : sub == 2 ? ev2 : ev3) * inv;
            int lr = 0; if (sub < 4) lr = (int)atomicAdd((unsigned*)(lcnt + myi), 1u);
            LDS_WAIT(); __builtin_amdgcn_s_barrier(); asm volatile("" ::: "memory");
            unsigned* ecnt = (unsigned*)(ws + WS_CTL) + CW_CNT + l * 32 * 16;
            if (t2 < 32) { const unsigned n = (unsigned)lcnt[t2]; lbase[t2] = n ? (int)atomicAdd(ecnt + t2 * 16, n) : 0; }
            asm volatile("s_waitcnt vmcnt(0) lgkmcnt(0)" ::: "memory"); __builtin_amdgcn_s_barrier(); asm volatile("" ::: "memory");
            if (sub < 4) { const int mm = u.row0 + pn * 64 + rowl; const int rk = lbase[myi] + lr;
                ((int*)(ws + WS_TOKE))[mm * 4 + sub] = myi; ((int*)(ws + WS_TOKR))[mm * 4 + sub] = rk; ((float*)(ws + WS_TOKG))[mm * 4 + sub] = myg; ((int*)(ws + WS_ELIST))[(size_t)myi * T_ + rk] = mm; }
        } else {
#pragma unroll
        for (int bj = 0; bj < 2; ++bj) { const f32x4 g0 = *(const f32x4*)(g + col2 + bj * 128), g1 = *(const f32x4*)(g + col2 + bj * 128 + 4), b0 = *(const f32x4*)(b + col2 + bj * 128), b1 = *(const f32x4*)(b + col2 + bj * 128 + 4);
#pragma unroll
            for (int ai = 0; ai < 2; ++ai)
#pragma unroll
                for (int m = 0; m < 4; ++m) { const int r = ai * 128 + wr * 64 + m * 16 + fr; const float mean = stats[2 * r], rstd = stats[2 * r + 1];
                    const unsigned eo = e2 + (unsigned)((ai * 128 + m * 16) * 1024 + bj * 128);
                    const f32x4 y0 = (acc[ai][bj][m][0] - mean) * rstd * g0 + b0, y1 = (acc[ai][bj][m][1] - mean) * rstd * g1 + b1;
                    if (WF32) { *(f32x4*)((char*)hf + (size_t)(eo * 4u)) = y0; *(f32x4*)((char*)hf + (size_t)(eo * 4u) + 16) = y1; }
                    u32x4 w; w.x = pk2(y0[0], y0[1]); w.y = pk2(y0[2], y0[3]); w.z = pk2(y1[0], y1[1]); w.w = pk2(y1[2], y1[3]); *(u32x4*)((char*)hb + (size_t)(eo * 2u)) = w; } }

        }
    }
};

struct EpiSoftmax {
    static constexpr bool PERM = true; static constexpr int SEG = 0;
    LAS float* xch;
    __device__ __forceinline__ void operator()(f32x4 (&acc)[2][2][4][2], const Unit& u, int wr, int wc, int fr, int fq) const {
        LAS float* xm = xch; LAS float* xs = xch + 1024;
#pragma unroll
        for (int ai = 0; ai < 2; ++ai)
#pragma unroll
            for (int m = 0; m < 4; ++m) {
                float v = -3.0e38f;
#pragma unroll
                for (int bj = 0; bj < 2; ++bj)
#pragma unroll
                    for (int n = 0; n < 2; ++n) { const f32x4 a = acc[ai][bj][m][n]; v = fmaxf(v, fmaxf(fmaxf(a[0], a[1]), fmaxf(a[2], a[3]))); }
                v = fmaxf(v, __shfl_xor(v, 16)); v = fmaxf(v, __shfl_xor(v, 32));
                if (fq == 0) xm[wc * 256 + ai * 128 + wr * 64 + m * 16 + fr] = v;
            }
        LDS_WAIT(); __builtin_amdgcn_s_barrier(); asm volatile("" ::: "memory");
#pragma unroll
        for (int ai = 0; ai < 2; ++ai)
#pragma unroll
            for (int m = 0; m < 4; ++m) {
                const int r = ai * 128 + wr * 64 + m * 16 + fr;
                const float M = fmaxf(fmaxf(xm[r], xm[256 + r]), fmaxf(xm[512 + r], xm[768 + r]));
                float s = 0.f;
#pragma unroll
                for (int bj = 0; bj < 2; ++bj)
#pragma unroll
                    for (int n = 0; n < 2; ++n) { f32x4 a = acc[ai][bj][m][n];
                        a[0] = __expf(a[0] - M); a[1] = __expf(a[1] - M); a[2] = __expf(a[2] - M); a[3] = __expf(a[3] - M);
                        acc[ai][bj][m][n] = a; s += (a[0] + a[1]) + (a[2] + a[3]); }
                s += __shfl_xor(s, 16); s += __shfl_xor(s, 32);
                if (fq == 0) xs[wc * 256 + r] = s;
            }
        LDS_WAIT(); __builtin_amdgcn_s_barrier(); asm volatile("" ::: "memory");
        bf16_t* base = (bf16_t*)u.c;
#pragma unroll
        for (int ai = 0; ai < 2; ++ai)
#pragma unroll
            for (int m = 0; m < 4; ++m) {
                const int r = ai * 128 + wr * 64 + m * 16 + fr;
                const float inv = 1.f / ((xs[r] + xs[256 + r]) + (xs[512 + r] + xs[768 + r]));
#pragma unroll
                for (int bj = 0; bj < 2; ++bj) { const f32x4 a0 = acc[ai][bj][m][0] * inv, a1 = acc[ai][bj][m][1] * inv;
                    u32x4 w; w.x = pk2(a0[0], a0[1]); w.y = pk2(a0[2], a0[3]); w.z = pk2(a1[0], a1[1]); w.w = pk2(a1[2], a1[3]);
                    *(u32x4*)(base + (size_t)r * u.ldc + bj * 128 + wc * 32 + 8 * fq) = w; }
            }
    }
};

struct EpiSwiGLU {
    static constexpr bool PERM = true; static constexpr int SEG = 0;
    const float* b1;
    __device__ __forceinline__ void operator()(f32x4 (&acc)[2][2][4][2], const Unit& u, int wr, int wc, int fr, int fq) const {
        bf16_t* base = (bf16_t*)u.c;
        const int colb = wc * 32 + 8 * fq;
        const float* bb = b1 + (size_t)u.aux * 2048 + u.col0 + colb;
        f32x4 bg[2], bl[2];
#pragma unroll
        for (int n = 0; n < 2; ++n) { bg[n] = *(const f32x4*)(bb + 4 * n); bl[n] = *(const f32x4*)(bb + 1024 + 4 * n); }
#pragma unroll
        for (int ai = 0; ai < 2; ++ai)
#pragma unroll
            for (int m = 0; m < 4; ++m) {
                float o[8];
#pragma unroll
                for (int n = 0; n < 2; ++n) {
                    const f32x4 gv = acc[ai][0][m][n] + bg[n], lv = acc[ai][1][m][n] + bl[n];
#pragma unroll
                    for (int e = 0; e < 4; ++e) { const float gg = fminf(gv[e], 7.0f), ll = fminf(fmaxf(lv[e], -7.0f), 7.0f); o[4 * n + e] = gg * sigmoidf_(1.702f * gg) * (ll + 1.0f); }
                }
                u32x4 w; w.x = pk2(o[0], o[1]); w.y = pk2(o[2], o[3]); w.z = pk2(o[4], o[5]); w.w = pk2(o[6], o[7]);
                *(u32x4*)(base + (size_t)(ai * 128 + wr * 64 + m * 16 + fr) * u.ldc + colb) = w;
            }
    }
};


struct EpiMoeX {
    static constexpr bool PERM = true; static constexpr int SEG = 0;
    const float* b1; const float* b2;
    __device__ __forceinline__ void operator()(f32x4 (&acc)[2][2][4][2], const Unit& u, int wr, int wc, int fr, int fq) const {
        if (u.kind) { EpiStoreBf16 E2{b2, 1.f}; E2(acc, u, wr, wc, fr, fq); return; }
        bf16_t* base = (bf16_t*)u.c;
        const int colb = wc * 32 + 8 * fq;
        const float* bb = b1 + (size_t)u.aux * 2048 + u.col0 + colb;
        f32x4 bg[2], bl[2];
#pragma unroll
        for (int n = 0; n < 2; ++n) { bg[n] = *(const f32x4*)(bb + 4 * n); bl[n] = *(const f32x4*)(bb + 1024 + 4 * n); }
#pragma unroll
        for (int ai = 0; ai < 2; ++ai)
#pragma unroll
            for (int m = 0; m < 4; ++m) {
                float o[8];
#pragma unroll
                for (int n = 0; n < 2; ++n) {
                    const f32x4 gv = acc[ai][0][m][n] + bg[n], lv = acc[ai][1][m][n] + bl[n];
#pragma unroll
                    for (int e = 0; e < 4; ++e) { const float gg = fminf(gv[e], 7.0f), ll = fminf(fmaxf(lv[e], -7.0f), 7.0f); o[4 * n + e] = gg * sigmoidf_(1.702f * gg) * (ll + 1.0f); }
                }
                u32x4 w; w.x = pk2(o[0], o[1]); w.y = pk2(o[2], o[3]); w.z = pk2(o[4], o[5]); w.w = pk2(o[6], o[7]);
                bf16_t* dst = base + (size_t)(ai * 128 + wr * 64 + m * 16 + fr) * u.ldc + colb;
                asm volatile("global_store_dwordx4 %0, %1, off sc1\n\ts_nop 1" :: "v"(dst), "v"(w) : "memory");
            }
    }
};
struct SchedInProj {
    static constexpr bool GATHER = false; static constexpr bool COUNTED = false;
    const char* A; const char* B; char* C; int G, c;
    __device__ __forceinline__ bool next(int i, Unit& u) const {
        const int L = i * G + c; if (L >= 64 * 36) return false;
        int pm, pn; pg8::swz_tile(L, 64, 36, pm, pn);
        u.a = A + (size_t)pm * 256 * 1024 * 2; u.b = B + (size_t)pn * 256 * 1024 * 2; u.c = C + ((size_t)pm * 256 * ZC + pn * 256) * 2;
        u.ldc = ZC; u.row0 = pm * 256; u.col0 = pn * 256; u.aux = (pn * 256 >= LR_COL) ? 16 : 0; return true;
    }
};
struct SchedKV {
    static constexpr bool GATHER = false; static constexpr bool COUNTED = false;
    const char* ws; int G, c;
    __device__ __forceinline__ bool next(int i, Unit& u) const {
        const int L = i * G + c; if (L >= NL_ * 32) return false;
        const int l = L >> 5, r = L & 31, pm = r >> 3, pn = r & 7;
        u.a = ws + WS_MEMB + (size_t)pm * 256 * 1024 * 2; u.b = ws + WS_W + (size_t)l * LW_END + LW_WKV + (size_t)pn * 256 * 1024 * 2;
        u.c = (char*)ws + WS_KMEM + (size_t)l * 2 * SZ_W1K + ((size_t)pm * 256 * 2048 + pn * 256) * 2; u.ldc = 2048; u.row0 = 0; u.col0 = 0; u.aux = 0; u.g0 = 0; u.g1 = 0; return true;
    }
};
struct SchedMq {
    static constexpr bool GATHER = false; static constexpr bool COUNTED = false;
    const char* ws; int G, c;
    __device__ __forceinline__ bool next(int i, Unit& u) const {
        const int L = i * G + c; if (L >= NL_ * 64) return false;
        const int l = L >> 6, r = L & 63, bb = r >> 4, hh = (r >> 2) & 3, pn = r & 3;
        u.a = ws + WS_KMEM + (size_t)l * 2 * SZ_W1K + ((size_t)bb * 256 * 2048 + hh * 256) * 2; u.b = ws + WS_W + (size_t)l * LW_END + LW_WQ + ((size_t)pn * 256 * 1024 + hh * 256) * 2;
        u.c = (char*)ws + WS_MQT + ((size_t)l * 4 + bb) * SZ_W1K + ((size_t)hh * 256 * 1024 + pn * 256) * 2; u.ldc = 1024; u.row0 = 0; u.col0 = 0; u.aux = 0; u.g0 = 0; u.g1 = 0; return true;
    }
};
struct SchedVw {
    static constexpr bool GATHER = false; static constexpr bool COUNTED = false;
    const char* ws; int G, c;
    __device__ __forceinline__ bool next(int i, Unit& u) const {
        const int L = i * G + c; if (L >= NL_ * 64) return false;
        const int l = L >> 6, r = L & 63, bb = r >> 4, hh = (r >> 2) & 3, pm = r & 3;
        u.a = ws + WS_W + (size_t)l * LW_END + LW_WO + ((size_t)pm * 256 * 1024 + hh * 256) * 2; u.b = ws + WS_KMEM + (size_t)l * 2 * SZ_W1K + ((size_t)bb * 256 * 2048 + 1024 + hh * 256) * 2;
        u.c = (char*)ws + WS_VWT + ((size_t)l * 4 + bb) * SZ_W1K + ((size_t)pm * 256 * 1024 + hh * 256) * 2; u.ldc = 1024; u.row0 = 0; u.col0 = 0; u.aux = 0; u.g0 = 0; u.g1 = 0; return true;
    }
};
struct SchedBranch {
    static constexpr bool GATHER = false; static constexpr bool COUNTED = false;
    const char* ys; const char* wbr; int G, c;
    __device__ __forceinline__ bool next(int i, Unit& u) const {
        const int L = i * G + c; if (L >= 256) return false;
        int pm, pn; pg8::swz_tile(L, 64, 4, pm, pn);
        u.a = ys + (size_t)pm * 256 * 2048 * 2; u.b = wbr + (size_t)pn * 256 * 2048 * 2; u.c = nullptr;
        u.ldc = 1024; u.row0 = pm * 256; u.col0 = pn * 256; u.aux = 0; return true;
    }
};
struct SchedSq {
    static constexpr bool GATHER = false; static constexpr bool COUNTED = false;
    const char* A; const char* B; char* C; int csz, G, c;
    __device__ __forceinline__ bool next(int i, Unit& u) const {
        const int L = i * G + c; if (L >= 256) return false;
        int pm, pn; pg8::swz_tile(L, 64, 4, pm, pn);
        u.a = A + (size_t)pm * 256 * 1024 * 2; u.b = B + (size_t)pn * 256 * 1024 * 2; u.c = C + ((size_t)pm * 256 * 1024 + pn * 256) * csz;
        u.ldc = 1024; u.row0 = pm * 256; u.col0 = pn * 256; u.aux = 0; return true;
    }
};
struct SchedXB {
    static constexpr bool GATHER = false; static constexpr bool COUNTED = false;
    const char* A; const char* B; char* C; int csz, G, c;
    __device__ __forceinline__ bool next(int i, Unit& u) const {
        const int L = i * G + c; if (L >= 256) return false;
        int pm, pn; pg8::swz_tile(L, 64, 4, pm, pn); const int bb = pm >> 4;
        u.a = A + (size_t)pm * 256 * 1024 * 2; u.b = B + (size_t)bb * SZ_W1K + (size_t)pn * 256 * 1024 * 2; u.c = C + ((size_t)pm * 256 * 1024 + pn * 256) * csz;
        u.ldc = 1024; u.row0 = pm * 256; u.col0 = pn * 256; u.aux = 0; u.g0 = 0; u.g1 = 0; return true;
    }
};
template <int NCOL, int BROWS  , int CW  , int AUXMUL  , bool GATH  >
struct SchedMoe {
    static constexpr bool GATHER = GATH; static constexpr bool COUNTED = false;
    const char* A; const char* B; char* C; const LAS int* tstart; const int* elist; int G, c;
    __device__ __forceinline__ bool next(int i, Unit& u) const {
        const int rtiles = tstart[32]; constexpr int CS = NCOL / 4;
        int rt, ct;
        if ((G & 7) == 0 && G >= 256) { const int x = c & 7, j = c >> 3, per = G >> 3;
            const int slot = i * per + j; const int st = (slot >> 5) * 8 + x, w = slot & 31;
            const int rg = st / CS, cs = st % CS; rt = rg * 8 + (w & 7); ct = cs * 4 + (w >> 3);
            if (rt >= rtiles) return false; }
        else { const int L = i * G + c; if (L >= rtiles * NCOL) return false; rt = L / NCOL; ct = L % NCOL; }
        const int e = tstart[(MISC_R2E - MISC_MOE) / 4 + rt];
        u.a = GATH ? A : A + (size_t)rt * 256 * 1024 * 2; u.b = B + ((size_t)e * BROWS + ct * 256) * 1024 * 2; u.c = C + ((size_t)rt * 256 * 1024 + ct * CW) * 2;
        u.ldc = 1024; u.row0 = rt * 256; u.col0 = ct * CW; u.aux = e * AUXMUL;
        u.g0 = e * T_ + (rt - tstart[e]) * 256; u.g1 = e * T_ + tstart[33 + e]; return true;
    }
    __device__ __forceinline__ unsigned rowoff(const Unit& u, int row) const { const int idx = u.g0 + row; const int tok = (idx < u.g1) ? elist[idx] : 0; return (unsigned)tok * 2048u; }
};

struct SchedMoeX {
    static constexpr bool GATHER = true; static constexpr bool COUNTED = true;
    const char* hb; const char* w1; const char* w2; char* act; char* ysl; const LAS int* tstart; const int* elist; unsigned* cnt; int G, c;
    __device__ __forceinline__ bool next(int i, Unit& u) const {
        const int rtiles = tstart[32], ng = (rtiles + 7) >> 3, nst1 = 2 * ng, rem = rtiles & 7;
        const int x = c & 7, j = c >> 3, rsub = j & 7, csub = j >> 3;
        int k = i;
        if (rem != 0 && rsub >= rem) {
            const int qa = nst1 - 2, qb = nst1 - 1, qc = nst1 + ng - 1;
            if ((qa & 7) == x && (qa >> 3) <= k) ++k;
            if ((qb & 7) == x && (qb >> 3) <= k) ++k;
            if ((qc & 7) == x && (qc >> 3) <= k) ++k; }
        const int q = 8 * k + x; if (q >= 3 * ng) return false;
        int rt, e;
        if (q < nst1) { const int rg = q >> 1, ct = (q & 1) * 4 + csub; rt = rg * 8 + rsub; e = tstart[(MISC_R2E - MISC_MOE) / 4 + rt];
            u.a = hb; u.b = w1 + ((size_t)e * 2048 + ct * 256) * 1024 * 2; u.c = act + ((size_t)rt * 256 * 1024 + ct * 128) * 2; u.col0 = ct * 128; u.aux = e; u.kind = 0; }
        else { const int rg = q - nst1, ct = csub; rt = rg * 8 + rsub; e = tstart[(MISC_R2E - MISC_MOE) / 4 + rt];
            u.a = act + (size_t)rt * 256 * 1024 * 2; u.b = w2 + ((size_t)e * 1024 + ct * 256) * 1024 * 2; u.c = ysl + ((size_t)rt * 256 * 1024 + ct * 256) * 2; u.col0 = ct * 256; u.aux = e * 1024; u.kind = 1; }
        u.ldc = 1024; u.row0 = rt * 256; u.g0 = e * T_ + (rt - tstart[e]) * 256; u.g1 = e * T_ + tstart[33 + e]; return true;
    }
    __device__ __forceinline__ unsigned rowoff(const Unit& u, int row) const {
        if (u.kind) return (unsigned)row * 2048u;
        const int idx = u.g0 + row; const int tok = (idx < u.g1) ? elist[idx] : 0; return (unsigned)tok * 2048u; }
    __device__ __forceinline__ int pending(const Unit& u) const { return u.kind ? -1 : (u.row0 >> 8); }
    __device__ __forceinline__ void publish(int rt, int lane) const { if (lane == 0) __hip_atomic_fetch_add(cnt + rt * 16, 1u, __ATOMIC_RELAXED, __HIP_MEMORY_SCOPE_AGENT); }
    __device__ __forceinline__ void a_ready(const Unit& u) const {
        if (u.kind == 0) return;
        if (threadIdx.x < 64) {
            const unsigned* cp = cnt + (u.row0 >> 8) * 16; unsigned sp = 0;
            while ((unsigned)__builtin_amdgcn_readfirstlane((int)__hip_atomic_load(cp, __ATOMIC_RELAXED, __HIP_MEMORY_SCOPE_AGENT)) < 64u && ++sp < (1u << 22)) __builtin_amdgcn_s_sleep(2);
            __builtin_amdgcn_fence(__ATOMIC_ACQUIRE, "agent");
            asm volatile("s_waitcnt vmcnt(0)" ::: "memory"); }
        asm volatile("" ::: "memory"); __builtin_amdgcn_s_barrier(); asm volatile("" ::: "memory");
    }
};
struct Ctx { int tid, lane, wave, G, bid; LAS unsigned char* lds; };
__device__ __forceinline__ Ctx relaunder(const Ctx& c0) { Ctx c = c0; int t_ = c0.tid; asm volatile("" : "+v"(t_)); c.tid = t_; c.lane = t_ & 63; c.wave = __builtin_amdgcn_readfirstlane(t_ >> 6); return c; }

template <bool WIDE = false>
__device__ __forceinline__ void ln_row_regs(f32x4 (&v)[4], const float* g, const float* b, int lane, float* of32, bf16_t* obf) {
    float s = 0.f;
#pragma unroll
    for (int j = 0; j < 4; ++j) s += (v[j][0] + v[j][1]) + (v[j][2] + v[j][3]);
    const float mean = wave_sum(s) * (1.f / 1024.f); float s2 = 0.f;
#pragma unroll
    for (int j = 0; j < 4; ++j) { v[j] = v[j] - mean; s2 += (v[j][0] * v[j][0] + v[j][1] * v[j][1]) + (v[j][2] * v[j][2] + v[j][3] * v[j][3]); }
    const float rstd = 1.f / sqrtf(wave_sum(s2) * (1.f / 1024.f) + LN_EPS);
#pragma unroll
    for (int j = 0; j < 4; ++j) { const int col = WIDE ? 8 * lane + 4 * (j & 1) + 512 * (j >> 1) : 4 * lane + 256 * j;
        const f32x4 gg = *(const f32x4*)(g + col), bb = *(const f32x4*)(b + col);
        v[j] = v[j] * rstd * gg + bb;
        if (of32) *(f32x4*)(of32 + col) = v[j];
        if (obf && !WIDE) { u32x2 w; w.x = pk2(v[j][0], v[j][1]); w.y = pk2(v[j][2], v[j][3]); *(u32x2*)(obf + col) = w; }
    }
    if (obf && WIDE) {
#pragma unroll
        for (int jj = 0; jj < 2; ++jj) { u32x4 w; w.x = pk2(v[2 * jj][0], v[2 * jj][1]); w.y = pk2(v[2 * jj][2], v[2 * jj][3]); w.z = pk2(v[2 * jj + 1][0], v[2 * jj + 1][1]); w.w = pk2(v[2 * jj + 1][2], v[2 * jj + 1][3]);
            *(u32x4*)(obf + 8 * lane + 512 * jj) = w; } }
}
__device__ __forceinline__ void ln_rows_phase(const Ctx& c, const float* src, const float* g, const float* b, float* of32, bf16_t* obf) {
    const int gw = c.bid * 8 + c.wave, NGW = c.G * 8;
    for (int m = gw; m < T_; m += NGW) {
        f32x4 v[4];
#pragma unroll
        for (int j = 0; j < 4; ++j) v[j] = *(const f32x4*)(src + (size_t)m * 1024 + 4 * c.lane + 256 * j);
        ln_row_regs(v, g, b, c.lane, of32 ? of32 + (size_t)m * 1024 : nullptr, obf ? obf + (size_t)m * 1024 : nullptr);
    }
}

__device__ __forceinline__ void cvt_item(const float* W, int ldw, int k0, int nsrc, bf16_t* WT, int ldt, int ndst, LAS float* scr, int lane) {
    const int cq = lane & 15, kr = lane >> 4;
    f32x4 v[16];
#pragma unroll
    for (int i = 0; i < 16; ++i) v[i] = __builtin_nontemporal_load((const f32x4*)(W + (size_t)(k0 + kr + 4 * i) * ldw + nsrc + 4 * cq));
#pragma unroll
    for (int i = 0; i < 16; ++i) { LAS float* s = scr + (kr + 4 * i) * 65 + 4 * cq; s[0] = v[i][0]; s[1] = v[i][1]; s[2] = v[i][2]; s[3] = v[i][3]; }
    LDS_WAIT();
    const int ch = lane & 7;
#pragma unroll
    for (int j = 0; j < 8; ++j) { const int n = (lane >> 3) + 8 * j; const LAS float* s = scr + (8 * ch) * 65 + n;
        u32x4 o; o.x = pk2(s[0], s[65]); o.y = pk2(s[2 * 65], s[3 * 65]); o.z = pk2(s[4 * 65], s[5 * 65]); o.w = pk2(s[6 * 65], s[7 * 65]);
        *(u32x4*)(WT + (size_t)(ndst + n) * ldt + k0 + 8 * ch) = o; }
    LDS_WAIT();
}

__device__ __forceinline__ void ph_prologue(const Ctx& c, KP p) {
    unsigned char* ws = p->ws;
    ln_rows_phase(c, p->in[I_X], p->in[I_LN0G], p->in[I_LN0B], (c.G == 256) ? nullptr : (float*)(ws + WS_H), (bf16_t*)(ws + WS_HB));
    { const float* mem = p->in[I_MEM]; bf16_t* mb = (bf16_t*)(ws + WS_MEMB);
      for (int i = c.bid * 512 + c.tid; i < 1024 * 1024 / 4; i += c.G * 512) { const f32x4 v = *(const f32x4*)(mem + 4 * (size_t)i); u32x2 w; w.x = pk2(v[0], v[1]); w.y = pk2(v[2], v[3]); *(u32x2*)(mb + 4 * (size_t)i) = w; } }
    { bf16_t* lgw = (bf16_t*)(ws + WS_LGW);
      for (int i = c.bid * 512 + c.tid; i < NL_ * 2 * 8 * 64 * 64; i += c.G * 512) { const int k = i & 63, d = (i >> 6) & 63, n = (i >> 12) & 7, g = (i >> 15) & 1, l = i >> 16;
          lgw[i] = (bf16_t)f2bf((g ? p->in[I_LWX] : p->in[I_LWA])[(((size_t)l * 8 + n) * 64 + k) * 64 + d]); }
      for (int i = c.bid * 512 + c.tid; i < NL_ * 1024 * 1024 / 4; i += c.G * 512) { const int l = i >> 18, o = (i & 262143) * 4;
          const f32x4 v = *(const f32x4*)(p->in[I_WQ] + (size_t)l * 1024 * 1024 + o); u32x2 w; w.x = pk2(v[0], v[1]); w.y = pk2(v[2], v[3]); *(u32x2*)((bf16_t*)(ws + WS_W + (size_t)l * LW_END + LW_WQ) + o) = w; }
      { bf16_t* rws = (bf16_t*)(ws + WS_RWS);
        for (int i = c.bid * 512 + c.tid; i < NL_ * 32 * 1024; i += c.G * 512) { const int k = i & 1023, e = (i >> 10) & 31, l = i >> 15;
            const float w = p->in[I_RW][((size_t)l * 1024 + k) * 32 + e]; const unsigned hi = f2bf(w);
            rws[((size_t)l * 2 * 32 + e) * 1024 + k] = (bf16_t)hi; rws[((size_t)l * 2 * 32 + 32 + e) * 1024 + k] = (bf16_t)f2bf(w - bf2f(hi)); } }
      bf16_t* wlr = (bf16_t*)(ws + WS_WLR);
      for (int i = c.bid * 512 + c.tid; i < NL_ * 16 * 1024; i += c.G * 512) { const int k = i & 1023, j = (i >> 10) & 15, l = i >> 14;
          wlr[i] = (bf16_t)f2bf(p->in[I_WIN][((size_t)l * 1024 + k) * INC + LR_COL + j]); } }
    LAS float* scr = (LAS float*)(c.lds) + c.wave * (64 * 65);
    const int gw = c.bid * 8 + c.wave, NGW = c.G * 8;
    constexpr int I_IN = 16 * 144, I_BR = 4 * 8 * 16, I_SQ = 16 * 16, I_M1 = 32 * 16 * 32, I_M2 = 32 * 16 * 16;
    constexpr int PER_L = I_IN + I_BR + 4 * I_SQ + I_M1 + I_M2;
    for (int it = gw; it < NL_ * PER_L; it += NGW) {
        const int l = it / PER_L; int r = it % PER_L;
        unsigned char* lw = ws + WS_W + (size_t)l * LW_END;
        if (r < I_IN) { const int kb = r % 16, nb = r / 16, d0 = nb * 64;
            cvt_item(p->in[I_WIN] + (size_t)l * 1024 * INC, INC, kb * 64, d0 + (d0 >= LR_COL ? 16 : 0), (bf16_t*)(lw + LW_WIN), 1024, d0, scr, c.lane); continue; }
        r -= I_IN;
        if (r < I_BR) { const int br = r / 128, q = r % 128, kb = q % 8, nb = q / 8;
            cvt_item(p->in[I_WBR] + ((size_t)l * 4 + br) * 512 * 1024, 1024, kb * 64, nb * 64, (bf16_t*)(lw + LW_WBR) + br * 512, 2048, nb * 64, scr, c.lane); continue; }
        r -= I_BR;
        if (r < 4 * I_SQ) { const int w = r / I_SQ, q = r % I_SQ, kb = q % 16, nb = q / 16;
            const float* src = (w == 0 ? p->in[I_WOUT] : w == 1 ? p->in[I_WK] : w == 2 ? p->in[I_WV] : p->in[I_WO]) + (size_t)l * 1024 * 1024;
            bf16_t* dst = (bf16_t*)(lw + (w == 0 ? LW_WOUT : w == 1 ? LW_WKV : w == 2 ? LW_WKV + SZ_W1K : LW_WO));
            cvt_item(src, 1024, kb * 64, nb * 64, dst, 1024, nb * 64, scr, c.lane); continue; }
        r -= 4 * I_SQ;
        if (r < I_M1) { const int e = r / 512, q = r % 512, kb = q % 16, nb = q / 16, d0 = nb * 64, j = d0 >> 8, ii = d0 & 255;
            const int nsrc = (ii < 128) ? (128 * j + ii) : (1024 + 128 * j + (ii - 128));
            cvt_item(p->in[I_W1] + ((size_t)l * 32 + e) * 1024 * 2048, 2048, kb * 64, nsrc, (bf16_t*)(lw + LW_W1) + (size_t)e * 2048 * 1024, 1024, d0, scr, c.lane); continue; }
        r -= I_M1;
        { const int e = r / 256, q = r % 256, kb = q % 16, nb = q / 16;
            cvt_item(p->in[I_W2] + ((size_t)l * 32 + e) * 1024 * 1024, 1024, kb * 64, nb * 64, (bf16_t*)(lw + LW_W2) + (size_t)e * 1024 * 1024, 1024, nb * 64, scr, c.lane); }
    }
}

__device__ __forceinline__ void ph_conv_a(const Ctx& c0, KP p, int l, int item) {
    const Ctx c = relaunder(c0);
    const bf16_t* z = (const bf16_t*)(p->ws + WS_Z); bf16_t* ys = (bf16_t*)(p->ws + WS_YS);
    const int b = item >> 6, t0 = (item & 63) * 64; const size_t rb = (size_t)b * SEQ_;
    LAS bf16_t* ub = (LAS bf16_t*)c.lds;
    LAS float* red = (LAS float*)(c.lds + 96256);
    LAS float* yb = (LAS float*)(c.lds + 96512);
    { const int cg = c.tid & 63;
#pragma unroll 6
      for (int r = c.tid >> 6; r < 94; r += 8) { const int t = t0 - 30 + r; u32x4 o = (u32x4){0u, 0u, 0u, 0u};
          if (t >= 0) { const u32x4 va = *(const u32x4*)(z + (rb + t) * ZC + Z_AVAL + 8 * cg), vg = *(const u32x4*)(z + (rb + t) * ZC + Z_AGATE + 8 * cg);
              o.x = pk2(bflo(va.x) * sigmoidf_(bflo(vg.x)), bfhi(va.x) * sigmoidf_(bfhi(vg.x))); o.y = pk2(bflo(va.y) * sigmoidf_(bflo(vg.y)), bfhi(va.y) * sigmoidf_(bfhi(vg.y)));
              o.z = pk2(bflo(va.z) * sigmoidf_(bflo(vg.z)), bfhi(va.z) * sigmoidf_(bfhi(vg.z))); o.w = pk2(bflo(va.w) * sigmoidf_(bflo(vg.w)), bfhi(va.w) * sigmoidf_(bfhi(vg.w))); }
          *(LAS u32x4*)(ub + r * 512 + 8 * cg) = o; } }
    const int ch = c.tid;
    float w[31];
#pragma unroll
    for (int j = 0; j < 31; ++j) w[j] = p->in[I_CAW][((size_t)l * 31 + j) * 512 + ch];
    const float cb = p->in[I_CAB][l * 512 + ch], lg = p->in[I_LNAG][l * 512 + ch], lb = p->in[I_LNAB][l * 512 + ch];
    __syncthreads();
    for (int g = 0; g < 4; ++g) {
        float u[46];
#pragma unroll
        for (int r = 0; r < 46; ++r) u[r] = bf2f(ub[(16 * g + r) * 512 + ch]);
        float y[16];
#pragma unroll
        for (int i = 0; i < 16; ++i) { float a = cb;
#pragma unroll
            for (int j = 0; j < 31; ++j) a += w[j] * u[i + j];
            y[i] = a; }
#pragma unroll
        for (int i = 0; i < 16; ++i) yb[i * 512 + ch] = y[i];
        __syncthreads();
#pragma unroll
        for (int h2 = 0; h2 < 2; ++h2) { const int tk = c.wave + 8 * h2;
          const f32x4 a0 = *(const LAS f32x4*)(yb + tk * 512 + 8 * c.lane), a1 = *(const LAS f32x4*)(yb + tk * 512 + 8 * c.lane + 4);
          float s1 = ((a0[0] + a0[1]) + (a0[2] + a0[3])) + ((a1[0] + a1[1]) + (a1[2] + a1[3]));
          float s2 = ((a0[0] * a0[0] + a0[1] * a0[1]) + (a0[2] * a0[2] + a0[3] * a0[3])) + ((a1[0] * a1[0] + a1[1] * a1[1]) + (a1[2] * a1[2] + a1[3] * a1[3]));
          s1 = wave_sum(s1); s2 = wave_sum(s2);
          if (c.lane == 0) { const float mean = s1 * (1.f / 512.f); red[tk * 2] = mean; red[tk * 2 + 1] = 1.f / sqrtf(fmaxf(s2 * (1.f / 512.f) - mean * mean, 0.f) + LN_EPS); } }
        __syncthreads();
#pragma unroll
        for (int i = 0; i < 16; ++i) { const float v = (y[i] - red[2 * i]) * red[2 * i + 1] * lg + lb;
            ys[(rb + t0 + 16 * g + i) * 2048 + ch] = (bf16_t)f2bf(v * sigmoidf_(v)); }
    }
    __syncthreads();
}

__device__ __forceinline__ float gelu_tanh(float x) { const float u = 0.7978845608028654f * (x + 0.044715f * x * x * x); const float e = __expf(2.f * u); return 0.5f * x * (2.f - 2.f * __builtin_amdgcn_rcpf(e + 1.f)); }
template <int MODE>
__device__ __forceinline__ void ph_lru(const Ctx& c0, KP p, int l, int item) {
    const Ctx c = relaunder(c0);
    const bf16_t* z = (const bf16_t*)(p->ws + WS_Z); bf16_t* ys = (bf16_t*)(p->ws + WS_YS);
    float* lagg = (float*)(p->ws + WS_LAGG);
    const int b = item >> 6, tile = item & 63, t0 = tile * 64; const size_t rb = (size_t)b * SEQ_;
    LAS bf16_t* xc = (LAS bf16_t*)c.lds;
    LAS bf16_t* dg = (LAS bf16_t*)(c.lds + 66560);
    { const int cg = c.tid & 63, tr = c.tid >> 6;
      f32x4 cw[4][2], cbv[2];
#pragma unroll
      for (int j = 0; j < 4; ++j) { cw[j][0] = *(const f32x4*)(p->in[I_CDW] + ((size_t)l * 4 + j) * 512 + 8 * cg); cw[j][1] = *(const f32x4*)(p->in[I_CDW] + ((size_t)l * 4 + j) * 512 + 8 * cg + 4); }
      cbv[0] = *(const f32x4*)(p->in[I_CDB] + l * 512 + 8 * cg); cbv[1] = *(const f32x4*)(p->in[I_CDB] + l * 512 + 8 * cg + 4);
      u32x4 xr[11]; u32x4 gr[8];
#pragma unroll
      for (int i = 0; i < 11; ++i) { const int t = t0 + tr * 8 - 3 + i; xr[i] = (t >= 0) ? *(const u32x4*)(z + (rb + t) * ZC + Z_DX + 8 * cg) : (u32x4){0u, 0u, 0u, 0u}; }
      if (MODE == 3) {
#pragma unroll
          for (int i = 0; i < 8; ++i) gr[i] = *(const u32x4*)(z + (rb + t0 + tr * 8 + i) * ZC + Z_DG + 8 * cg); }
#pragma unroll
      for (int i = 0; i < 8; ++i) { f32x4 a0 = cbv[0], a1 = cbv[1];
#pragma unroll
          for (int j = 0; j < 4; ++j) { const u32x4 x = xr[i + j];
              a0 += cw[j][0] * (f32x4){bflo(x.x), bfhi(x.x), bflo(x.y), bfhi(x.y)}; a1 += cw[j][1] * (f32x4){bflo(x.z), bfhi(x.z), bflo(x.w), bfhi(x.w)}; }
          u32x4 o; o.x = pk2(a0[0], a0[1]); o.y = pk2(a0[2], a0[3]); o.z = pk2(a1[0], a1[1]); o.w = pk2(a1[2], a1[3]);
          *(LAS u32x4*)(xc + (tr * 8 + i) * 520 + 8 * cg) = o;
          if (MODE == 3) *(LAS u32x4*)(dg + (tr * 8 + i) * 520 + 8 * cg) = gr[i]; } }
    const int n = c.wave, r = c.lane & 15, q = c.lane >> 4;
    bf16x8 wfa[4][2], wfx[4][2];
    { const bf16_t* gw = (const bf16_t*)(p->ws + WS_LGW) + ((size_t)l * 2 * 8 + n) * 4096;
#pragma unroll
      for (int cb = 0; cb < 4; ++cb)
#pragma unroll
          for (int ks = 0; ks < 2; ++ks) { wfa[cb][ks] = *(const bf16x8*)(gw + (16 * cb + r) * 64 + 32 * ks + 8 * q); wfx[cb][ks] = *(const bf16x8*)(gw + 8 * 4096 + (16 * cb + r) * 64 + 32 * ks + 8 * q); } }
    float ba[4], bx[4], ls[4], hst[4], Atot[4];
#pragma unroll
    for (int cb = 0; cb < 4; ++cb) { const int ch = 64 * n + 16 * cb + r; ba[cb] = p->in[I_LBA][l * 512 + ch]; bx[cb] = p->in[I_LBX][l * 512 + ch];
        ls[cb] = -8.0f * softplusf_(-p->in[I_LLAM][l * 512 + ch]);
        hst[cb] = (MODE == 3) ? lagg[(size_t)2 * 4 * 64 * 512 + ((size_t)b * 64 + tile) * 512 + ch] : 0.f; Atot[cb] = 1.f; }
    __syncthreads();
    for (int rbk = 0; rbk < 4; ++rbk) {
        const bf16x8 af0 = *(const LAS bf16x8*)(xc + (16 * rbk + r) * 520 + 64 * n + 8 * q), af1 = *(const LAS bf16x8*)(xc + (16 * rbk + r) * 520 + 64 * n + 32 + 8 * q);
#pragma unroll
        for (int cb = 0; cb < 4; ++cb) {
            f32x4 pr = __builtin_amdgcn_mfma_f32_16x16x32_bf16(af0, wfa[cb][0], (f32x4){0.f, 0.f, 0.f, 0.f}, 0, 0, 0); pr = __builtin_amdgcn_mfma_f32_16x16x32_bf16(af1, wfa[cb][1], pr, 0, 0, 0);
            f32x4 pi = __builtin_amdgcn_mfma_f32_16x16x32_bf16(af0, wfx[cb][0], (f32x4){0.f, 0.f, 0.f, 0.f}, 0, 0, 0); pi = __builtin_amdgcn_mfma_f32_16x16x32_bf16(af1, wfx[cb][1], pi, 0, 0, 0);
            const int chl = 64 * n + 16 * cb + r;
            float a[4], u[4];
#pragma unroll
            for (int j = 0; j < 4; ++j) { const float xv = bf2f(xc[(16 * rbk + 4 * q + j) * 520 + chl]);
                const float rr = sigmoidf_(pr[j] + ba[cb]), ig = sigmoidf_(pi[j] + bx[cb]);
                const float aa = __expf(rr * ls[cb]); a[j] = aa; u[j] = sqrtf(fmaxf(1.f - aa * aa, 0.f)) * (ig * xv); }
            const float Aloc = (a[0] * a[1]) * (a[2] * a[3]), Hloc = ((u[0] * a[1] + u[1]) * a[2] + u[2]) * a[3] + u[3];
            const float A1 = __shfl_xor(Aloc, 16), A2 = __shfl_xor(Aloc, 32), A3 = __shfl_xor(Aloc, 48), H1 = __shfl_xor(Hloc, 16), H2 = __shfl_xor(Hloc, 32), H3 = __shfl_xor(Hloc, 48);
            float h = hst[cb], hstart = h, At = 1.f;
#pragma unroll
            for (int qq = 0; qq < 4; ++qq) { const int idx = qq ^ q;
                const float Ag = (idx == 0) ? Aloc : (idx == 1) ? A1 : (idx == 2) ? A2 : A3, Hg = (idx == 0) ? Hloc : (idx == 1) ? H1 : (idx == 2) ? H2 : H3;
                hstart = (qq == q) ? h : hstart; h = Ag * h + Hg; At *= Ag; }
            hst[cb] = h; Atot[cb] *= At;
            if (MODE == 3) { float hh = hstart;
#pragma unroll
                for (int j = 0; j < 4; ++j) { hh = a[j] * hh + u[j]; LAS bf16_t* dp = dg + (16 * rbk + 4 * q + j) * 520 + chl; *dp = (bf16_t)f2bf(hh * gelu_tanh(bf2f(*dp))); } }
        }
    }
    if (MODE == 1) { if (q == 0) {
#pragma unroll
        for (int cb = 0; cb < 4; ++cb) { const int ch = 64 * n + 16 * cb + r; lagg[((size_t)b * 64 + tile) * 512 + ch] = Atot[cb]; lagg[(size_t)4 * 64 * 512 + ((size_t)b * 64 + tile) * 512 + ch] = hst[cb]; } } }
    if (MODE == 3) { __syncthreads();
        const int cg = c.tid & 63, tr = c.tid >> 6;
#pragma unroll
        for (int i = 0; i < 8; ++i) *(u32x4*)(ys + (rb + t0 + tr * 8 + i) * 2048 + 1536 + 8 * cg) = *(const LAS u32x4*)(dg + (tr * 8 + i) * 520 + 8 * cg); }
    __syncthreads();
}
__device__ __forceinline__ void ph_lru_carry(const Ctx& c, KP p) {
    float* lagg = (float*)(p->ws + WS_LAGG);
    for (int g = c.bid * 512 + c.tid; g < 4 * 512; g += c.G * 512) { const int b = g >> 9, ch = g & 511; float s = 0.f;
        for (int j0 = 0; j0 < 64; j0 += 16) { float av[16], hv[16];
#pragma unroll
            for (int j = 0; j < 16; ++j) { const size_t o = ((size_t)b * 64 + j0 + j) * 512 + ch; av[j] = lagg[o]; hv[j] = lagg[(size_t)4 * 64 * 512 + o]; }
#pragma unroll
            for (int j = 0; j < 16; ++j) { const size_t o = ((size_t)b * 64 + j0 + j) * 512 + ch; lagg[(size_t)2 * 4 * 64 * 512 + o] = s; s = av[j] * s + hv[j]; } } }
}

__device__ __forceinline__ void ph_gla1(const Ctx& c0, KP p, int l, int item) {
    const Ctx c = relaunder(c0);
    const bf16_t* z = (const bf16_t*)(p->ws + WS_Z); const bf16_t* hb = (const bf16_t*)(p->ws + WS_HB);
    float* bcum = (float*)(p->ws + WS_BCUM); float* kvst = (float*)(p->ws + WS_KVST);
    const int b = item >> 6, ck = item & 63; const size_t r0 = (size_t)b * SEQ_ + ck * 64;
    LAS float* lrp = (LAS float*)c.lds;
    LAS float* lrs = (LAS float*)(c.lds + 8192);
    LAS float* tot = (LAS float*)(c.lds + 8192);
    LAS float* bcs = (LAS float*)(c.lds + 12288);
    LAS bf16_t* keT = (LAS bf16_t*)(c.lds + 77824);
    LAS bf16_t* vT = (LAS bf16_t*)(c.lds + 96256);
    const int r = c.lane & 15, q = c.lane >> 4;
    u32x4 nkv[2], nvv[2][2];
#define GLA1_LOAD(hp_) do { const int t_ = c.tid >> 3, k0_ = (c.tid & 7) * 8, v0_ = (c.tid & 7) * 16; \
        _Pragma("unroll") for (int h2_ = 0; h2_ < 2; ++h2_) { const int hh_ = 2 * (hp_) + h2_; nkv[h2_] = *(const u32x4*)(z + (r0 + t_) * ZC + Z_BK + hh_ * 64 + k0_); \
            nvv[h2_][0] = *(const u32x4*)(z + (r0 + t_) * ZC + Z_BV + hh_ * 128 + v0_); nvv[h2_][1] = *(const u32x4*)(z + (r0 + t_) * ZC + Z_BV + hh_ * 128 + v0_ + 8); } } while (0)
    GLA1_LOAD(0);
    { const int rbk = c.wave & 3, kh = c.wave >> 2;
      const bf16_t* ap = hb + (r0 + 16 * rbk + r) * 1024 + 512 * kh + 8 * q; const bf16_t* bp = (const bf16_t*)(p->ws + WS_WLR) + ((size_t)l * 16 + r) * 1024 + 512 * kh + 8 * q;
      f32x4 acc = (f32x4){0.f, 0.f, 0.f, 0.f};
#pragma unroll 8
      for (int ks = 0; ks < 16; ++ks) acc = __builtin_amdgcn_mfma_f32_16x16x32_bf16(*(const bf16x8*)(ap + 32 * ks), *(const bf16x8*)(bp + 32 * ks), acc, 0, 0, 0);
#pragma unroll
      for (int j = 0; j < 4; ++j) lrp[(kh * 64 + 16 * rbk + 4 * q + j) * 16 + r] = acc[j]; }
    __syncthreads();
    { const float* bi = p->in[I_BIN] + (size_t)l * INC + LR_COL;
      for (int i = c.tid; i < 1024; i += 512) lrs[i] = lrp[i] + lrp[1024 + i] + bi[i & 15]; }
    __syncthreads();
    { const int n = c.tid & 255, th = c.tid >> 8; float w2[16];
#pragma unroll
      for (int j = 0; j < 16; ++j) w2[j] = p->in[I_WA2][((size_t)l * 16 + j) * 256 + n];
      const float ba = p->in[I_GBA][l * 256 + n]; float cum = 0.f;
      for (int t = 32 * th; t < 32 * th + 32; ++t) { float pre = ba;
#pragma unroll
          for (int j4 = 0; j4 < 4; ++j4) { const f32x4 lv = *(const LAS f32x4*)(lrs + t * 16 + 4 * j4); pre += lv[0] * w2[4 * j4] + lv[1] * w2[4 * j4 + 1] + lv[2] * w2[4 * j4 + 2] + lv[3] * w2[4 * j4 + 3]; }
          cum += -softplusf_(-pre) * (1.f / 16.f);
          bcs[t * 256 + n] = cum; }
      __syncthreads();
      if (th == 0) tot[n] = cum;
      __syncthreads();
      if (th == 1) { const float a = tot[n]; for (int t = 32; t < 64; ++t) bcs[t * 256 + n] += a; }
      __syncthreads();
      for (int t = 32 * th; t < 32 * th + 32; ++t) bcum[(r0 + t) * 256 + n] = bcs[t * 256 + n]; }
    for (int hp = 0; hp < 2; ++hp) {
        { const int t = c.tid >> 3, k0 = (c.tid & 7) * 8, v0 = (c.tid & 7) * 16;
#pragma unroll
          for (int h2 = 0; h2 < 2; ++h2) { const int hh = 2 * hp + h2;
              const u32x4 kv = nkv[h2]; const unsigned kw[4] = {kv.x, kv.y, kv.z, kv.w};
#pragma unroll
              for (int e = 0; e < 4; ++e) { const int kk = hh * 64 + k0 + 2 * e;
                  keT[(h2 * 64 + k0 + 2 * e) * 72 + t] = (bf16_t)f2bf(bflo(kw[e]) * __expf(bcs[63 * 256 + kk] - bcs[t * 256 + kk]));
                  keT[(h2 * 64 + k0 + 2 * e + 1) * 72 + t] = (bf16_t)f2bf(bfhi(kw[e]) * __expf(bcs[63 * 256 + kk + 1] - bcs[t * 256 + kk + 1])); }
#pragma unroll
              for (int qq = 0; qq < 2; ++qq) { const u32x4 vv = nvv[h2][qq]; const unsigned vw[4] = {vv.x, vv.y, vv.z, vv.w};
#pragma unroll
                  for (int e = 0; e < 4; ++e) { vT[(h2 * 128 + v0 + 8 * qq + 2 * e) * 72 + t] = (bf16_t)(vw[e] & 0xffffu); vT[(h2 * 128 + v0 + 8 * qq + 2 * e + 1) * 72 + t] = (bf16_t)(vw[e] >> 16); } } } }
        __syncthreads();
        if (hp == 0) GLA1_LOAD(1);
        { const int h2 = c.wave >> 2, rbk = c.wave & 3, hh = 2 * hp + h2;
          const bf16x8 a0 = *(const LAS bf16x8*)(keT + (h2 * 64 + 16 * rbk + r) * 72 + 8 * q), a1 = *(const LAS bf16x8*)(keT + (h2 * 64 + 16 * rbk + r) * 72 + 32 + 8 * q);
          float* dst = kvst + ((((size_t)b * 64 + ck) * 4 + hh) * 64 + 16 * rbk + 4 * q) * 128 + r;
#pragma unroll
          for (int cb = 0; cb < 8; ++cb) {
              const bf16x8 b0 = *(const LAS bf16x8*)(vT + (h2 * 128 + 16 * cb + r) * 72 + 8 * q), b1 = *(const LAS bf16x8*)(vT + (h2 * 128 + 16 * cb + r) * 72 + 32 + 8 * q);
              f32x4 d = __builtin_amdgcn_mfma_f32_16x16x32_bf16(a0, b0, (f32x4){0.f, 0.f, 0.f, 0.f}, 0, 0, 0); d = __builtin_amdgcn_mfma_f32_16x16x32_bf16(a1, b1, d, 0, 0, 0);
#pragma unroll
              for (int j = 0; j < 4; ++j) dst[(size_t)j * 128 + 16 * cb] = d[j]; } }
        __syncthreads();
    }
}
__device__ __forceinline__ void ph_gla2(const Ctx& c, KP p) {
    const float* bcum = (const float*)(p->ws + WS_BCUM); const float* kvst = (const float*)(p->ws + WS_KVST); bf16_t* sprev = (bf16_t*)(p->ws + WS_SPREV);
    for (int g = c.bid * 512 + c.tid; g < 4 * 4 * 64 * 128; g += c.G * 512) {
        const int v = g & 127, k = (g >> 7) & 63, hh = (g >> 13) & 3, b = g >> 15; float s = 0.f;
        for (int c0 = 0; c0 < 64; c0 += 16) { float kv[16], dc[16];
#pragma unroll
            for (int j = 0; j < 16; ++j) { const int ck = c0 + j; kv[j] = kvst[((((size_t)b * 64 + ck) * 4 + hh) * 64 + k) * 128 + v]; dc[j] = bcum[((size_t)b * SEQ_ + ck * 64 + 63) * 256 + hh * 64 + k]; }
#pragma unroll
            for (int j = 0; j < 16; ++j) { const int ck = c0 + j; sprev[((((size_t)b * 64 + ck) * 4 + hh) * 64 + k) * 128 + v] = (bf16_t)f2bf(s); s = __expf(dc[j]) * s + kv[j]; } }
    }
}
__device__ __forceinline__ void ph_gla3(const Ctx& c0, KP p, int l, int item) {
    const Ctx c = relaunder(c0);
    const bf16_t* z = (const bf16_t*)(p->ws + WS_Z); const float* bcum = (const float*)(p->ws + WS_BCUM); const bf16_t* sprev = (const bf16_t*)(p->ws + WS_SPREV); bf16_t* ys = (bf16_t*)(p->ws + WS_YS);
    const int b = item >> 6, ck = item & 63; const size_t r0 = (size_t)b * SEQ_ + ck * 64;
    LAS bf16_t* qd = (LAS bf16_t*)c.lds;
    LAS bf16_t* ki = (LAS bf16_t*)(c.lds + 9216);
    LAS bf16_t* vT = (LAS bf16_t*)(c.lds + 18432);
    LAS bf16_t* sT = (LAS bf16_t*)(c.lds + 36864);
    LAS bf16_t* scp = (LAS bf16_t*)(c.lds + 55296) + c.wave * (16 * 72);
    LAS bf16_t* br = (LAS bf16_t*)(c.lds + 73728);
    LAS float* part = (LAS float*)(c.lds + 91136);
    const int r = c.lane & 15, q = c.lane >> 4, rbk = c.wave & 3, half = c.wave >> 2;
    u32x4 nqv, nkv, nvv0, nvv1, nrv0, nrv1, nsq0, nsq1; f32x4 nbc0, nbc1;
#define GLA3_LOAD(hh_) do { const int t_ = c.tid >> 3, k0_ = (c.tid & 7) * 8, v0_ = (c.tid & 7) * 16; \
        nqv = *(const u32x4*)(z + (r0 + t_) * ZC + Z_BQ + (hh_) * 64 + k0_); nkv = *(const u32x4*)(z + (r0 + t_) * ZC + Z_BK + (hh_) * 64 + k0_); \
        nbc0 = *(const f32x4*)(bcum + (r0 + t_) * 256 + (hh_) * 64 + k0_); nbc1 = *(const f32x4*)(bcum + (r0 + t_) * 256 + (hh_) * 64 + k0_ + 4); \
        nvv0 = *(const u32x4*)(z + (r0 + t_) * ZC + Z_BV + (hh_) * 128 + v0_); nvv1 = *(const u32x4*)(z + (r0 + t_) * ZC + Z_BV + (hh_) * 128 + v0_ + 8); \
        nrv0 = *(const u32x4*)(z + (r0 + t_) * ZC + Z_BR + (hh_) * 128 + v0_); nrv1 = *(const u32x4*)(z + (r0 + t_) * ZC + Z_BR + (hh_) * 128 + v0_ + 8); \
        const bf16_t* sps_ = sprev + ((((size_t)b * 64 + ck) * 4 + (hh_)) * 64 + t_) * 128 + v0_;       \
        nsq0 = *(const u32x4*)(sps_); nsq1 = *(const u32x4*)(sps_ + 8); } while (0)
    GLA3_LOAD(0);
    for (int hh = 0; hh < 4; ++hh) {
        { const int t = c.tid >> 3, k0 = (c.tid & 7) * 8, v0 = (c.tid & 7) * 16;
          const u32x4 qv = nqv, kv = nkv, vv0 = nvv0, vv1 = nvv1, rv0 = nrv0, rv1 = nrv1, sq0 = nsq0, sq1 = nsq1; const f32x4 bc0 = nbc0, bc1 = nbc1;
          const unsigned qw[4] = {qv.x, qv.y, qv.z, qv.w}, kw[4] = {kv.x, kv.y, kv.z, kv.w}; const float bcv[8] = {bc0[0], bc0[1], bc0[2], bc0[3], bc1[0], bc1[1], bc1[2], bc1[3]};
          unsigned qo[4], ko[4];
#pragma unroll
          for (int e = 0; e < 4; ++e) { const float e0 = __expf(bcv[2 * e]), e1 = __expf(bcv[2 * e + 1]);
              qo[e] = pk2(bflo(qw[e]) * 0.125f * e0, bfhi(qw[e]) * 0.125f * e1); ko[e] = pk2(bflo(kw[e]) * __builtin_amdgcn_rcpf(e0), bfhi(kw[e]) * __builtin_amdgcn_rcpf(e1)); }
          *(LAS u32x4*)(qd + t * 72 + k0) = (u32x4){qo[0], qo[1], qo[2], qo[3]}; *(LAS u32x4*)(ki + t * 72 + k0) = (u32x4){ko[0], ko[1], ko[2], ko[3]};
          const unsigned vw[8] = {vv0.x, vv0.y, vv0.z, vv0.w, vv1.x, vv1.y, vv1.z, vv1.w};
#pragma unroll
          for (int e = 0; e < 8; ++e) { vT[(v0 + 2 * e) * 72 + t] = (bf16_t)(vw[e] & 0xffffu); vT[(v0 + 2 * e + 1) * 72 + t] = (bf16_t)(vw[e] >> 16); }
          const unsigned sw[8] = {sq0.x, sq0.y, sq0.z, sq0.w, sq1.x, sq1.y, sq1.z, sq1.w};
#pragma unroll
          for (int e = 0; e < 8; ++e) { sT[(v0 + 2 * e) * 72 + t] = (bf16_t)(sw[e] & 0xffffu); sT[(v0 + 2 * e + 1) * 72 + t] = (bf16_t)(sw[e] >> 16); }
          *(LAS u32x4*)(br + t * 136 + v0) = rv0; *(LAS u32x4*)(br + t * 136 + v0 + 8) = rv1; }
        __syncthreads();
        if (hh < 3) GLA3_LOAD(hh + 1);
        const bf16x8 aq0 = *(const LAS bf16x8*)(qd + (16 * rbk + r) * 72 + 8 * q), aq1 = *(const LAS bf16x8*)(qd + (16 * rbk + r) * 72 + 32 + 8 * q);
#pragma unroll
        for (int cb = 0; cb < 4; ++cb) {
            const bf16x8 b0 = *(const LAS bf16x8*)(ki + (16 * cb + r) * 72 + 8 * q), b1 = *(const LAS bf16x8*)(ki + (16 * cb + r) * 72 + 32 + 8 * q);
            f32x4 d = __builtin_amdgcn_mfma_f32_16x16x32_bf16(aq0, b0, (f32x4){0.f, 0.f, 0.f, 0.f}, 0, 0, 0); d = __builtin_amdgcn_mfma_f32_16x16x32_bf16(aq1, b1, d, 0, 0, 0);
#pragma unroll
            for (int j = 0; j < 4; ++j) scp[(4 * q + j) * 72 + 16 * cb + r] = (bf16_t)f2bf((16 * cb + r <= 16 * rbk + 4 * q + j) ? d[j] : 0.f); }
        LDS_WAIT(); __builtin_amdgcn_wave_barrier();
        const bf16x8 as0 = *(const LAS bf16x8*)(scp + r * 72 + 8 * q), as1 = *(const LAS bf16x8*)(scp + r * 72 + 32 + 8 * q);
        f32x4 o[4]; float ssq[4] = {0.f, 0.f, 0.f, 0.f};
#pragma unroll
        for (int cbl = 0; cbl < 4; ++cbl) { const int vr = 16 * (4 * half + cbl) + r;
            const bf16x8 bv0 = *(const LAS bf16x8*)(vT + vr * 72 + 8 * q), bv1 = *(const LAS bf16x8*)(vT + vr * 72 + 32 + 8 * q), bs0 = *(const LAS bf16x8*)(sT + vr * 72 + 8 * q), bs1 = *(const LAS bf16x8*)(sT + vr * 72 + 32 + 8 * q);
            f32x4 d = __builtin_amdgcn_mfma_f32_16x16x32_bf16(as0, bv0, (f32x4){0.f, 0.f, 0.f, 0.f}, 0, 0, 0); d = __builtin_amdgcn_mfma_f32_16x16x32_bf16(as1, bv1, d, 0, 0, 0);
            d = __builtin_amdgcn_mfma_f32_16x16x32_bf16(aq0, bs0, d, 0, 0, 0); d = __builtin_amdgcn_mfma_f32_16x16x32_bf16(aq1, bs1, d, 0, 0, 0);
            o[cbl] = d;
#pragma unroll
            for (int j = 0; j < 4; ++j) ssq[j] += d[j] * d[j]; }
#pragma unroll
        for (int j = 0; j < 4; ++j) { float s = ssq[j]; s += __shfl_xor(s, 1); s += __shfl_xor(s, 2); s += __shfl_xor(s, 4); s += __shfl_xor(s, 8); if (r == 0) part[half * 64 + 16 * rbk + 4 * q + j] = s; }
        __syncthreads();
#pragma unroll
        for (int j = 0; j < 4; ++j) { const int t = 16 * rbk + 4 * q + j; const float rstd = 1.f / sqrtf((part[t] + part[64 + t]) * (1.f / 128.f) + LN_EPS);
#pragma unroll
            for (int cbl = 0; cbl < 4; ++cbl) { const int v = 16 * (4 * half + cbl) + r; LAS bf16_t* bp = br + t * 136 + v; const float x = bf2f(*bp);
                *bp = (bf16_t)f2bf(o[cbl][j] * rstd * p->in[I_GNG][l * 128 + v] * (x * sigmoidf_(x))); } }
        __syncthreads();
        for (int i = c.tid; i < 1024; i += 512) { const int t = i >> 4, ch = i & 15; *(u32x4*)(ys + (r0 + t) * 2048 + 512 + hh * 128 + 8 * ch) = *(const LAS u32x4*)(br + t * 136 + 8 * ch); }
        __syncthreads();
    }
}

__device__ __forceinline__ void ph_stick(const Ctx& c0, KP p, int item) {
    const Ctx c = relaunder(c0);
    const bf16_t* z = (const bf16_t*)(p->ws + WS_Z); bf16_t* ys = (bf16_t*)(p->ws + WS_YS);
    const int b = item >> 7, hh = (item >> 4) & 7, qblk = item & 15; const size_t rb = (size_t)b * SEQ_;
    const int r = c.lane & 15, q = c.lane >> 4;
    const int tq0 = qblk * 256 + 32 * c.wave;
    volatile LAS int* flg = (volatile LAS int*)(c.lds + LDS_MISC + MISC_RED);
    bf16x8 qf[2][2];
#pragma unroll
    for (int qb = 0; qb < 2; ++qb)
#pragma unroll
        for (int ks = 0; ks < 2; ++ks) { const u32x4 v = *(const u32x4*)(z + (rb + tq0 + 16 * qb + r) * ZC + Z_CQ + hh * 64 + 32 * ks + 8 * q);
            u32x4 w; w.x = pk2(bflo(v.x) * 0.125f, bfhi(v.x) * 0.125f); w.y = pk2(bflo(v.y) * 0.125f, bfhi(v.y) * 0.125f); w.z = pk2(bflo(v.z) * 0.125f, bfhi(v.z) * 0.125f); w.w = pk2(bflo(v.w) * 0.125f, bfhi(v.w) * 0.125f);
            qf[qb][ks] = __builtin_bit_cast(bf16x8, w); }
    f32x4 oacc[4][2];
#pragma unroll
    for (int db = 0; db < 4; ++db)
#pragma unroll
        for (int qb = 0; qb < 2; ++qb) oacc[db][qb] = (f32x4){0.f, 0.f, 0.f, 0.f};
    float P[2] = {1.f, 1.f};
    const int kt_hi = qblk * 4 + 3, skey = c.tid >> 3, sd = c.tid & 7;
    u32x4 kreg, vreg;
    { const size_t row = rb + kt_hi * 64 + skey; kreg = *(const u32x4*)(z + row * ZC + Z_CK + hh * 64 + 8 * sd); vreg = *(const u32x4*)(z + row * ZC + Z_CV + hh * 64 + 8 * sd); }
#define STK_WRITE(buf) do { LAS bf16_t* Kt_ = (LAS bf16_t*)(c.lds + (buf) * 18432); LAS bf16_t* Vt_ = (LAS bf16_t*)(c.lds + (buf) * 18432 + 9216); \
        *(LAS u32x4*)(Kt_ + skey * 72 + 8 * sd) = kreg; const unsigned vw_[4] = {vreg.x, vreg.y, vreg.z, vreg.w}; \
        _Pragma("unroll") for (int e_ = 0; e_ < 4; ++e_) { Vt_[(8 * sd + 2 * e_) * 68 + skey] = (bf16_t)(vw_[e_] & 0xffffu); Vt_[(8 * sd + 2 * e_ + 1) * 68 + skey] = (bf16_t)(vw_[e_] >> 16); } } while (0)
    STK_WRITE(0);
    __syncthreads();
    bool wdone = false;
    for (int kt = kt_hi, it = 0; kt >= 0; --kt, ++it) {
        const int cur = it & 1;
        if (kt > 0) { const size_t row = rb + (kt - 1) * 64 + skey; kreg = *(const u32x4*)(z + row * ZC + Z_CK + hh * 64 + 8 * sd); vreg = *(const u32x4*)(z + row * ZC + Z_CV + hh * 64 + 8 * sd); }
        const int k0 = kt * 64;
        if (!wdone && k0 < tq0 + 31) {
            const LAS bf16_t* Kt = (const LAS bf16_t*)(c.lds + cur * 18432); const LAS bf16_t* Vt = (const LAS bf16_t*)(c.lds + cur * 18432 + 9216);
            for (int g = 1; g >= 0; --g) {
                const int g0 = k0 + 32 * g; if (g0 >= tq0 + 31) continue;
                f32x4 s[2][2];
#pragma unroll
                for (int blk = 0; blk < 2; ++blk) {
                    const bf16x8 kf0 = *(const LAS bf16x8*)(Kt + (32 * g + 16 * blk + r) * 72 + 8 * q), kf1 = *(const LAS bf16x8*)(Kt + (32 * g + 16 * blk + r) * 72 + 32 + 8 * q);
#pragma unroll
                    for (int qb = 0; qb < 2; ++qb) { f32x4 a = __builtin_amdgcn_mfma_f32_16x16x32_bf16(kf0, qf[qb][0], (f32x4){0.f, 0.f, 0.f, 0.f}, 0, 0, 0);
                        s[blk][qb] = __builtin_amdgcn_mfma_f32_16x16x32_bf16(kf1, qf[qb][1], a, 0, 0, 0); }
                }
                bf16x8 wf[2];
#pragma unroll
                for (int qb = 0; qb < 2; ++qb) {
                    const int tquery = tq0 + 16 * qb + r;
                    float w[2][4];
#pragma unroll
                    for (int blk = 1; blk >= 0; --blk) {
                        float be[4], kp[4];
#pragma unroll
                        for (int j = 0; j < 4; ++j) { const float zz = s[blk][qb][j]; const float e = __expf(-fabsf(zz)); const float rr = __builtin_amdgcn_rcpf(1.f + e); const float er = e * rr;
                            const bool valid = (g0 + 16 * blk + 4 * q + j) < tquery;
                            be[j] = valid ? (zz >= 0.f ? rr : er) : 0.f; kp[j] = valid ? (zz >= 0.f ? er : rr) : 1.f; }
                        const float p2 = kp[3], p1 = p2 * kp[2], p0 = p1 * kp[1], L = p0 * kp[0];
                        const float L16 = __shfl_xor(L, 16); const float M = L * L16; const float M32 = __shfl_xor(M, 32);
                        const float X = (q == 3) ? 1.f : (q == 2) ? L16 : (q == 1) ? M32 : L16 * M32;
                        const float base = X * P[qb];
                        w[blk][3] = be[3] * base; w[blk][2] = be[2] * p2 * base; w[blk][1] = be[1] * p1 * base; w[blk][0] = be[0] * p0 * base;
                        P[qb] *= M * M32;
                    }
                    u32x4 pw; pw.x = pk2(w[0][0], w[0][1]); pw.y = pk2(w[0][2], w[0][3]); pw.z = pk2(w[1][0], w[1][1]); pw.w = pk2(w[1][2], w[1][3]);
                    wf[qb] = __builtin_bit_cast(bf16x8, pw);
                }
#pragma unroll
                for (int db = 0; db < 4; ++db) {
                    const u32x2 v0 = *(const LAS u32x2*)(Vt + (16 * db + r) * 68 + 32 * g + 4 * q), v1 = *(const LAS u32x2*)(Vt + (16 * db + r) * 68 + 32 * g + 16 + 4 * q);
                    const bf16x8 vf = __builtin_bit_cast(bf16x8, (u32x4){v0.x, v0.y, v1.x, v1.y});
#pragma unroll
                    for (int qb = 0; qb < 2; ++qb) oacc[db][qb] = __builtin_amdgcn_mfma_f32_16x16x32_bf16(vf, wf[qb], oacc[db][qb], 0, 0, 0);
                }
            }
            wdone = __all((P[0] < 1e-30f) && (P[1] < 1e-30f));
        }
        if (c.lane == 0) flg[cur * 8 + c.wave] = wdone ? 1 : 0;
        if (kt > 0) STK_WRITE(cur ^ 1);
        __syncthreads();
        int alld = 1;
#pragma unroll
        for (int w8 = 0; w8 < 8; ++w8) alld &= flg[cur * 8 + w8];
        if (alld) break;
    }
#undef STK_WRITE
#pragma unroll
    for (int qb = 0; qb < 2; ++qb) { bf16_t* op = ys + (rb + tq0 + 16 * qb + r) * 2048 + 1024 + hh * 64 + 4 * q;
#pragma unroll
        for (int db = 0; db < 4; ++db) { const f32x4 o = oacc[db][qb]; u32x2 w; w.x = pk2(o[0], o[1]); w.y = pk2(o[2], o[3]); *(u32x2*)(op + 16 * db) = w; } }
    __syncthreads();
}

__device__ __forceinline__ void ph_ln2_router(const Ctx& c0, KP p, int l, bool fused  ) {
    const Ctx c = relaunder(c0);
    unsigned char* ws = p->ws; float* hf = (float*)(ws + WS_H); bf16_t* hb = (bf16_t*)(ws + WS_HB); const float* pre = fused ? (const float*)hf : (const float*)(ws + WS_PRE);
    int* toke = (int*)(ws + WS_TOKE); int* tokr = (int*)(ws + WS_TOKR); float* tokg = (float*)(ws + WS_TOKG); int* elist = (int*)(ws + WS_ELIST);
    unsigned* cnt = (unsigned*)(ws + WS_CTL) + CW_CNT + l * 32 * 16;
    const float* rw = p->in[I_RW] + (size_t)l * 1024 * 32; const float* rbias = p->in[I_RB] + l * 32;
    const float* g = p->in[I_LN2G] + l * 1024; const float* bb = p->in[I_LN2B] + l * 1024;
    LAS float* arow = (LAS float*)c.lds;
    LAS float* part = (LAS float*)(c.lds + 65792);
    LAS float* lgt = (LAS float*)(c.lds + 65792 + 16384);
    const int r = c.lane & 15, kq = c.lane >> 4;
    float bf0[32], bf1[32];
#pragma unroll
    for (int i = 0; i < 32; ++i) { const int k = 4 * (32 * c.wave + i) + kq; bf0[i] = rw[(size_t)k * 32 + r]; bf1[i] = rw[(size_t)k * 32 + 16 + r]; }
    for (int tile = c.bid; tile < T_ / 64; tile += c.G) {
        f32x4 nv[2][4];
#pragma unroll
        for (int rr = 0; rr < 2; ++rr)
#pragma unroll
            for (int j = 0; j < 4; ++j) nv[rr][j] = *(const f32x4*)(pre + (size_t)(tile * 64 + 2 * c.wave + rr) * 1024 + 4 * c.lane + 256 * j);
        for (int grp = 0; grp < 4; ++grp) {
            const int m0 = tile * 64 + grp * 16;
            f32x4 v[2][4];
#pragma unroll
            for (int rr = 0; rr < 2; ++rr)
#pragma unroll
                for (int j = 0; j < 4; ++j) v[rr][j] = nv[rr][j];
            if (grp < 3) {
#pragma unroll
                for (int rr = 0; rr < 2; ++rr)
#pragma unroll
                    for (int j = 0; j < 4; ++j) nv[rr][j] = *(const f32x4*)(pre + (size_t)(m0 + 16 + 2 * c.wave + rr) * 1024 + 4 * c.lane + 256 * j); }
#pragma unroll
            for (int rr = 0; rr < 2; ++rr) { const int lr = 2 * c.wave + rr, m = m0 + lr;
                if (!fused) ln_row_regs(v[rr], g, bb, c.lane, hf + (size_t)m * 1024, hb + (size_t)m * 1024);
#pragma unroll
                for (int j = 0; j < 4; ++j) *(LAS f32x4*)(arow + lr * 1028 + 4 * c.lane + 256 * j) = v[rr][j]; }
            __syncthreads();
            f32x4 acc0 = (f32x4){0.f, 0.f, 0.f, 0.f}, acc1 = (f32x4){0.f, 0.f, 0.f, 0.f};
#pragma unroll
            for (int i = 0; i < 32; ++i) { const float a = arow[r * 1028 + 4 * (32 * c.wave + i) + kq];
                acc0 = __builtin_amdgcn_mfma_f32_16x16x4f32(a, bf0[i], acc0, 0, 0, 0); acc1 = __builtin_amdgcn_mfma_f32_16x16x4f32(a, bf1[i], acc1, 0, 0, 0); }
#pragma unroll
            for (int j = 0; j < 4; ++j) { part[(c.wave * 16 + 4 * kq + j) * 32 + r] = acc0[j]; part[(c.wave * 16 + 4 * kq + j) * 32 + 16 + r] = acc1[j]; }
            __syncthreads();
            { const int row = c.tid >> 5, e = c.tid & 31; float s = rbias[e];
#pragma unroll
              for (int w = 0; w < 8; ++w) s += part[(w * 16 + row) * 32 + e];
              lgt[row * 32 + e] = s; }
            __syncthreads();
            if (c.tid < 16) { const int m = m0 + c.tid; float lg[32];
#pragma unroll
                for (int e = 0; e < 32; ++e) lg[e] = lgt[c.tid * 32 + e];
                float tv[4]; int ti[4]; unsigned taken = 0u;
#pragma unroll
                for (int k = 0; k < 4; ++k) { float best = -3.0e38f; int bi = 0;
#pragma unroll
                    for (int e = 0; e < 32; ++e) { const bool ok = !((taken >> e) & 1u) && (lg[e] > best); best = ok ? lg[e] : best; bi = ok ? e : bi; }
                    tv[k] = best; ti[k] = bi; taken |= 1u << bi; }
                float ev[4]; ev[0] = 1.f; ev[1] = __expf(tv[1] - tv[0]); ev[2] = __expf(tv[2] - tv[0]); ev[3] = __expf(tv[3] - tv[0]);
                const float inv = 1.f / (ev[0] + ev[1] + ev[2] + ev[3]);
#pragma unroll
                for (int k = 0; k < 4; ++k) { const unsigned rk = atomicAdd(cnt + ti[k] * 16, 1u); toke[m * 4 + k] = ti[k]; tokr[m * 4 + k] = (int)rk; tokg[m * 4 + k] = ev[k] * inv; elist[(size_t)ti[k] * T_ + rk] = m; } }
        }
    }
    __syncthreads();
}
__device__ __forceinline__ void ph_router_fused(const Ctx& c0, KP p, int l) {
    const Ctx c = relaunder(c0);
    unsigned char* ws = p->ws; const float* hf = (const float*)(ws + WS_H);
    int* toke = (int*)(ws + WS_TOKE); int* tokr = (int*)(ws + WS_TOKR); float* tokg = (float*)(ws + WS_TOKG); int* elist = (int*)(ws + WS_ELIST);
    unsigned* cnt = (unsigned*)(ws + WS_CTL) + CW_CNT + l * 32 * 16;
    const bf16_t* rwh = (const bf16_t*)(ws + WS_RWS) + (size_t)l * 2 * 32 * 1024; const bf16_t* rwl = rwh + 32 * 1024; const float* rbias = p->in[I_RB] + l * 32;
    LAS float* part = (LAS float*)c.lds;
    LAS float* lgt = (LAS float*)(c.lds + 16384);
    LAS int* lcnt = (LAS int*)(c.lds + 16384 + 8448);
    LAS int* lbase = lcnt + 32;
    if (c.tid < 32) lcnt[c.tid] = 0;
    __syncthreads();
    const int r = c.lane & 15, q = c.lane >> 4, rbk = c.wave & 3, kh = c.wave >> 2;
    for (int tile = c.bid; tile < T_ / 64; tile += c.G) {
        const int m0 = tile * 64;
        const float* ap = hf + (size_t)(m0 + 16 * rbk + r) * 1024 + 512 * kh + 8 * q;
        const bf16_t* bhp = rwh + (size_t)r * 1024 + 512 * kh + 8 * q; const bf16_t* blp = rwl + (size_t)r * 1024 + 512 * kh + 8 * q;
        f32x4 acc0 = (f32x4){0.f, 0.f, 0.f, 0.f}, acc1 = (f32x4){0.f, 0.f, 0.f, 0.f};
#pragma unroll 4
        for (int ks = 0; ks < 16; ++ks) {
            const f32x4 a0 = *(const f32x4*)(ap + 32 * ks), a1 = *(const f32x4*)(ap + 32 * ks + 4);
            const bf16x8 bh0 = *(const bf16x8*)(bhp + 32 * ks), bl0 = *(const bf16x8*)(blp + 32 * ks), bh1 = *(const bf16x8*)(bhp + 16 * 1024 + 32 * ks), bl1 = *(const bf16x8*)(blp + 16 * 1024 + 32 * ks);
            u32x4 hi, lo; hi.x = pk2(a0[0], a0[1]); hi.y = pk2(a0[2], a0[3]); hi.z = pk2(a1[0], a1[1]); hi.w = pk2(a1[2], a1[3]);
            lo.x = pk2(a0[0] - bflo(hi.x), a0[1] - bfhi(hi.x)); lo.y = pk2(a0[2] - bflo(hi.y), a0[3] - bfhi(hi.y)); lo.z = pk2(a1[0] - bflo(hi.z), a1[1] - bfhi(hi.z)); lo.w = pk2(a1[2] - bflo(hi.w), a1[3] - bfhi(hi.w));
            const bf16x8 ah = __builtin_bit_cast(bf16x8, hi), al = __builtin_bit_cast(bf16x8, lo);
            acc0 = __builtin_amdgcn_mfma_f32_16x16x32_bf16(ah, bh0, acc0, 0, 0, 0); acc0 = __builtin_amdgcn_mfma_f32_16x16x32_bf16(ah, bl0, acc0, 0, 0, 0); acc0 = __builtin_amdgcn_mfma_f32_16x16x32_bf16(al, bh0, acc0, 0, 0, 0);
            acc1 = __builtin_amdgcn_mfma_f32_16x16x32_bf16(ah, bh1, acc1, 0, 0, 0); acc1 = __builtin_amdgcn_mfma_f32_16x16x32_bf16(ah, bl1, acc1, 0, 0, 0); acc1 = __builtin_amdgcn_mfma_f32_16x16x32_bf16(al, bh1, acc1, 0, 0, 0); }
#pragma unroll
        for (int j = 0; j < 4; ++j) { part[(kh * 64 + 16 * rbk + 4 * q + j) * 32 + r] = acc0[j]; part[(kh * 64 + 16 * rbk + 4 * q + j) * 32 + 16 + r] = acc1[j]; }
        __syncthreads();
        for (int i = c.tid; i < 2048; i += 512) { const int row = i >> 5, e = i & 31; lgt[row * 33 + e] = part[i] + part[2048 + i] + rbias[e]; }
        __syncthreads();
        int ti[4] = {0, 0, 0, 0}, lr[4] = {0, 0, 0, 0}; float gt[4] = {0.f, 0.f, 0.f, 0.f};
        if (c.tid < 64) { float lg[32];
#pragma unroll
            for (int e = 0; e < 32; ++e) lg[e] = lgt[c.tid * 33 + e];
            float tv[4]; unsigned taken = 0u;
#pragma unroll
            for (int k = 0; k < 4; ++k) { float best = -3.0e38f; int bi = 0;
#pragma unroll
                for (int e = 0; e < 32; ++e) { const bool ok = !((taken >> e) & 1u) && (lg[e] > best); best = ok ? lg[e] : best; bi = ok ? e : bi; }
                tv[k] = best; ti[k] = bi; taken |= 1u << bi; }
            float ev[4]; ev[0] = 1.f; ev[1] = __expf(tv[1] - tv[0]); ev[2] = __expf(tv[2] - tv[0]); ev[3] = __expf(tv[3] - tv[0]);
            const float inv = 1.f / (ev[0] + ev[1] + ev[2] + ev[3]);
#pragma unroll
            for (int k = 0; k < 4; ++k) { gt[k] = ev[k] * inv; lr[k] = (int)atomicAdd((unsigned*)(lcnt + ti[k]), 1u); } }
        __syncthreads();
        if (c.tid < 32) { const unsigned n = (unsigned)lcnt[c.tid]; lbase[c.tid] = n ? (int)atomicAdd(cnt + c.tid * 16, n) : 0; lcnt[c.tid] = 0; }
        __syncthreads();
        if (c.tid < 64) { const int m = m0 + c.tid;
#pragma unroll
            for (int k = 0; k < 4; ++k) { const int rk = lbase[ti[k]] + lr[k]; toke[m * 4 + k] = ti[k]; tokr[m * 4 + k] = rk; tokg[m * 4 + k] = gt[k]; elist[(size_t)ti[k] * T_ + rk] = m; } }
    }
    __syncthreads();
}
__device__ __forceinline__ void moe_tstart(const Ctx& c, KP p, int l) {
    LAS int* ts = (LAS int*)(c.lds + LDS_MISC + MISC_MOE);
    const unsigned* cnt = (const unsigned*)(p->ws + WS_CTL) + CW_CNT + l * 32 * 16;
    if (c.tid < 64) {
        const int e = c.lane & 31; const int n = (int)__hip_atomic_load(cnt + e * 16, __ATOMIC_RELAXED, __HIP_MEMORY_SCOPE_AGENT); const int tl = (n + 255) >> 8;
        int inc = tl;
#pragma unroll
        for (int o = 1; o < 32; o <<= 1) { const int v = __shfl_up(inc, o); if ((c.lane & 31) >= o) inc += v; }
        if (c.lane < 32) { ts[e] = inc - tl; ts[33 + e] = n; if (e == 31) ts[32] = inc;
            LAS int* r2e = (LAS int*)(c.lds + LDS_MISC + MISC_R2E); for (int rt = inc - tl; rt < inc; ++rt) r2e[rt] = e; } }
    __syncthreads();
}
__device__ __forceinline__ void ph_combine(const Ctx& c0, KP p, int l, float* out_f32, bool hbres  ) {
    const Ctx c = relaunder(c0);
    unsigned char* ws = p->ws; float* hf = (float*)(ws + WS_H); bf16_t* hb = (bf16_t*)(ws + WS_HB); const bf16_t* ysl = (const bf16_t*)(ws + WS_YSL); const int* toke = (const int*)(ws + WS_TOKE); const int* tokr = (const int*)(ws + WS_TOKR); const float* tokg = (const float*)(ws + WS_TOKG);
    moe_tstart(c, p, l);
    const LAS int* ts = (const LAS int*)(c.lds + LDS_MISC + MISC_MOE);
    const float* g = p->in[I_LN3G] + l * 1024; const float* bb = p->in[I_LN3B] + l * 1024;
    const int gw = c.bid * 8 + c.wave, NGW = c.G * 8;
    for (int base = 0; gw + base * NGW < T_; base += 16) {
        const int mr = gw + (base + (c.lane >> 2)) * NGW;
        const int slotv = (mr < T_) ? ts[toke[mr * 4 + (c.lane & 3)]] * 256 + tokr[mr * 4 + (c.lane & 3)] : 0; const float gatev = (mr < T_) ? tokg[mr * 4 + (c.lane & 3)] : 0.f;
        for (int i2 = 0; i2 < 16; i2 += 2) {
            const int mA = gw + (base + i2) * NGW; if (mA >= T_) break;
            const int mB = (mA + NGW < T_) ? mA + NGW : mA;
            f32x4 va[4], vb[4]; u32x4 ya[4][2], yb2[4][2]; float ga[4], gb[4];
#pragma unroll
            for (int k = 0; k < 4; ++k) { const int sa = __builtin_amdgcn_readlane(slotv, 4 * i2 + k), sb = __builtin_amdgcn_readlane(slotv, (mB != mA) ? 4 * i2 + 4 + k : 4 * i2 + k);
                ga[k] = __uint_as_float(__builtin_amdgcn_readlane(__float_as_uint(gatev), 4 * i2 + k)); gb[k] = __uint_as_float(__builtin_amdgcn_readlane(__float_as_uint(gatev), (mB != mA) ? 4 * i2 + 4 + k : 4 * i2 + k));
#pragma unroll
                for (int j = 0; j < 2; ++j) { ya[k][j] = *(const u32x4*)(ysl + (size_t)sa * 1024 + 8 * c.lane + 512 * j); yb2[k][j] = *(const u32x4*)(ysl + (size_t)sb * 1024 + 8 * c.lane + 512 * j); } }
#pragma unroll
            for (int j = 0; j < 2; ++j) {
                if (hbres) { const u32x4 xa = *(const u32x4*)(hb + (size_t)mA * 1024 + 8 * c.lane + 512 * j), xb = *(const u32x4*)(hb + (size_t)mB * 1024 + 8 * c.lane + 512 * j);
                    va[2 * j] = DN_ALPHA * (f32x4){bflo(xa.x), bfhi(xa.x), bflo(xa.y), bfhi(xa.y)}; va[2 * j + 1] = DN_ALPHA * (f32x4){bflo(xa.z), bfhi(xa.z), bflo(xa.w), bfhi(xa.w)};
                    vb[2 * j] = DN_ALPHA * (f32x4){bflo(xb.x), bfhi(xb.x), bflo(xb.y), bfhi(xb.y)}; vb[2 * j + 1] = DN_ALPHA * (f32x4){bflo(xb.z), bfhi(xb.z), bflo(xb.w), bfhi(xb.w)}; }
                else { va[2 * j] = DN_ALPHA * *(const f32x4*)(hf + (size_t)mA * 1024 + 8 * c.lane + 512 * j); va[2 * j + 1] = DN_ALPHA * *(const f32x4*)(hf + (size_t)mA * 1024 + 8 * c.lane + 512 * j + 4);
                    vb[2 * j] = DN_ALPHA * *(const f32x4*)(hf + (size_t)mB * 1024 + 8 * c.lane + 512 * j); vb[2 * j + 1] = DN_ALPHA * *(const f32x4*)(hf + (size_t)mB * 1024 + 8 * c.lane + 512 * j + 4); } }
#pragma unroll
            for (int k = 0; k < 4; ++k)
#pragma unroll
                for (int j = 0; j < 2; ++j) { const u32x4 y = ya[k][j];
                    va[2 * j][0] += ga[k] * bflo(y.x); va[2 * j][1] += ga[k] * bfhi(y.x); va[2 * j][2] += ga[k] * bflo(y.y); va[2 * j][3] += ga[k] * bfhi(y.y);
                    va[2 * j + 1][0] += ga[k] * bflo(y.z); va[2 * j + 1][1] += ga[k] * bfhi(y.z); va[2 * j + 1][2] += ga[k] * bflo(y.w); va[2 * j + 1][3] += ga[k] * bfhi(y.w);
                    const u32x4 y2 = yb2[k][j];
                    vb[2 * j][0] += gb[k] * bflo(y2.x); vb[2 * j][1] += gb[k] * bfhi(y2.x); vb[2 * j][2] += gb[k] * bflo(y2.y); vb[2 * j][3] += gb[k] * bfhi(y2.y);
                    vb[2 * j + 1][0] += gb[k] * bflo(y2.z); vb[2 * j + 1][1] += gb[k] * bfhi(y2.z); vb[2 * j + 1][2] += gb[k] * bflo(y2.w); vb[2 * j + 1][3] += gb[k] * bfhi(y2.w); }
            ln_row_regs<true>(va, g, bb, c.lane, out_f32 ? out_f32 + (size_t)mA * 1024 : (hbres ? nullptr : hf + (size_t)mA * 1024), out_f32 ? nullptr : hb + (size_t)mA * 1024);
            if (mB != mA) ln_row_regs<true>(vb, g, bb, c.lane, out_f32 ? out_f32 + (size_t)mB * 1024 : (hbres ? nullptr : hf + (size_t)mB * 1024), out_f32 ? nullptr : hb + (size_t)mB * 1024);
        }
    }
}
#ifndef MK_MULTI_LAUNCH
#define MK_MULTI_LAUNCH 0
#endif
constexpr int PH_PER_LAYER = 13, NPH = 1 + PH_PER_LAYER * NL_;

#define PHASE_ENTER \
    Ctx c; { int t_ = threadIdx.x; asm volatile("" : "+v"(t_)); c.tid = t_; c.lane = t_ & 63; c.wave = __builtin_amdgcn_readfirstlane(t_ >> 6); { int g_ = gridDim.x, b_ = blockIdx.x; asm volatile("" : "+s"(g_), "+s"(b_)); c.G = g_; c.bid = b_; } c.lds = lds; } \
    KP p = kp0; asm volatile("" : "+s"(p)); int l = l0; asm volatile("" : "+s"(l)); unsigned char* ws = p->ws; (void)l; (void)ws; \
    const char* lw = (const char*)ws + WS_W + (size_t)l * LW_END; (void)lw;

__global__ void __launch_bounds__(512, 2) fwd_kernel(Params p_arg) {
    extern __shared__ __attribute__((aligned(16))) unsigned char lds_raw[];
    LAS unsigned char* lds = (LAS unsigned char*)lds_raw;
    const KP kp0 = (KP)__builtin_amdgcn_kernarg_segment_ptr();
    if (threadIdx.x < 4) ((LAS unsigned*)(lds + LDS_MISC + MISC_BAR))[threadIdx.x] = 0u;
    __syncthreads();
    const int ph_lo = kp0->ph_lo, ph_hi = kp0->ph_hi;
    XcdBarrier bar;
    { unsigned* bw = (unsigned*)(kp0->ws + WS_CTL) + CW_BAR + kp0->li * XCD_BAR_WORDS;
      bar.bar = bw; bar.x = 0; bar.st = (volatile LAS unsigned*)(lds + LDS_MISC + MISC_BAR);
      if (ph_hi - ph_lo > 1) bar = xcd_barrier_post(bw, (volatile LAS unsigned*)(lds + LDS_MISC + MISC_BAR)); }
    int ph = 0;
#define RUN (ph >= kp0->ph_lo && ph < kp0->ph_hi)
#define SEAM do { if (ph + 1 < kp0->ph_hi) xcd_barrier(bar); } while (0)

    { const int l0 = 0;
      if (RUN) { PHASE_ENTER; ph_prologue(c, p); SEAM; } ++ph; }

    for (int l0 = 0; l0 < NL_; ++l0) {
        if (RUN) { PHASE_ENTER; SchedInProj S{(const char*)ws + WS_HB, lw + LW_WIN, (char*)ws + WS_Z, c.G, c.bid}; EpiStoreBf16T<true> E{p->in[I_BIN] + (size_t)l * INC, 1.f};
            pg8::gemm_phase(lds, pg8::Gemm{1024, 1024, 1024}, S, E); SEAM; } ++ph;
        if (RUN) { PHASE_ENTER;
            const int skip = p->pad;
            if (!(skip & 1)) for (int it = c.bid; it < 256; it += c.G) ph_conv_a(c, p, l, it);
            if (!(skip & 2)) for (int it = c.bid; it < 256; it += c.G) ph_gla1(c, p, l, it);
            if (!(skip & 4)) for (int it = c.bid; it < 256; it += c.G) ph_lru<1>(c, p, l, it);
            if (!(skip & 8)) for (int it = c.bid; it < 512; it += c.G) ph_stick(c, p, it);
            if (l == 0) { SchedKV S{(const char*)ws, c.G, c.bid}; EpiStoreBf16 E{nullptr, 1.f}; pg8::gemm_phase(lds, pg8::Gemm{1024, 1024, 1024}, S, E); }
            SEAM; } ++ph;
        if (RUN) { PHASE_ENTER; ph_gla2(c, p); ph_lru_carry(c, p); SEAM; } ++ph;
        if (RUN) { PHASE_ENTER;
            const int skip = p->pad;
            if (!(skip & 1)) for (int it = c.bid; it < 256; it += c.G) ph_gla3(c, p, l, it);
            if (!(skip & 2)) for (int it = c.bid; it < 256; it += c.G) ph_lru<3>(c, p, l, it);
            if (l == 0) {
                { SchedMq S{(const char*)ws, c.G, c.bid}; EpiStoreBf16 E{nullptr, 0.0625f}; pg8::gemm_phase(lds, pg8::Gemm{2048, 1024, 256}, S, E); }
                { SchedVw S{(const char*)ws, c.G, c.bid}; EpiStoreBf16 E{nullptr, 1.f}; pg8::gemm_phase(lds, pg8::Gemm{1024, 2048, 256}, S, E); } }
            SEAM; } ++ph;
        if (RUN) { PHASE_ENTER; SchedBranch S{(const char*)ws + WS_YS, lw + LW_WBR, c.G, c.bid}; EpiMerge E{(const bf16_t*)(ws + WS_Z), (bf16_t*)(ws + WS_MB), p->pad};
            pg8::gemm_phase(lds, pg8::Gemm{2048, 2048, 2048}, S, E); SEAM; } ++ph;
        if (RUN) { PHASE_ENTER; SchedSq S{(const char*)ws + WS_MB, lw + LW_WOUT, nullptr, 4, c.G, c.bid};
            if (c.G == 256) { EpiResidLNT<false, false> E{p->in[I_BOUT] + l * 1024, p->in[I_LN1G] + l * 1024, p->in[I_LN1B] + l * 1024, ws,
                    (LAS float*)(lds + LDS_MISC + MISC_XCH), (LAS float*)(lds + LDS_MISC + MISC_STAT), (unsigned*)(ws + WS_CTL) + CW_LN + (l * 2 + 0) * 64 * 16, nullptr, nullptr, 0};
                pg8::gemm_phase(lds, pg8::Gemm{1024, 1024, 1024}, S, E); }
            else { EpiResid E{p->in[I_BOUT] + l * 1024, (const float*)(ws + WS_H), (float*)(ws + WS_PRE)}; pg8::gemm_phase(lds, pg8::Gemm{1024, 1024, 1024}, S, E); }
            SEAM; } ++ph;
        if (RUN && gridDim.x != 256) { PHASE_ENTER; ln_rows_phase(c, (const float*)(ws + WS_PRE), p->in[I_LN1G] + l * 1024, p->in[I_LN1B] + l * 1024, (float*)(ws + WS_H), (bf16_t*)(ws + WS_HB)); SEAM; } ++ph;
        if (RUN) { PHASE_ENTER; SchedXB S{(const char*)ws + WS_HB, (const char*)ws + WS_MQT + (size_t)l * 4 * SZ_W1K, (char*)ws + WS_P, 2, c.G, c.bid}; EpiSoftmax E{(LAS float*)(lds + LDS_MISC + MISC_XCH)};
            pg8::gemm_phase(lds, pg8::Gemm{1024, 1024, 1024}, S, E); SEAM; } ++ph;
        if (RUN) { PHASE_ENTER; SchedXB S{(const char*)ws + WS_P, (const char*)ws + WS_VWT + (size_t)l * 4 * SZ_W1K, nullptr, 4, c.G, c.bid};
            if (c.G == 256) { EpiResidLNT<false, true> E{nullptr, p->in[I_LN2G] + l * 1024, p->in[I_LN2B] + l * 1024, ws,
                    (LAS float*)(lds + LDS_MISC + MISC_XCH), (LAS float*)(lds + LDS_MISC + MISC_STAT), (unsigned*)(ws + WS_CTL) + CW_LN + (l * 2 + 1) * 64 * 16, (LAS char*)lds, p->in[I_RB] + l * 32, l};
                pg8::gemm_phase(lds, pg8::Gemm{1024, 1024, 1024}, S, E); }
            else { EpiResid E{nullptr, (const float*)(ws + WS_H), (float*)(ws + WS_PRE)}; pg8::gemm_phase(lds, pg8::Gemm{1024, 1024, 1024}, S, E); }
            SEAM; } ++ph;
        if (RUN && gridDim.x != 256) { PHASE_ENTER; ph_ln2_router(c, p, l, false); SEAM; } ++ph;
        if (RUN && gridDim.x == 256) { PHASE_ENTER; moe_tstart(c, p, l);
            SchedMoeX S{(const char*)ws + WS_HB, lw + LW_W1, lw + LW_W2, (char*)ws + WS_ACT, (char*)ws + WS_YSL, (const LAS int*)(lds + LDS_MISC + MISC_MOE), (const int*)(ws + WS_ELIST),
                        (unsigned*)(ws + WS_CTL) + CW_MOE + l * 288 * 16, c.G, c.bid};
            EpiMoeX E{p->in[I_B1] + (size_t)l * 32 * 2048, p->in[I_B2] + (size_t)l * 32 * 1024};
            pg8::gemm_phase(lds, pg8::Gemm{1024, 1024, 1024}, S, E); SEAM; }
        else if (RUN) { PHASE_ENTER; moe_tstart(c, p, l);
            SchedMoe<8, 2048, 128, 1, true> S{(const char*)ws + WS_HB, lw + LW_W1, (char*)ws + WS_ACT, (const LAS int*)(lds + LDS_MISC + MISC_MOE), (const int*)(ws + WS_ELIST), c.G, c.bid}; EpiSwiGLU E{p->in[I_B1] + (size_t)l * 32 * 2048};
            pg8::gemm_phase(lds, pg8::Gemm{1024, 1024, 1024}, S, E); SEAM; } ++ph;
        if (RUN && gridDim.x != 256) { PHASE_ENTER; moe_tstart(c, p, l);
            SchedMoe<4, 1024, 256, 1024, false> S{(const char*)ws + WS_ACT, lw + LW_W2, (char*)ws + WS_YSL, (const LAS int*)(lds + LDS_MISC + MISC_MOE), nullptr, c.G, c.bid}; EpiStoreBf16 E{p->in[I_B2] + (size_t)l * 32 * 1024, 1.f};
            pg8::gemm_phase(lds, pg8::Gemm{1024, 1024, 1024}, S, E); SEAM; } ++ph;
        if (RUN) { PHASE_ENTER; ph_combine(c, p, l, (l == NL_ - 1) ? p->out : nullptr, c.G == 256); SEAM; } ++ph;
    }
#undef RUN
#undef SEAM
}

extern "C" void kernel_launch(void* const* d_in, const int* in_sizes, int n_in, void* d_out, int out_size, void* d_ws, size_t ws_size, hipStream_t stream) {
    static int grid = 0;
    if (grid == 0) {
        if (n_in != 39 || in_sizes[0] != T_ * D_ || out_size != T_ * D_ || ws_size < WS_END) {
            fprintf(stderr, "kernel_launch: unexpected shapes (n_in %d, in0 %d, out %d, ws %zu, need %zu)\n", n_in, n_in > 0 ? in_sizes[0] : -1, out_size, ws_size, (size_t)WS_END); grid = -1; return; }
        int dev = 0, cus = 0, per_cu = 0;
        if (hipGetDevice(&dev) != hipSuccess || hipDeviceGetAttribute(&cus, hipDeviceAttributeMultiprocessorCount, dev) != hipSuccess) { grid = -1; return; }
        if (hipFuncSetAttribute((const void*)fwd_kernel, hipFuncAttributeMaxDynamicSharedMemorySize, LDS_BYTES) != hipSuccess) { fprintf(stderr, "kernel_launch: hipFuncSetAttribute failed\n"); grid = -1; return; }
        if (hipOccupancyMaxActiveBlocksPerMultiprocessor(&per_cu, (const void*)fwd_kernel, 512, LDS_BYTES) != hipSuccess || per_cu < 1) { fprintf(stderr, "kernel_launch: occupancy query says %d\n", per_cu); grid = -1; return; }
        grid = cus;
    }
    if (grid <= 0) return;
    (void)hipMemsetAsync((char*)d_ws + WS_CTL, 0, CTL_BYTES, stream);
    Params p{};
    for (int i = 0; i < 39; ++i) p.in[i] = (const float*)d_in[i];
    p.out = (float*)d_out; p.ws = (unsigned char*)d_ws; p.li = 0; p.pad = 0;
#if MK_MULTI_LAUNCH
    for (int ph = 0; ph < NPH; ++ph) { p.ph_lo = ph; p.ph_hi = ph + 1; hipLaunchKernelGGL(fwd_kernel, dim3(grid), dim3(512), LDS_BYTES, stream, p); }
#else
    p.ph_lo = 0; p.ph_hi = NPH;
    hipLaunchKernelGGL(fwd_kernel, dim3(grid), dim3(512), LDS_BYTES, stream, p);
#endif
#if defined(PROBE_K) && PROBE_K > 0
    p.pad = PROBE_SKIP;
    for (int r = 0; r < PROBE_K; ++r) { p.ph_lo = PROBE_PH; p.ph_hi = PROBE_PH + 1; hipLaunchKernelGGL(fwd_kernel, dim3(grid), dim3(512), LDS_BYTES, stream, p); }
#endif
}
```

```cpp
#define MK_MULTI_LAUNCH 0
#include <hip/hip_runtime.h>
#include <stdint.h>
#include <stdio.h>

#define LAS __attribute__((address_space(3)))
typedef unsigned short bf16_t;
typedef short bf16x8 __attribute__((ext_vector_type(8)));
typedef float f32x4 __attribute__((ext_vector_type(4)));
typedef float f32x2 __attribute__((ext_vector_type(2)));
typedef unsigned u32x4 __attribute__((ext_vector_type(4)));
typedef unsigned u32x2 __attribute__((ext_vector_type(2)));

constexpr int T_ = 16384, D_ = 1024, NB_ = 4, SEQ_ = 4096, NL_ = 4;
constexpr int INC = 9232;
constexpr int ZC = 9216;
constexpr int LR_COL = 2560;
constexpr int Z_AVAL = 0, Z_AGATE = 512, Z_BQ = 1024, Z_BK = 1280, Z_BV = 1536, Z_BR = 2048, Z_CQ = 2560, Z_CK = 3072, Z_CV = 3584, Z_DX = 4096, Z_DG = 4608, Z_GM = 5120;
constexpr int NEXP = 32, TOPK = 4;
constexpr int NSLOT = 73728;
constexpr float LN_EPS = 1e-5f;
constexpr float DN_ALPHA = 1.6817928305074290f;

__device__ __forceinline__ float bf2f(unsigned v) { return __uint_as_float(v << 16); }
__device__ __forceinline__ float bflo(unsigned v) { return __uint_as_float(v << 16); }
__device__ __forceinline__ float bfhi(unsigned v) { return __uint_as_float(v & 0xffff0000u); }
__device__ __forceinline__ unsigned f2bf(float f) { unsigned u = __float_as_uint(f); u += 0x7FFFu + ((u >> 16) & 1u); return u >> 16; }
typedef __bf16 bf16x2_t __attribute__((ext_vector_type(2)));
__device__ __forceinline__ unsigned pk2(float lo, float hi) { const f32x2 v = {lo, hi}; return __builtin_bit_cast(unsigned, __builtin_convertvector(v, bf16x2_t)); }
__device__ __forceinline__ float wave_sum(float v) {
#pragma unroll
    for (int o = 1; o < 64; o <<= 1) v += __shfl_xor(v, o);
    return v;
}
__device__ __forceinline__ float sigmoidf_(float x) { return __builtin_amdgcn_rcpf(1.f + __expf(-x)); }
__device__ __forceinline__ float softplusf_(float x) { return fmaxf(x, 0.f) + __logf(1.f + __expf(-fabsf(x))); }
#define LDS_WAIT() asm volatile("s_waitcnt lgkmcnt(0)" ::: "memory")

namespace pg8 {
constexpr int BM = 256, BK = 64, HALF = 128, HTB = HALF * BK * 2, STAGE_BYTES = 8 * HTB;
__host__ __device__ __forceinline__ int lds_byte(int r, int c) { const int st = (r >> 4) * 2 + (c >> 5), rr = r & 15, cc = c & 31, ob = rr * 64 + cc * 2; return st * 1024 + (ob ^ (((ob >> 9) & 1) << 5)); }
__host__ __device__ __forceinline__ void stage_rc(int b, int& R, int& C) { const int st = b / 1024, sb = b % 1024, swz = sb ^ (((sb >> 9) & 1) << 5); R = (st >> 1) * 16 + swz / 64; C = (st & 1) * 32 + (swz % 64) / 2; }
__host__ __device__ __forceinline__ int perm32(int rho) { const int n = rho >> 4, i = rho & 15; return 8 * (i >> 2) + 4 * n + (i & 3); }

struct Unit { const char* a; const char* b; char* c; int ldc, row0, col0, aux, g0, g1, kind; };
struct Gemm { int lda, ldb, K; };

__device__ __forceinline__ void swz_tile(int L, int nM, int nN, int& pm, int& pn) {
    const int nwg = nM * nN; int wgid = L;
    { const int q = nwg / 8, r = nwg % 8, xcd = wgid % 8, off = wgid / 8; wgid = (xcd < r ? xcd * (q + 1) : r * (q + 1) + (xcd - r) * q) + off; }
    const int nig = 8 * nN, gid = wgid / nig, fm = gid * 8, gsz = (nM - fm) < 8 ? (nM - fm) : 8;
    pm = fm + ((wgid % nig) % gsz); pn = (wgid % nig) / gsz;
}

template <class Epi, class Sched>
__device__ __forceinline__ void gemm_phase(LAS unsigned char* lds, const Gemm g, const Sched& S, const Epi& E) {
    int tid_ = threadIdx.x; asm volatile("" : "+v"(tid_));
    const int tid = tid_, wid = __builtin_amdgcn_readfirstlane(tid >> 6), lane = tid & 63, wr = wid >> 2, wc = wid & 3, fr = lane & 15, fq = lane >> 4;
    const int K = g.K, nt = K / BK;
    unsigned voffA[2][2], nvoffA[2][2], voffB[2]; int RA[2], CA[2];
#pragma unroll
    for (int i = 0; i < 2; ++i) { int R, C; stage_rc(tid * 16 + i * 8192, R, C); const int Rb = Epi::PERM ? ((R & ~31) + perm32(R & 31)) : R; RA[i] = R; CA[i] = C;
        voffA[0][i] = (unsigned)(R * g.lda + C) * 2u; voffA[1][i] = (unsigned)((R + HALF) * g.lda + C) * 2u; voffB[i] = (unsigned)(Rb * g.ldb + C) * 2u; }
    const size_t kstep = (size_t)(BK * 2);
    const size_t hstepB = (size_t)HALF * g.ldb * 2;
    const unsigned ldsw = (unsigned)wid * 1024u;
    const int aoff = lds_byte(wr * 64 + fr, fq * 8), boff = lds_byte(wc * 32 + fr, fq * 8);
#define PG8_SA(b, h) (((b) * 2 + (h)) * HTB)
#define PG8_SB(b, h) ((4 + (b) * 2 + (h)) * HTB)
#define PG8_STAGE(bufoff, gbase, voff) do { _Pragma("unroll") for (int _i = 0; _i < 2; ++_i) \
        __builtin_amdgcn_global_load_lds((const unsigned*)((const char*)(gbase) + (voff)[_i]), (LAS unsigned*)(lds + (bufoff) + ldsw + _i * 8192), 16, 0, 0); } while (0)
#define PG8_STAGEA(b, h, gbase, vo) PG8_STAGE(PG8_SA(b, h), gbase, (vo)[h])
#define PG8_LDA(dst, b, h) do { _Pragma("unroll") for (int m = 0; m < 4; ++m) _Pragma("unroll") for (int k = 0; k < 2; ++k) dst[m][k] = *(const LAS bf16x8*)(lds + PG8_SA(b, h) + aoff + m * 2048 + k * 1024); } while (0)
#define PG8_LDB(dst, b, h) do { _Pragma("unroll") for (int n = 0; n < 2; ++n) _Pragma("unroll") for (int k = 0; k < 2; ++k) dst[n][k] = *(const LAS bf16x8*)(lds + PG8_SB(b, h) + boff + n * 2048 + k * 1024); } while (0)
#define PG8_MMA(ai, bj, At, Bt) do { __builtin_amdgcn_s_setprio(1); _Pragma("unroll") for (int m = 0; m < 4; ++m) _Pragma("unroll") for (int n = 0; n < 2; ++n) _Pragma("unroll") for (int k = 0; k < 2; ++k) \
        acc[ai][bj][m][n] = __builtin_amdgcn_mfma_f32_16x16x32_bf16(Bt[n][k], At[m][k], acc[ai][bj][m][n], 0, 0, 0); __builtin_amdgcn_s_setprio(0); } while (0)
#define PG8_WAIT_V(n) asm volatile("s_waitcnt vmcnt(" #n ")" ::: "memory")
#define PG8_WAIT_L(n) asm volatile("s_waitcnt lgkmcnt(" #n ")" ::: "memory")
#define PG8_BAR __builtin_amdgcn_s_barrier()
#define PG8_SCHED __builtin_amdgcn_sched_barrier(0)
    Unit cur, nxt; int ui = 0;
    if (!S.next(0, cur)) return;
    f32x4 acc[2][2][4][2];
#pragma unroll
    for (int a = 0; a < 2; ++a)
#pragma unroll
        for (int b = 0; b < 2; ++b)
#pragma unroll
            for (int m = 0; m < 4; ++m)
#pragma unroll
                for (int n = 0; n < 2; ++n) acc[a][b][m][n] = (f32x4){0.f, 0.f, 0.f, 0.f};
    bf16x8 At[4][2], B0[2][2], B1[2][2];
    const char* cA = cur.a; const char* cB = cur.b;
    int pend = -1;
    if constexpr (Sched::COUNTED) S.a_ready(cur);
    if constexpr (Sched::GATHER) {
#pragma unroll
        for (int h = 0; h < 2; ++h)
#pragma unroll
            for (int i = 0; i < 2; ++i) voffA[h][i] = S.rowoff(cur, h * HALF + RA[i]) + (unsigned)CA[i] * 2u; }
    PG8_STAGE(PG8_SB(0, 0), cB, voffB); PG8_STAGE(PG8_SB(0, 1), cB + hstepB, voffB); PG8_STAGEA(0, 0, cA, voffA); PG8_STAGEA(0, 1, cA, voffA);
    if (wr == 1) PG8_BAR;
    PG8_WAIT_V(2); PG8_BAR;
    PG8_STAGE(PG8_SB(1, 0), cB + kstep, voffB); PG8_STAGEA(1, 0, cA + kstep, voffA); PG8_STAGE(PG8_SB(1, 1), cB + hstepB + kstep, voffB);
    PG8_WAIT_V(6); PG8_BAR;
    for (;;) {
        const bool has_next = S.next(ui + 1, nxt);
        if constexpr (Sched::GATHER) { if (has_next) {
#pragma unroll
            for (int h = 0; h < 2; ++h)
#pragma unroll
                for (int i = 0; i < 2; ++i) nvoffA[h][i] = S.rowoff(nxt, h * HALF + RA[i]) + (unsigned)CA[i] * 2u; } }
        const char* nA = has_next ? nxt.a : cA; const char* nB = has_next ? nxt.b : cB;
#pragma unroll 1
        for (int t = 0; t < nt; t += 2) {
            const bool last = (t == nt - 2);
            if constexpr (Sched::COUNTED) { if (last) {
                if (pend >= 0) { S.publish(pend, lane); pend = -1; }
                if (has_next) S.a_ready(nxt); } }
            const char* a1 = cA + (size_t)(t + 1) * kstep;
            const char* a2 = last ? nA : cA + (size_t)(t + 2) * kstep; const char* b2 = last ? nB : cB + (size_t)(t + 2) * kstep;
            const char* a3 = a2 + kstep; const char* b3 = b2 + kstep;
            unsigned vo2[2][2];
#pragma unroll
            for (int h = 0; h < 2; ++h)
#pragma unroll
                for (int i = 0; i < 2; ++i) vo2[h][i] = (Sched::GATHER && last && has_next) ? nvoffA[h][i] : voffA[h][i];
            PG8_LDB(B0, 0, 0); PG8_LDB(B1, 0, 1); PG8_SCHED; PG8_LDA(At, 0, 0); PG8_STAGEA(1, 1, a1, voffA);
            PG8_WAIT_V(8); PG8_WAIT_L(0); PG8_BAR; PG8_MMA(0, 0, At, B0); PG8_MMA(0, 1, At, B1); PG8_BAR; PG8_SCHED;
            PG8_LDA(At, 0, 1); PG8_STAGE(PG8_SB(0, 0), b2, voffB); PG8_STAGE(PG8_SB(0, 1), b2 + hstepB, voffB); PG8_STAGEA(0, 0, a2, vo2);
            PG8_WAIT_V(8); PG8_WAIT_L(0); PG8_BAR; PG8_MMA(1, 0, At, B0); PG8_MMA(1, 1, At, B1); PG8_BAR; PG8_SCHED;
            PG8_LDB(B0, 1, 0); PG8_LDB(B1, 1, 1); PG8_SCHED; PG8_LDA(At, 1, 0); PG8_STAGEA(0, 1, a2, vo2);
            PG8_WAIT_V(8); PG8_WAIT_L(0); PG8_BAR; PG8_MMA(0, 0, At, B0); PG8_MMA(0, 1, At, B1); PG8_BAR; PG8_SCHED;
            PG8_LDA(At, 1, 1); PG8_STAGE(PG8_SB(1, 0), b3, voffB); PG8_STAGE(PG8_SB(1, 1), b3 + hstepB, voffB); PG8_STAGEA(1, 0, a3, vo2);
            PG8_WAIT_V(8); PG8_WAIT_L(0); PG8_BAR; PG8_MMA(1, 0, At, B0); PG8_MMA(1, 1, At, B1); PG8_BAR; PG8_SCHED;
            if constexpr (Epi::SEG > 0) {
                if (!last && ((t + 2) % Epi::SEG) == 0) { int fr_e = fr, fq_e = fq; asm volatile("" : "+v"(fr_e), "+v"(fq_e)); E.mid(acc, cur, (t + 2) / Epi::SEG - 1, wr, wc, fr_e, fq_e); } }
        }
        if (wr == 0) PG8_BAR;
        { int fr_e = fr, fq_e = fq; asm volatile("" : "+v"(fr_e), "+v"(fq_e));
          E(acc, cur, wr, wc, fr_e, fq_e); }
        if constexpr (Sched::COUNTED) pend = S.pending(cur);
        if (!has_next) break;
#pragma unroll
        for (int a = 0; a < 2; ++a)
#pragma unroll
            for (int b = 0; b < 2; ++b)
#pragma unroll
                for (int m = 0; m < 4; ++m)
#pragma unroll
                    for (int n = 0; n < 2; ++n) acc[a][b][m][n] = (f32x4){0.f, 0.f, 0.f, 0.f};
        cur = nxt; cA = nA; cB = nB; ++ui;
        if constexpr (Sched::GATHER) {
#pragma unroll
            for (int h = 0; h < 2; ++h)
#pragma unroll
                for (int i = 0; i < 2; ++i) voffA[h][i] = nvoffA[h][i]; }
        if (wr == 1) PG8_BAR;
    }
    PG8_WAIT_V(0);
    if constexpr (Sched::COUNTED) { if (pend >= 0) S.publish(pend, lane); }
    PG8_BAR;
#undef PG8_SA
#undef PG8_SB
#undef PG8_STAGE
#undef PG8_STAGEA
#undef PG8_LDA
#undef PG8_LDB
#undef PG8_MMA
#undef PG8_WAIT_V
#undef PG8_WAIT_L
#undef PG8_BAR
#undef PG8_SCHED
}
}

#define XB_TMO      128
#define XB_XCNT(j)  (256  + 64 * (j))
#define XB_XSUB(j)  (1280 + 64 * (j))
#define XB_XGEN(j)  (2304 + 64 * (j))
#define XB_TOP      3328
#define XB_TOPGEN   3392
#define XCD_BAR_WORDS 3456
#define XB_SPIN_CAP (1u << 18)
__device__ __forceinline__ unsigned xb_ld(unsigned* p)              { return __hip_atomic_load(p, __ATOMIC_RELAXED, __HIP_MEMORY_SCOPE_AGENT); }
__device__ __forceinline__ unsigned xb_add(unsigned* p, unsigned v) { return __hip_atomic_fetch_add(p, v, __ATOMIC_RELAXED, __HIP_MEMORY_SCOPE_AGENT); }
__device__ __forceinline__ unsigned xb_xcc_id() { return (unsigned)__builtin_amdgcn_s_getreg((3 << 11) | 20) & 0xFu; }
#define XB_SPIN(cond, bar) do { unsigned _sp = 0; while (cond) { __builtin_amdgcn_s_sleep(1); \
    if ((++_sp & 255u) == 0u) { if (xb_ld(&(bar)[XB_TMO])) break; if (_sp > XB_SPIN_CAP) { atomicAdd(&(bar)[XB_TMO], 1u); break; } } } } while (0)
struct XcdBarrier { unsigned* bar; unsigned x; volatile LAS unsigned* st; };
__device__ __forceinline__ XcdBarrier xcd_barrier_post(unsigned* bar, volatile LAS unsigned* st) {
    XcdBarrier b; b.bar = bar; b.x = xb_xcc_id(); b.st = st;
    if (threadIdx.x == 0) (void)xb_add(&bar[XB_XCNT(b.x)], 1u);
    return b;
}
__device__ __forceinline__ void xcd_barrier_complete(unsigned* bar, unsigned x, unsigned& nloc, unsigned& nx) {
    const unsigned G = gridDim.x * gridDim.y * gridDim.z;
    unsigned sum, cnt, mine, sp = 0u;
    for (;;) {
        sum = 0u; cnt = 0u; mine = 0u;
#pragma unroll
        for (unsigned j = 0; j < 16; ++j) { const unsigned c = xb_ld(&bar[XB_XCNT(j)]); sum += c; cnt += (c > 0u) ? 1u : 0u; mine = (j == x) ? c : mine; }
        if (sum == G) break;
        __builtin_amdgcn_s_sleep(1);
        if ((++sp & 255u) == 0u) { if (xb_ld(&bar[XB_TMO])) break; if (sp > XB_SPIN_CAP) { atomicAdd(&bar[XB_TMO], 1u); break; } }
    }
    nloc = mine > 0u ? mine : 1u; nx = cnt > 0u ? cnt : 1u;
}
__device__ __forceinline__ void xcd_barrier(const XcdBarrier& b) {
    asm volatile("s_waitcnt vmcnt(0)" ::: "memory");
    __syncthreads();
    if (threadIdx.x == 0) {
        unsigned* bar = b.bar;
        __builtin_amdgcn_s_waitcnt(0);
        unsigned nloc = b.st[0], nx = b.st[1];
        if (nloc == 0u) { xcd_barrier_complete(bar, b.x, nloc, nx); b.st[0] = nloc; b.st[1] = nx; }
        const unsigned old = xb_add(&bar[XB_XSUB(b.x)], 1u);
        const unsigned gen = old / nloc;
        if (old + 1u == (gen + 1u) * nloc) {
            __builtin_amdgcn_fence(__ATOMIC_RELEASE, "agent");
            asm volatile("s_waitcnt vmcnt(0)" ::: "memory");
            const unsigned og = xb_add(&bar[XB_TOP], 1u);
            const unsigned tg = og / nx;
            if (og + 1u == (tg + 1u) * nx) xb_add(&bar[XB_TOPGEN], 1u);
            else XB_SPIN(xb_ld(&bar[XB_TOPGEN]) == tg, bar);
            xb_add(&bar[XB_XGEN(b.x)], 1u);
            __builtin_amdgcn_fence(__ATOMIC_ACQUIRE, "agent");
            asm volatile("s_waitcnt vmcnt(0)" ::: "memory");
        } else {
            asm volatile("buffer_inv sc1" ::: "memory");
            XB_SPIN(xb_ld(&bar[XB_XGEN(b.x)]) == gen, bar);
            asm volatile("s_waitcnt vmcnt(0)" ::: "memory");
        }
    }
    __syncthreads();
}
constexpr size_t al256(size_t x) { return (x + 255) & ~(size_t)255; }
constexpr size_t WS_CTL = 0, CTL_BYTES = 256u << 10;
constexpr size_t SZ_WIN = (size_t)ZC * 1024 * 2, SZ_WBR = (size_t)4 * 1024 * 512 * 2, SZ_W1K = (size_t)1024 * 1024 * 2, SZ_WKV = 2 * SZ_W1K;
constexpr size_t SZ_W1 = (size_t)NEXP * 2048 * 1024 * 2, SZ_W2 = (size_t)NEXP * 1024 * 1024 * 2;
constexpr size_t LW_WIN = 0, LW_WBR = LW_WIN + SZ_WIN, LW_WOUT = LW_WBR + SZ_WBR, LW_WQ = LW_WOUT + SZ_W1K, LW_WKV = LW_WQ + SZ_W1K, LW_WO = LW_WKV + SZ_WKV,
                 LW_W1 = LW_WO + SZ_W1K, LW_W2 = LW_W1 + SZ_W1, LW_END = LW_W2 + SZ_W2;
constexpr size_t WS_W = WS_CTL + CTL_BYTES;
constexpr size_t WS_MEMB = WS_W + NL_ * LW_END;
constexpr size_t WS_KMEM = WS_MEMB + SZ_W1K;
constexpr size_t WS_MQT = WS_KMEM + NL_ * 2 * SZ_W1K;
constexpr size_t WS_VWT = WS_MQT + NL_ * 4 * SZ_W1K;
constexpr size_t WS_H = WS_VWT + NL_ * 4 * SZ_W1K;
constexpr size_t WS_HB = WS_H + (size_t)T_ * 1024 * 4;
constexpr size_t WS_Z = WS_HB + (size_t)T_ * 1024 * 2;
constexpr size_t WS_BCUM = WS_Z + (size_t)T_ * ZC * 2;
constexpr size_t WS_KVST = WS_BCUM + (size_t)T_ * 256 * 4;
constexpr size_t WS_SPREV = WS_KVST + (size_t)4 * 64 * 4 * 64 * 128 * 4;
constexpr size_t WS_LAGG = WS_SPREV + (size_t)4 * 64 * 4 * 64 * 128 * 4;
constexpr size_t WS_YS = WS_LAGG + (size_t)3 * 4 * 64 * 512 * 4;
constexpr size_t WS_MF = WS_YS + (size_t)T_ * 2048 * 2;
constexpr size_t WS_MB = WS_MF + (size_t)3 * T_ * 1024 * 2;
constexpr size_t WS_PRE = WS_MB + (size_t)T_ * 1024 * 2;
constexpr size_t WS_Q = WS_PRE + (size_t)T_ * 1024 * 4;
constexpr size_t WS_P = WS_Q + (size_t)T_ * 1024 * 2;
constexpr size_t WS_O = WS_P + (size_t)T_ * 1024 * 2;
constexpr size_t WS_TOKE = WS_O + (size_t)T_ * 1024 * 2;
constexpr size_t WS_TOKR = WS_TOKE + (size_t)T_ * 4 * 4;
constexpr size_t WS_TOKG = WS_TOKR + (size_t)T_ * 4 * 4;
constexpr size_t WS_TOKS = WS_TOKG + (size_t)T_ * 4 * 4;
constexpr size_t WS_SGATE = WS_TOKS + (size_t)T_ * 4 * 4;
constexpr size_t WS_XS = al256(WS_SGATE + (size_t)NSLOT * 4);
constexpr size_t WS_ACT = WS_XS + (size_t)NSLOT * 1024 * 2;
constexpr size_t WS_YSL = WS_ACT + (size_t)NSLOT * 1024 * 2;
constexpr size_t WS_ELIST = WS_YSL + (size_t)NSLOT * 1024 * 2;
constexpr size_t WS_XLN = WS_ELIST + (size_t)NEXP * T_ * 4;
constexpr size_t WS_LGW = WS_XLN + (size_t)64 * 4 * 256 * 8;
constexpr size_t WS_WLR = WS_LGW + (size_t)NL_ * 2 * 8 * 64 * 64 * 2;
constexpr size_t WS_RWS = WS_WLR + (size_t)NL_ * 16 * 1024 * 2;
constexpr size_t WS_XRT = WS_RWS + (size_t)NL_ * 2 * 32 * 1024 * 2;
constexpr size_t WS_END = WS_XRT + (size_t)64 * 4 * 256 * 32 * 4;

constexpr int CW_BAR = 0;
constexpr int CW_CNT = 8 * XCD_BAR_WORDS;
constexpr int CW_LN = CW_CNT + NL_ * 32 * 16;
constexpr int CW_RT = CW_LN + NL_ * 2 * 64 * 16;
constexpr int CW_MOE = CW_RT + NL_ * 64 * 16;
static_assert((CW_MOE + NL_ * 288 * 16) * 4 <= (int)CTL_BYTES, "control words");

constexpr int LDS_STAGE = 0, LDS_MISC = 131072, LDS_BYTES = 147456;
constexpr int MISC_XCH = 0;
constexpr int MISC_MOE = 8192;
constexpr int MISC_RED = 9216;
constexpr int MISC_STAT = 10240;
constexpr int MISC_R2E = 12288;
constexpr int MISC_BAR = 16368;

struct Params { const float* in[39]; float* out; unsigned char* ws; int ph_lo, ph_hi, li, pad; };
typedef const Params __attribute__((address_space(4)))* KP;

enum { I_X = 0, I_MEM, I_LN0G, I_LN0B, I_WIN, I_BIN, I_CAW, I_CAB, I_LNAG, I_LNAB, I_WA2, I_GBA, I_GNG, I_CDW, I_CDB, I_LWA, I_LBA, I_LWX, I_LBX, I_LLAM,
       I_WBR, I_WOUT, I_BOUT, I_LN1G, I_LN1B, I_WQ, I_WK, I_WV, I_WO, I_LN2G, I_LN2B, I_RW, I_RB, I_W1, I_B1, I_W2, I_B2, I_LN3G, I_LN3B };

using pg8::Unit;
typedef f32x4 (AccT)[2][2][4][2];

template <bool SIG = false>
struct EpiStoreBf16T {
    static constexpr bool PERM = true; static constexpr int SEG = 0;
    const float* bias; float scale;
    __device__ __forceinline__ void operator()(f32x4 (&acc)[2][2][4][2], const Unit& u, int wr, int wc, int fr, int fq) const {
        bf16_t* base = (bf16_t*)u.c;
        const int colb = wc * 32 + 8 * fq;
        f32x4 bv[2][2];
#pragma unroll
        for (int bj = 0; bj < 2; ++bj)
#pragma unroll
            for (int n = 0; n < 2; ++n) bv[bj][n] = bias ? *(const f32x4*)(bias + u.col0 + u.aux + colb + bj * 128 + 4 * n) : (f32x4){0.f, 0.f, 0.f, 0.f};
#pragma unroll
        for (int ai = 0; ai < 2; ++ai)
#pragma unroll
            for (int m = 0; m < 4; ++m) {
                bf16_t* rowp = base + (size_t)(ai * 128 + wr * 64 + m * 16 + fr) * u.ldc + colb;
#pragma unroll
                for (int bj = 0; bj < 2; ++bj) {
                    f32x4 v0 = (acc[ai][bj][m][0] + bv[bj][0]) * scale, v1 = (acc[ai][bj][m][1] + bv[bj][1]) * scale;
                    if (SIG && u.col0 >= Z_GM) {
#pragma unroll
                        for (int e4 = 0; e4 < 4; ++e4) { v0[e4] = fminf(1.f + __expf(-v0[e4]), 1048576.f); v1[e4] = fminf(1.f + __expf(-v1[e4]), 1048576.f); } }
                    u32x4 w; w.x = pk2(v0[0], v0[1]); w.y = pk2(v0[2], v0[3]); w.z = pk2(v1[0], v1[1]); w.w = pk2(v1[2], v1[3]);
                    *(u32x4*)(rowp + bj * 128) = w;
                }
            }
    }
};
typedef EpiStoreBf16T<false> EpiStoreBf16;

struct EpiMerge {
    static constexpr bool PERM = true; static constexpr int SEG = 8;
    const bf16_t* z; bf16_t* mb; int dbg;
    static __device__ __forceinline__ float gfl(float g) { return fmaxf(g, 9.5367431640625e-7f); }
    __device__ __forceinline__ void mid(f32x4 (&acc)[2][2][4][2], const Unit& u, int seg, int wr, int wc, int fr, int fq) const {
        const int colb = u.col0 + wc * 32 + 8 * fq;
#pragma unroll
        for (int ai = 0; ai < 2; ++ai) {
            u32x4 ga[4][2], gb[4][2];
#pragma unroll
            for (int m = 0; m < 4; ++m)
#pragma unroll
                for (int bj = 0; bj < 2; ++bj) { const bf16_t* gp = z + (size_t)(u.row0 + ai * 128 + wr * 64 + m * 16 + fr) * ZC + Z_GM + seg * 1024 + colb + bj * 128;
                    ga[m][bj] = *(const u32x4*)gp; gb[m][bj] = *(const u32x4*)(gp + 1024); }
#pragma unroll
            for (int m = 0; m < 4; ++m)
#pragma unroll
                for (int bj = 0; bj < 2; ++bj) { const u32x4 a = ga[m][bj], b = gb[m][bj];
                    const unsigned aw[4] = {a.x, a.y, a.z, a.w}, bw[4] = {b.x, b.y, b.z, b.w};
#pragma unroll
                    for (int e = 0; e < 4; ++e) { const float r0 = bflo(bw[e]) * __builtin_amdgcn_rcpf(bflo(aw[e])), r1 = bfhi(bw[e]) * __builtin_amdgcn_rcpf(bfhi(aw[e]));
                        acc[ai][bj][m][e >> 1][2 * (e & 1)] *= r0; acc[ai][bj][m][e >> 1][2 * (e & 1) + 1] *= r1; } }
        }
    }
    __device__ __forceinline__ void operator()(f32x4 (&acc)[2][2][4][2], const Unit& u, int wr, int wc, int fr, int fq) const {
        if (dbg & 16) return;
        const int colb = u.col0 + wc * 32 + 8 * fq;
#pragma unroll
        for (int ai = 0; ai < 2; ++ai) {
            u32x4 gz[4][2];
#pragma unroll
            for (int m = 0; m < 4; ++m)
#pragma unroll
                for (int bj = 0; bj < 2; ++bj) gz[m][bj] = *(const u32x4*)(z + (size_t)(u.row0 + ai * 128 + wr * 64 + m * 16 + fr) * ZC + Z_GM + 3 * 1024 + colb + bj * 128);
#pragma unroll
            for (int m = 0; m < 4; ++m)
#pragma unroll
                for (int bj = 0; bj < 2; ++bj) { const u32x4 g4 = gz[m][bj]; const f32x4 a0 = acc[ai][bj][m][0], a1 = acc[ai][bj][m][1];
                    u32x4 w; w.x = pk2(a0[0] * __builtin_amdgcn_rcpf(bflo(g4.x)), a0[1] * __builtin_amdgcn_rcpf(bfhi(g4.x))); w.y = pk2(a0[2] * __builtin_amdgcn_rcpf(bflo(g4.y)), a0[3] * __builtin_amdgcn_rcpf(bfhi(g4.y)));
                    w.z = pk2(a1[0] * __builtin_amdgcn_rcpf(bflo(g4.z)), a1[1] * __builtin_amdgcn_rcpf(bfhi(g4.z))); w.w = pk2(a1[2] * __builtin_amdgcn_rcpf(bflo(g4.w)), a1[3] * __builtin_amdgcn_rcpf(bfhi(g4.w)));
                    *(u32x4*)(mb + (size_t)(u.row0 + ai * 128 + wr * 64 + m * 16 + fr) * 1024 + colb + bj * 128) = w; }
        }
    }
};

struct EpiResid {
    static constexpr bool PERM = false; static constexpr int SEG = 0;
    const float* bias; const float* h; float* pre;
    __device__ __forceinline__ void operator()(f32x4 (&acc)[2][2][4][2], const Unit& u, int wr, int wc, int fr, int fq) const {
        const int colb = u.col0 + wc * 32 + 4 * fq;
        f32x4 bv[2][2];
#pragma unroll
        for (int bj = 0; bj < 2; ++bj)
#pragma unroll
            for (int n = 0; n < 2; ++n) bv[bj][n] = bias ? *(const f32x4*)(bias + colb + bj * 128 + n * 16) : (f32x4){0.f, 0.f, 0.f, 0.f};
#pragma unroll
        for (int ai = 0; ai < 2; ++ai)
#pragma unroll
            for (int mh = 0; mh < 2; ++mh) {
                f32x4 hv[2][2][2];
#pragma unroll
                for (int mm = 0; mm < 2; ++mm) { const int row = u.row0 + ai * 128 + wr * 64 + (2 * mh + mm) * 16 + fr;
#pragma unroll
                    for (int bj = 0; bj < 2; ++bj)
#pragma unroll
                        for (int n = 0; n < 2; ++n) hv[mm][bj][n] = *(const f32x4*)(h + (size_t)row * 1024 + colb + bj * 128 + n * 16); }
#pragma unroll
                for (int mm = 0; mm < 2; ++mm) { const int row = u.row0 + ai * 128 + wr * 64 + (2 * mh + mm) * 16 + fr;
#pragma unroll
                    for (int bj = 0; bj < 2; ++bj)
#pragma unroll
                        for (int n = 0; n < 2; ++n) *(f32x4*)(pre + (size_t)row * 1024 + colb + bj * 128 + n * 16) = acc[ai][bj][2 * mh + mm][n] + DN_ALPHA * hv[mm][bj][n] + bv[bj][n]; }
            }
    }
};

template <bool WF32  , bool ROUTE  >
struct EpiResidLNT {
    static constexpr bool PERM = true; static constexpr int SEG = 0;
    const float* bias; const float* g; const float* b; unsigned char* ws; LAS float* xch; LAS float* stats; unsigned* cnt;
    LAS char* sl; const float* rbias; int l;
    __device__ __forceinline__ void operator()(f32x4 (&acc)[2][2][4][2], const Unit& u, int wr, int wc, int fr, int fq) const {
        float* hf = (float*)(ws + WS_H); bf16_t* hb = (bf16_t*)(ws + WS_HB); unsigned long long* xbuf = (unsigned long long*)(ws + WS_XLN);
        const int tid = threadIdx.x, colb = u.col0 + wc * 32 + 8 * fq, panel = u.row0 >> 8, pn = u.col0 >> 8;
        const unsigned e0 = (unsigned)((u.row0 + wr * 64 + fr) * 1024 + colb);
#pragma unroll
        for (int bj = 0; bj < 2; ++bj) {
            u32x4 hv[2][4];
#pragma unroll
            for (int ai = 0; ai < 2; ++ai)
#pragma unroll
                for (int m = 0; m < 4; ++m) hv[ai][m] = *(const u32x4*)((const char*)hb + (size_t)((e0 + (unsigned)((ai * 128 + m * 16) * 1024 + bj * 128)) * 2u));
            const f32x4 bv0 = bias ? *(const f32x4*)(bias + colb + bj * 128) : (f32x4){0.f, 0.f, 0.f, 0.f}, bv1 = bias ? *(const f32x4*)(bias + colb + bj * 128 + 4) : (f32x4){0.f, 0.f, 0.f, 0.f};
#pragma unroll
            for (int ai = 0; ai < 2; ++ai) {
#pragma unroll
                for (int m = 0; m < 4; ++m) { const u32x4 x = hv[ai][m];
                    acc[ai][bj][m][0] = acc[ai][bj][m][0] + DN_ALPHA * (f32x4){bflo(x.x), bfhi(x.x), bflo(x.y), bfhi(x.y)} + bv0;
                    acc[ai][bj][m][1] = acc[ai][bj][m][1] + DN_ALPHA * (f32x4){bflo(x.z), bfhi(x.z), bflo(x.w), bfhi(x.w)} + bv1; }
                asm volatile("" : "+v"(acc[ai][bj][0][0]), "+v"(acc[ai][bj][1][0]), "+v"(acc[ai][bj][2][0]), "+v"(acc[ai][bj][3][0]), "+v"(acc[ai][bj][0][1]), "+v"(acc[ai][bj][1][1]), "+v"(acc[ai][bj][2][1]), "+v"(acc[ai][bj][3][1]) :: "memory"); }
        }
#pragma unroll
        for (int ai = 0; ai < 2; ++ai)
#pragma unroll
            for (int m = 0; m < 4; ++m) { float s1 = 0.f, s2 = 0.f;
#pragma unroll
                for (int bj = 0; bj < 2; ++bj)
#pragma unroll
                    for (int n = 0; n < 2; ++n) { const f32x4 a = acc[ai][bj][m][n]; s1 += (a[0] + a[1]) + (a[2] + a[3]); s2 += (a[0] * a[0] + a[1] * a[1]) + (a[2] * a[2] + a[3] * a[3]); }
                s1 += __shfl_xor(s1, 16); s1 += __shfl_xor(s1, 32); s2 += __shfl_xor(s2, 16); s2 += __shfl_xor(s2, 32);
                if (fq == 0) { const int r = ai * 128 + wr * 64 + m * 16 + fr; xch[wc * 256 + r] = s1; xch[1024 + wc * 256 + r] = s2; } }
        LDS_WAIT(); __builtin_amdgcn_s_barrier(); asm volatile("" ::: "memory");
        if (tid < 256) { const float s1 = (xch[tid] + xch[256 + tid]) + (xch[512 + tid] + xch[768 + tid]), s2 = (xch[1024 + tid] + xch[1280 + tid]) + (xch[1536 + tid] + xch[1792 + tid]);
            __hip_atomic_store(xbuf + ((size_t)panel * 4 + pn) * 256 + tid, ((unsigned long long)__float_as_uint(s2) << 32) | (unsigned long long)__float_as_uint(s1), __ATOMIC_RELAXED, __HIP_MEMORY_SCOPE_AGENT); }
        asm volatile("s_waitcnt vmcnt(0)" ::: "memory"); __builtin_amdgcn_s_barrier(); asm volatile("" ::: "memory");
        if (tid == 0) { unsigned* cp = cnt + panel * 16; __hip_atomic_fetch_add(cp, 1u, __ATOMIC_RELAXED, __HIP_MEMORY_SCOPE_AGENT);
            unsigned sp = 0; while (__hip_atomic_load(cp, __ATOMIC_RELAXED, __HIP_MEMORY_SCOPE_AGENT) < 4u && ++sp < (1u << 22)) __builtin_amdgcn_s_sleep(1); }
        asm volatile("s_waitcnt vmcnt(0) lgkmcnt(0)" ::: "memory"); __builtin_amdgcn_s_barrier(); asm volatile("" ::: "memory");
        if (tid < 256) { float S1 = 0.f, S2 = 0.f;
#pragma unroll
            for (int j = 0; j < 4; ++j) { const unsigned long long x = __hip_atomic_load(xbuf + ((size_t)panel * 4 + j) * 256 + tid, __ATOMIC_RELAXED, __HIP_MEMORY_SCOPE_AGENT); S1 += __uint_as_float((unsigned)x); S2 += __uint_as_float((unsigned)(x >> 32)); }
            const float mean = S1 * (1.f / 1024.f); stats[2 * tid] = mean; stats[2 * tid + 1] = 1.f / sqrtf(fmaxf(S2 * (1.f / 1024.f) - mean * mean, 0.f) + LN_EPS); }
        LDS_WAIT(); __builtin_amdgcn_s_barrier(); asm volatile("" ::: "memory");
        unsigned e2 = e0; asm volatile("" : "+v"(e2));
        const int col2 = (int)(e2 & 1023u);
        if (ROUTE) {
            const bf16_t* rwh = (const bf16_t*)(ws + WS_RWS) + (size_t)l * 2 * 32 * 1024; const bf16_t* rwl = rwh + 32 * 1024;
            bf16x8 Bh[2][2], Bl[2][2]; f32x4 gv[2][2], bb[2][2];
#pragma unroll
            for (int bj = 0; bj < 2; ++bj) { gv[bj][0] = *(const f32x4*)(g + col2 + bj * 128); gv[bj][1] = *(const f32x4*)(g + col2 + bj * 128 + 4); bb[bj][0] = *(const f32x4*)(b + col2 + bj * 128); bb[bj][1] = *(const f32x4*)(b + col2 + bj * 128 + 4);
#pragma unroll
                for (int eb = 0; eb < 2; ++eb) { Bh[bj][eb] = *(const bf16x8*)(rwh + (size_t)(16 * eb + fr) * 1024 + col2 + bj * 128); Bl[bj][eb] = *(const bf16x8*)(rwl + (size_t)(16 * eb + fr) * 1024 + col2 + bj * 128); } }
            LAS float* plog = (LAS float*)sl;
#pragma unroll
            for (int ai = 0; ai < 2; ++ai)
#pragma unroll
                for (int m = 0; m < 4; ++m) { const int r = ai * 128 + wr * 64 + m * 16 + fr; const float mean = stats[2 * r], rstd = stats[2 * r + 1];
                    f32x4 L0 = (f32x4){0.f, 0.f, 0.f, 0.f}, L1 = (f32x4){0.f, 0.f, 0.f, 0.f};
#pragma unroll
                    for (int bj = 0; bj < 2; ++bj) { const unsigned eo = e2 + (unsigned)((ai * 128 + m * 16) * 1024 + bj * 128);
                        const f32x4 y0 = (acc[ai][bj][m][0] - mean) * rstd * gv[bj][0] + bb[bj][0], y1 = (acc[ai][bj][m][1] - mean) * rstd * gv[bj][1] + bb[bj][1];
                        if (WF32) { *(f32x4*)((char*)hf + (size_t)(eo * 4u)) = y0; *(f32x4*)((char*)hf + (size_t)(eo * 4u) + 16) = y1; }
                        u32x4 w; w.x = pk2(y0[0], y0[1]); w.y = pk2(y0[2], y0[3]); w.z = pk2(y1[0], y1[1]); w.w = pk2(y1[2], y1[3]); *(u32x4*)((char*)hb + (size_t)(eo * 2u)) = w;
                        u32x4 lo; lo.x = pk2(y0[0] - bflo(w.x), y0[1] - bfhi(w.x)); lo.y = pk2(y0[2] - bflo(w.y), y0[3] - bfhi(w.y)); lo.z = pk2(y1[0] - bflo(w.z), y1[1] - bfhi(w.z)); lo.w = pk2(y1[2] - bflo(w.w), y1[3] - bfhi(w.w));
                        const bf16x8 ah = __builtin_bit_cast(bf16x8, w), al = __builtin_bit_cast(bf16x8, lo);
                        L0 = __builtin_amdgcn_mfma_f32_16x16x32_bf16(ah, Bh[bj][0], L0, 0, 0, 0); L0 = __builtin_amdgcn_mfma_f32_16x16x32_bf16(ah, Bl[bj][0], L0, 0, 0, 0); L0 = __builtin_amdgcn_mfma_f32_16x16x32_bf16(al, Bh[bj][0], L0, 0, 0, 0);
                        L1 = __builtin_amdgcn_mfma_f32_16x16x32_bf16(ah, Bh[bj][1], L1, 0, 0, 0); L1 = __builtin_amdgcn_mfma_f32_16x16x32_bf16(ah, Bl[bj][1], L1, 0, 0, 0); L1 = __builtin_amdgcn_mfma_f32_16x16x32_bf16(al, Bh[bj][1], L1, 0, 0, 0); }
                    const int rt = wc * 256 + ai * 128 + wr * 64 + m * 16 + 4 * fq;
#pragma unroll
                    for (int j = 0; j < 4; ++j) { plog[(rt + j) * 32 + fr] = L0[j]; plog[(rt + j) * 32 + 16 + fr] = L1[j]; } }
            LDS_WAIT(); __builtin_amdgcn_s_barrier(); asm volatile("" ::: "memory");
            int t2 = tid; asm volatile("" : "+v"(t2));
            unsigned long long* xrt = (unsigned long long*)(ws + WS_XRT);
            { unsigned long long* dst = xrt + ((size_t)panel * 4 + pn) * 4096;
#pragma unroll
                for (int k = 0; k < 8; ++k) { const int o = (k * 512 + t2) * 2;
                    const f32x2 s = (*(const LAS f32x2*)(plog + o) + *(const LAS f32x2*)(plog + 8192 + o)) + (*(const LAS f32x2*)(plog + 16384 + o) + *(const LAS f32x2*)(plog + 24576 + o));
                    __hip_atomic_store(dst + k * 512 + t2, ((unsigned long long)__float_as_uint(s[1]) << 32) | (unsigned long long)__float_as_uint(s[0]), __ATOMIC_RELAXED, __HIP_MEMORY_SCOPE_AGENT); } }
            asm volatile("s_waitcnt vmcnt(0) lgkmcnt(0)" ::: "memory"); __builtin_amdgcn_s_barrier(); asm volatile("" ::: "memory");
            LAS int* lcnt = (LAS int*)sl; LAS int* lbase = lcnt + 32;
            if (t2 < 32) lcnt[t2] = 0;
            if (t2 == 0) { unsigned* cp = (unsigned*)(ws + WS_CTL) + CW_RT + (l * 64 + panel) * 16; __hip_atomic_fetch_add(cp, 1u, __ATOMIC_RELAXED, __HIP_MEMORY_SCOPE_AGENT);
                unsigned sp = 0; while (__hip_atomic_load(cp, __ATOMIC_RELAXED, __HIP_MEMORY_SCOPE_AGENT) < 4u && ++sp < (1u << 22)) __builtin_amdgcn_s_sleep(1); }
            asm volatile("s_waitcnt vmcnt(0) lgkmcnt(0)" ::: "memory"); __builtin_amdgcn_s_barrier(); asm volatile("" ::: "memory");
            const int rowl = t2 >> 3, sub = t2 & 7, e4 = sub * 4;
            float v[4]; v[0] = rbias[e4]; v[1] = rbias[e4 + 1]; v[2] = rbias[e4 + 2]; v[3] = rbias[e4 + 3];
#pragma unroll
            for (int j = 0; j < 4; ++j) { const unsigned long long* src = xrt + ((((size_t)panel * 4 + j) * 256 + pn * 64 + rowl) * 32 + e4) / 2;
                const unsigned long long x0 = __hip_atomic_load(src, __ATOMIC_RELAXED, __HIP_MEMORY_SCOPE_AGENT), x1 = __hip_atomic_load(src + 1, __ATOMIC_RELAXED, __HIP_MEMORY_SCOPE_AGENT);
                v[0] += __uint_as_float((unsigned)x0); v[1] += __uint_as_float((unsigned)(x0 >> 32)); v[2] += __uint_as_float((unsigned)x1); v[3] += __uint_as_float((unsigned)(x1 >> 32)); }
            int ti[4]; float tv[4];
#pragma unroll
            for (int k = 0; k < 4; ++k) { float best = v[0]; int bi = e4;
#pragma unroll
                for (int i = 1; i < 4; ++i) { const bool ok = v[i] > best; best = ok ? v[i] : best; bi = ok ? e4 + i : bi; }
#pragma unroll
                for (int d = 1; d < 8; d <<= 1) { const float ob = __shfl_xor(best, d); const int oi = __shfl_xor(bi, d); const bool tk = (ob > best) || (ob == best && oi < bi); best = tk ? ob : best; bi = tk ? oi : bi; }
                tv[k] = best; ti[k] = bi;
#pragma unroll
                for (int i = 0; i < 4; ++i) v[i] = (bi == e4 + i) ? -3.0e38f : v[i]; }
            const float ev1 = __expf(tv[1] - tv[0]), ev2 = __expf(tv[2] - tv[0]), ev3 = __expf(tv[3] - tv[0]);
            const float inv = 1.f / (1.f + ev1 + ev2 + ev3);
            const int myi = sub == 0 ? ti[0] : sub == 1 ? ti[1] : sub == 2 ? ti[2] : ti[3]; const float myg = (sub == 0 ? 1.f : sub == 1 ? ev1 : sub == 2 ? ev2 : ev3) * inv;
            int lr = 0; if (sub < 4) lr = (int)atomicAdd((unsigned*)(lcnt + myi), 1u);
            LDS_WAIT(); __builtin_amdgcn_s_barrier(); asm volatile("" ::: "memory");
            unsigned* ecnt = (unsigned*)(ws + WS_CTL) + CW_CNT + l * 32 * 16;
            if (t2 < 32) { const unsigned n = (unsigned)lcnt[t2]; lbase[t2] = n ? (int)atomicAdd(ecnt + t2 * 16, n) : 0; }
            asm volatile("s_waitcnt vmcnt(0) lgkmcnt(0)" ::: "memory"); __builtin_amdgcn_s_barrier(); asm volatile("" ::: "memory");
            if (sub < 4) { const int mm = u.row0 + pn * 64 + rowl; const int rk = lbase[myi] + lr;
                ((int*)(ws + WS_TOKE))[mm * 4 + sub] = myi; ((int*)(ws + WS_TOKR))[mm * 4 + sub] = rk; ((float*)(ws + WS_TOKG))[mm * 4 + sub] = myg; ((int*)(ws + WS_ELIST))[(size_t)myi * T_ + rk] = mm; }
        } else {
#pragma unroll
        for (int bj = 0; bj < 2; ++bj) { const f32x4 g0 = *(const f32x4*)(g + col2 + bj * 128), g1 = *(const f32x4*)(g + col2 + bj * 128 + 4), b0 = *(const f32x4*)(b + col2 + bj * 128), b1 = *(const f32x4*)(b + col2 + bj * 128 + 4);
#pragma unroll
            for (int ai = 0; ai < 2; ++ai)
#pragma unroll
                for (int m = 0; m < 4; ++m) { const int r = ai * 128 + wr * 64 + m * 16 + fr; const float mean = stats[2 * r], rstd = stats[2 * r + 1];
                    const unsigned eo = e2 + (unsigned)((ai * 128 + m * 16) * 1024 + bj * 128);
                    const f32x4 y0 = (acc[ai][bj][m][0] - mean) * rstd * g0 + b0, y1 = (acc[ai][bj][m][1] - mean) * rstd * g1 + b1;
                    if (WF32) { *(f32x4*)((char*)hf + (size_t)(eo * 4u)) = y0; *(f32x4*)((char*)hf + (size_t)(eo * 4u) + 16) = y1; }
                    u32x4 w; w.x = pk2(y0[0], y0[1]); w.y = pk2(y0[2], y0[3]); w.z = pk2(y1[0], y1[1]); w.w = pk2(y1[2], y1[3]); *(u32x4*)((char*)hb + (size_t)(eo * 2u)) = w; } }

        }
    }
};

struct EpiSoftmax {
    static constexpr bool PERM = true; static constexpr int SEG = 0;
    LAS float* xch;
    __device__ __forceinline__ void operator()(f32x4 (&acc)[2][2][4][2], const Unit& u, int wr, int wc, int fr, int fq) const {
        LAS float* xm = xch; LAS float* xs = xch + 1024;
#pragma unroll
        for (int ai = 0; ai < 2; ++ai)
#pragma unroll
            for (int m = 0; m < 4; ++m) {
                float v = -3.0e38f;
#pragma unroll
                for (int bj = 0; bj < 2; ++bj)
#pragma unroll
                    for (int n = 0; n < 2; ++n) { const f32x4 a = acc[ai][bj][m][n]; v = fmaxf(v, fmaxf(fmaxf(a[0], a[1]), fmaxf(a[2], a[3]))); }
                v = fmaxf(v, __shfl_xor(v, 16)); v = fmaxf(v, __shfl_xor(v, 32));
                if (fq == 0) xm[wc * 256 + ai * 128 + wr * 64 + m * 16 + fr] = v;
            }
        LDS_WAIT(); __builtin_amdgcn_s_barrier(); asm volatile("" ::: "memory");
#pragma unroll
        for (int ai = 0; ai < 2; ++ai)
#pragma unroll
            for (int m = 0; m < 4; ++m) {
                const int r = ai * 128 + wr * 64 + m * 16 + fr;
                const float M = fmaxf(fmaxf(xm[r], xm[256 + r]), fmaxf(xm[512 + r], xm[768 + r]));
                float s = 0.f;
#pragma unroll
                for (int bj = 0; bj < 2; ++bj)
#pragma unroll
                    for (int n = 0; n < 2; ++n) { f32x4 a = acc[ai][bj][m][n];
                        a[0] = __expf(a[0] - M); a[1] = __expf(a[1] - M); a[2] = __expf(a[2] - M); a[3] = __expf(a[3] - M);
                        acc[ai][bj][m][n] = a; s += (a[0] + a[1]) + (a[2] + a[3]); }
                s += __shfl_xor(s, 16); s += __shfl_xor(s, 32);
                if (fq == 0) xs[wc * 256 + r] = s;
            }
        LDS_WAIT(); __builtin_amdgcn_s_barrier(); asm volatile("" ::: "memory");
        bf16_t* base = (bf16_t*)u.c;
#pragma unroll
        for (int ai = 0; ai < 2; ++ai)
#pragma unroll
            for (int m = 0; m < 4; ++m) {
                const int r = ai * 128 + wr * 64 + m * 16 + fr;
                const float inv = 1.f / ((xs[r] + xs[256 + r]) + (xs[512 + r] + xs[768 + r]));
#pragma unroll
                for (int bj = 0; bj < 2; ++bj) { const f32x4 a0 = acc[ai][bj][m][0] * inv, a1 = acc[ai][bj][m][1] * inv;
                    u32x4 w; w.x = pk2(a0[0], a0[1]); w.y = pk2(a0[2], a0[3]); w.z = pk2(a1[0], a1[1]); w.w = pk2(a1[2], a1[3]);
                    *(u32x4*)(base + (size_t)r * u.ldc + bj * 128 + wc * 32 + 8 * fq) = w; }
            }
    }
};

struct EpiSwiGLU {
    static constexpr bool PERM = true; static constexpr int SEG = 0;
    const float* b1;
    __device__ __forceinline__ void operator()(f32x4 (&acc)[2][2][4][2], const Unit& u, int wr, int wc, int fr, int fq) const {
        bf16_t* base = (bf16_t*)u.c;
        const int colb = wc * 32 + 8 * fq;
        const float* bb = b1 + (size_t)u.aux * 2048 + u.col0 + colb;
        f32x4 bg[2], bl[2];
#pragma unroll
        for (int n = 0; n < 2; ++n) { bg[n] = *(const f32x4*)(bb + 4 * n); bl[n] = *(const f32x4*)(bb + 1024 + 4 * n); }
#pragma unroll
        for (int ai = 0; ai < 2; ++ai)
#pragma unroll
            for (int m = 0; m < 4; ++m) {
                float o[8];
#pragma unroll
                for (int n = 0; n < 2; ++n) {
                    const f32x4 gv = acc[ai][0][m][n] + bg[n], lv = acc[ai][1][m][n] + bl[n];
#pragma unroll
                    for (int e = 0; e < 4; ++e) { const float gg = fminf(gv[e], 7.0f), ll = fminf(fmaxf(lv[e], -7.0f), 7.0f); o[4 * n + e] = gg * sigmoidf_(1.702f * gg) * (ll + 1.0f); }
                }
                u32x4 w; w.x = pk2(o[0], o[1]); w.y = pk2(o[2], o[3]); w.z = pk2(o[4], o[5]); w.w = pk2(o[6], o[7]);
                *(u32x4*)(base + (size_t)(ai * 128 + wr * 64 + m * 16 + fr) * u.ldc + colb) = w;
            }
    }
};


struct EpiMoeX {
    static constexpr bool PERM = true; static constexpr int SEG = 0;
    const float* b1; const float* b2;
    __device__ __forceinline__ void operator()(f32x4 (&acc)[2][2][4][2], const Unit& u, int wr, int wc, int fr, int fq) const {
        if (u.kind) { EpiStoreBf16 E2{b2, 1.f}; E2(acc, u, wr, wc, fr, fq); return; }
        bf16_t* base = (bf16_t*)u.c;
        const int colb = wc * 32 + 8 * fq;
        const float* bb = b1 + (size_t)u.aux * 2048 + u.col0 + colb;
        f32x4 bg[2], bl[2];
#pragma unroll
        for (int n = 0; n < 2; ++n) { bg[n] = *(const f32x4*)(bb + 4 * n); bl[n] = *(const f32x4*)(bb + 1024 + 4 * n); }
#pragma unroll
        for (int ai = 0; ai < 2; ++ai)
#pragma unroll
            for (int m = 0; m < 4; ++m) {
                float o[8];
#pragma unroll
                for (int n = 0; n < 2; ++n) {
                    const f32x4 gv = acc[ai][0][m][n] + bg[n], lv = acc[ai][1][m][n] + bl[n];
#pragma unroll
                    for (int e = 0; e < 4; ++e) { const float gg = fminf(gv[e], 7.0f), ll = fminf(fmaxf(lv[e], -7.0f), 7.0f); o[4 * n + e] = gg * sigmoidf_(1.702f * gg) * (ll + 1.0f); }
                }
                u32x4 w; w.x = pk2(o[0], o[1]); w.y = pk2(o[2], o[3]); w.z = pk2(o[4], o[5]); w.w = pk2(o[6], o[7]);
                bf16_t* dst = base + (size_t)(ai * 128 + wr * 64 + m * 16 + fr) * u.ldc + colb;
                asm volatile("global_store_dwordx4 %0, %1, off sc1\n\ts_nop 1" :: "v"(dst), "v"(w) : "memory");
            }
    }
};
struct SchedInProj {
    static constexpr bool GATHER = false; static constexpr bool COUNTED = false;
    const char* A; const char* B; char* C; int G, c;
    __device__ __forceinline__ bool next(int i, Unit& u) const {
        const int L = i * G + c; if (L >= 64 * 36) return false;
        int pm, pn; pg8::swz_tile(L, 64, 36, pm, pn);
        u.a = A + (size_t)pm * 256 * 1024 * 2; u.b = B + (size_t)pn * 256 * 1024 * 2; u.c = C + ((size_t)pm * 256 * ZC + pn * 256) * 2;
        u.ldc = ZC; u.row0 = pm * 256; u.col0 = pn * 256; u.aux = (pn * 256 >= LR_COL) ? 16 : 0; return true;
    }
};
struct SchedKV {
    static constexpr bool GATHER = false; static constexpr bool COUNTED = false;
    const char* ws; int G, c;
    __device__ __forceinline__ bool next(int i, Unit& u) const {
        const int L = i * G + c; if (L >= NL_ * 32) return false;
        const int l = L >> 5, r = L & 31, pm = r >> 3, pn = r & 7;
        u.a = ws + WS_MEMB + (size_t)pm * 256 * 1024 * 2; u.b = ws + WS_W + (size_t)l * LW_END + LW_WKV + (size_t)pn * 256 * 1024 * 2;
        u.c = (char*)ws + WS_KMEM + (size_t)l * 2 * SZ_W1K + ((size_t)pm * 256 * 2048 + pn * 256) * 2; u.ldc = 2048; u.row0 = 0; u.col0 = 0; u.aux = 0; u.g0 = 0; u.g1 = 0; return true;
    }
};
struct SchedMq {
    static constexpr bool GATHER = false; static constexpr bool COUNTED = false;
    const char* ws; int G, c;
    __device__ __forceinline__ bool next(int i, Unit& u) const {
        const int L = i * G + c; if (L >= NL_ * 64) return false;
        const int l = L >> 6, r = L & 63, bb = r >> 4, hh = (r >> 2) & 3, pn = r & 3;
        u.a = ws + WS_KMEM + (size_t)l * 2 * SZ_W1K + ((size_t)bb * 256 * 2048 + hh * 256) * 2; u.b = ws + WS_W + (size_t)l * LW_END + LW_WQ + ((size_t)pn * 256 * 1024 + hh * 256) * 2;
        u.c = (char*)ws + WS_MQT + ((size_t)l * 4 + bb) * SZ_W1K + ((size_t)hh * 256 * 1024 + pn * 256) * 2; u.ldc = 1024; u.row0 = 0; u.col0 = 0; u.aux = 0; u.g0 = 0; u.g1 = 0; return true;
    }
};
struct SchedVw {
    static constexpr bool GATHER = false; static constexpr bool COUNTED = false;
    const char* ws; int G, c;
    __device__ __forceinline__ bool next(int i, Unit& u) const {
        const int L = i * G + c; if (L >= NL_ * 64) return false;
        const int l = L >> 6, r = L & 63, bb = r >> 4, hh = (r >> 2) & 3, pm = r & 3;
        u.a = ws + WS_W + (size_t)l * LW_END + LW_WO + ((size_t)pm * 256 * 1024 + hh * 256) * 2; u.b = ws + WS_KMEM + (size_t)l * 2 * SZ_W1K + ((size_t)bb * 256 * 2048 + 1024 + hh * 256) * 2;
        u.c = (char*)ws + WS_VWT + ((size_t)l * 4 + bb) * SZ_W1K + ((size_t)pm * 256 * 1024 + hh * 256) * 2; u.ldc = 1024; u.row0 = 0; u.col0 = 0; u.aux = 0; u.g0 = 0; u.g1 = 0; return true;
    }
};
struct SchedBranch {
    static constexpr bool GATHER = false; static constexpr bool COUNTED = false;
    const char* ys; const char* wbr; int G, c;
    __device__ __forceinline__ bool next(int i, Unit& u) const {
        const int L = i * G + c; if (L >= 256) return false;
        int pm, pn; pg8::swz_tile(L, 64, 4, pm, pn);
        u.a = ys + (size_t)pm * 256 * 2048 * 2; u.b = wbr + (size_t)pn * 256 * 2048 * 2; u.c = nullptr;
        u.ldc = 1024; u.row0 = pm * 256; u.col0 = pn * 256; u.aux = 0; return true;
    }
};
struct SchedSq {
    static constexpr bool GATHER = false; static constexpr bool COUNTED = false;
    const char* A; const char* B; char* C; int csz, G, c;
    __device__ __forceinline__ bool next(int i, Unit& u) const {
        const int L = i * G + c; if (L >= 256) return false;
        int pm, pn; pg8::swz_tile(L, 64, 4, pm, pn);
        u.a = A + (size_t)pm * 256 * 1024 * 2; u.b = B + (size_t)pn * 256 * 1024 * 2; u.c = C + ((size_t)pm * 256 * 1024 + pn * 256) * csz;
        u.ldc = 1024; u.row0 = pm * 256; u.col0 = pn * 256; u.aux = 0; return true;
    }
};
struct SchedXB {
    static constexpr bool GATHER = false; static constexpr bool COUNTED = false;
    const char* A; const char* B; char* C; int csz, G, c;
    __device__ __forceinline__ bool next(int i, Unit& u) const {
        const int L = i * G + c; if (L >= 256) return false;
        int pm, pn; pg8::swz_tile(L, 64, 4, pm, pn); const int bb = pm >> 4;
        u.a = A + (size_t)pm * 256 * 1024 * 2; u.b = B + (size_t)bb * SZ_W1K + (size_t)pn * 256 * 1024 * 2; u.c = C + ((size_t)pm * 256 * 1024 + pn * 256) * csz;
        u.ldc = 1024; u.row0 = pm * 256; u.col0 = pn * 256; u.aux = 0; u.g0 = 0; u.g1 = 0; return true;
    }
};
template <int NCOL, int BROWS  , int CW  , int AUXMUL  , bool GATH  >
struct SchedMoe {
    static constexpr bool GATHER = GATH; static constexpr bool COUNTED = false;
    const char* A; const char* B; char* C; const LAS int* tstart; const int* elist; int G, c;
    __device__ __forceinline__ bool next(int i, Unit& u) const {
        const int rtiles = tstart[32]; constexpr int CS = NCOL / 4;
        int rt, ct;
        if ((G & 7) == 0 && G >= 256) { const int x = c & 7, j = c >> 3, per = G >> 3;
            const int slot = i * per + j; const int st = (slot >> 5) * 8 + x, w = slot & 31;
            const int rg = st / CS, cs = st % CS; rt = rg * 8 + (w & 7); ct = cs * 4 + (w >> 3);
            if (rt >= rtiles) return false; }
        else { const int L = i * G + c; if (L >= rtiles * NCOL) return false; rt = L / NCOL; ct = L % NCOL; }
        const int e = tstart[(MISC_R2E - MISC_MOE) / 4 + rt];
        u.a = GATH ? A : A + (size_t)rt * 256 * 1024 * 2; u.b = B + ((size_t)e * BROWS + ct * 256) * 1024 * 2; u.c = C + ((size_t)rt * 256 * 1024 + ct * CW) * 2;
        u.ldc = 1024; u.row0 = rt * 256; u.col0 = ct * CW; u.aux = e * AUXMUL;
        u.g0 = e * T_ + (rt - tstart[e]) * 256; u.g1 = e * T_ + tstart[33 + e]; return true;
    }
    __device__ __forceinline__ unsigned rowoff(const Unit& u, int row) const { const int idx = u.g0 + row; const int tok = (idx < u.g1) ? elist[idx] : 0; return (unsigned)tok * 2048u; }
};

struct SchedMoeX {
    static constexpr bool GATHER = true; static constexpr bool COUNTED = true;
    const char* hb; const char* w1; const char* w2; char* act; char* ysl; const LAS int* tstart; const int* elist; unsigned* cnt; int G, c;
    __device__ __forceinline__ bool next(int i, Unit& u) const {
        const int rtiles = tstart[32], ng = (rtiles + 7) >> 3, nst1 = 2 * ng, rem = rtiles & 7;
        const int x = c & 7, j = c >> 3, rsub = j & 7, csub = j >> 3;
        int k = i;
        if (rem != 0 && rsub >= rem) {
            const int qa = nst1 - 2, qb = nst1 - 1, qc = nst1 + ng - 1;
            if ((qa & 7) == x && (qa >> 3) <= k) ++k;
            if ((qb & 7) == x && (qb >> 3) <= k) ++k;
            if ((qc & 7) == x && (qc >> 3) <= k) ++k; }
        const int q = 8 * k + x; if (q >= 3 * ng) return false;
        int rt, e;
        if (q < nst1) { const int rg = q >> 1, ct = (q & 1) * 4 + csub; rt = rg * 8 + rsub; e = tstart[(MISC_R2E - MISC_MOE) / 4 + rt];
            u.a = hb; u.b = w1 + ((size_t)e * 2048 + ct * 256) * 1024 * 2; u.c = act + ((size_t)rt * 256 * 1024 + ct * 128) * 2; u.col0 = ct * 128; u.aux = e; u.kind = 0; }
        else { const int rg = q - nst1, ct = csub; rt = rg * 8 + rsub; e = tstart[(MISC_R2E - MISC_MOE) / 4 + rt];
            u.a = act + (size_t)rt * 256 * 1024 * 2; u.b = w2 + ((size_t)e * 1024 + ct * 256) * 1024 * 2; u.c = ysl + ((size_t)rt * 256 * 1024 + ct * 256) * 2; u.col0 = ct * 256; u.aux = e * 1024; u.kind = 1; }
        u.ldc = 1024; u.row0 = rt * 256; u.g0 = e * T_ + (rt - tstart[e]) * 256; u.g1 = e * T_ + tstart[33 + e]; return true;
    }
    __device__ __forceinline__ unsigned rowoff(const Unit& u, int row) const {
        if (u.kind) return (unsigned)row * 2048u;
        const int idx = u.g0 + row; const int tok = (idx < u.g1) ? elist[idx] : 0; return (unsigned)tok * 2048u; }
    __device__ __forceinline__ int pending(const Unit& u) const { return u.kind ? -1 : (u.row0 >> 8); }
    __device__ __forceinline__ void publish(int rt, int lane) const { if (lane == 0) __hip_atomic_fetch_add(cnt + rt * 16, 1u, __ATOMIC_RELAXED, __HIP_MEMORY_SCOPE_AGENT); }
    __device__ __forceinline__ void a_ready(const Unit& u) const {
        if (u.kind == 0) return;
        if (threadIdx.x < 64) {
            const unsigned* cp = cnt + (u.row0 >> 8) * 16; unsigned sp = 0;
            while ((unsigned)__builtin_amdgcn_readfirstlane((int)__hip_atomic_load(cp, __ATOMIC_RELAXED, __HIP_MEMORY_SCOPE_AGENT)) < 64u && ++sp < (1u << 22)) __builtin_amdgcn_s_sleep(2);
            __builtin_amdgcn_fence(__ATOMIC_ACQUIRE, "agent");
            asm volatile("s_waitcnt vmcnt(0)" ::: "memory"); }
        asm volatile("" ::: "memory"); __builtin_amdgcn_s_barrier(); asm volatile("" ::: "memory");
    }
};
struct Ctx { int tid, lane, wave, G, bid; LAS unsigned char* lds; };
__device__ __forceinline__ Ctx relaunder(const Ctx& c0) { Ctx c = c0; int t_ = c0.tid; asm volatile("" : "+v"(t_)); c.tid = t_; c.lane = t_ & 63; c.wave = __builtin_amdgcn_readfirstlane(t_ >> 6); return c; }

template <bool WIDE = false>
__device__ __forceinline__ void ln_row_regs(f32x4 (&v)[4], const float* g, const float* b, int lane, float* of32, bf16_t* obf) {
    float s = 0.f;
#pragma unroll
    for (int j = 0; j < 4; ++j) s += (v[j][0] + v[j][1]) + (v[j][2] + v[j][3]);
    const float mean = wave_sum(s) * (1.f / 1024.f); float s2 = 0.f;
#pragma unroll
    for (int j = 0; j < 4; ++j) { v[j] = v[j] - mean; s2 += (v[j][0] * v[j][0] + v[j][1] * v[j][1]) + (v[j][2] * v[j][2] + v[j][3] * v[j][3]); }
    const float rstd = 1.f / sqrtf(wave_sum(s2) * (1.f / 1024.f) + LN_EPS);
#pragma unroll
    for (int j = 0; j < 4; ++j) { const int col = WIDE ? 8 * lane + 4 * (j & 1) + 512 * (j >> 1) : 4 * lane + 256 * j;
        const f32x4 gg = *(const f32x4*)(g + col), bb = *(const f32x4*)(b + col);
        v[j] = v[j] * rstd * gg + bb;
        if (of32) *(f32x4*)(of32 + col) = v[j];
        if (obf && !WIDE) { u32x2 w; w.x = pk2(v[j][0], v[j][1]); w.y = pk2(v[j][2], v[j][3]); *(u32x2*)(obf + col) = w; }
    }
    if (obf && WIDE) {
#pragma unroll
        for (int jj = 0; jj < 2; ++jj) { u32x4 w; w.x = pk2(v[2 * jj][0], v[2 * jj][1]); w.y = pk2(v[2 * jj][2], v[2 * jj][3]); w.z = pk2(v[2 * jj + 1][0], v[2 * jj + 1][1]); w.w = pk2(v[2 * jj + 1][2], v[2 * jj + 1][3]);
            *(u32x4*)(obf + 8 * lane + 512 * jj) = w; } }
}
__device__ __forceinline__ void ln_rows_phase(const Ctx& c, const float* src, const float* g, const float* b, float* of32, bf16_t* obf) {
    const int gw = c.bid * 8 + c.wave, NGW = c.G * 8;
    for (int m = gw; m < T_; m += NGW) {
        f32x4 v[4];
#pragma unroll
        for (int j = 0; j < 4; ++j) v[j] = *(const f32x4*)(src + (size_t)m * 1024 + 4 * c.lane + 256 * j);
        ln_row_regs(v, g, b, c.lane, of32 ? of32 + (size_t)m * 1024 : nullptr, obf ? obf + (size_t)m * 1024 : nullptr);
    }
}

__device__ __forceinline__ void cvt_item(const float* W, int ldw, int k0, int nsrc, bf16_t* WT, int ldt, int ndst, LAS float* scr, int lane) {
    const int cq = lane & 15, kr = lane >> 4;
    f32x4 v[16];
#pragma unroll
    for (int i = 0; i < 16; ++i) v[i] = __builtin_nontemporal_load((const f32x4*)(W + (size_t)(k0 + kr + 4 * i) * ldw + nsrc + 4 * cq));
#pragma unroll
    for (int i = 0; i < 16; ++i) { LAS float* s = scr + (kr + 4 * i) * 65 + 4 * cq; s[0] = v[i][0]; s[1] = v[i][1]; s[2] = v[i][2]; s[3] = v[i][3]; }
    LDS_WAIT();
    const int ch = lane & 7;
#pragma unroll
    for (int j = 0; j < 8; ++j) { const int n = (lane >> 3) + 8 * j; const LAS float* s = scr + (8 * ch) * 65 + n;
        u32x4 o; o.x = pk2(s[0], s[65]); o.y = pk2(s[2 * 65], s[3 * 65]); o.z = pk2(s[4 * 65], s[5 * 65]); o.w = pk2(s[6 * 65], s[7 * 65]);
        *(u32x4*)(WT + (size_t)(ndst + n) * ldt + k0 + 8 * ch) = o; }
    LDS_WAIT();
}

__device__ __forceinline__ void ph_prologue(const Ctx& c, KP p, int part, int gwx, int ngwx) {
    unsigned char* ws = p->ws;
    if (part != 1) {
    ln_rows_phase(c, p->in[I_X], p->in[I_LN0G], p->in[I_LN0B], (c.G == 256) ? nullptr : (float*)(ws + WS_H), (bf16_t*)(ws + WS_HB));
    { const float* mem = p->in[I_MEM]; bf16_t* mb = (bf16_t*)(ws + WS_MEMB);
      for (int i = c.bid * 512 + c.tid; i < 1024 * 1024 / 4; i += c.G * 512) { const f32x4 v = *(const f32x4*)(mem + 4 * (size_t)i); u32x2 w; w.x = pk2(v[0], v[1]); w.y = pk2(v[2], v[3]); *(u32x2*)(mb + 4 * (size_t)i) = w; } }
    { bf16_t* lgw = (bf16_t*)(ws + WS_LGW);
      for (int i = c.bid * 512 + c.tid; i < NL_ * 2 * 8 * 64 * 64; i += c.G * 512) { const int k = i & 63, d = (i >> 6) & 63, n = (i >> 12) & 7, g = (i >> 15) & 1, l = i >> 16;
          lgw[i] = (bf16_t)f2bf((g ? p->in[I_LWX] : p->in[I_LWA])[(((size_t)l * 8 + n) * 64 + k) * 64 + d]); }
      for (int i = c.bid * 512 + c.tid; i < NL_ * 1024 * 1024 / 4; i += c.G * 512) { const int l = i >> 18, o = (i & 262143) * 4;
          const f32x4 v = *(const f32x4*)(p->in[I_WQ] + (size_t)l * 1024 * 1024 + o); u32x2 w; w.x = pk2(v[0], v[1]); w.y = pk2(v[2], v[3]); *(u32x2*)((bf16_t*)(ws + WS_W + (size_t)l * LW_END + LW_WQ) + o) = w; }
      { bf16_t* rws = (bf16_t*)(ws + WS_RWS);
        for (int i = c.bid * 512 + c.tid; i < NL_ * 32 * 1024; i += c.G * 512) { const int k = i & 1023, e = (i >> 10) & 31, l = i >> 15;
            const float w = p->in[I_RW][((size_t)l * 1024 + k) * 32 + e]; const unsigned hi = f2bf(w);
            rws[((size_t)l * 2 * 32 + e) * 1024 + k] = (bf16_t)hi; rws[((size_t)l * 2 * 32 + 32 + e) * 1024 + k] = (bf16_t)f2bf(w - bf2f(hi)); } }
      bf16_t* wlr = (bf16_t*)(ws + WS_WLR);
      for (int i = c.bid * 512 + c.tid; i < NL_ * 16 * 1024; i += c.G * 512) { const int k = i & 1023, j = (i >> 10) & 15, l = i >> 14;
          wlr[i] = (bf16_t)f2bf(p->in[I_WIN][((size_t)l * 1024 + k) * INC + LR_COL + j]); } }
    }
    LAS float* scr = (LAS float*)(c.lds) + c.wave * (64 * 65);
    constexpr int I_IN = 16 * 144, I_BR = 4 * 8 * 16, I_SQ = 16 * 16, I_M1 = 32 * 16 * 32, I_M2 = 32 * 16 * 16;
    constexpr int PER_L = I_IN + I_BR + 4 * I_SQ + I_M1 + I_M2;
    const int it1 = (part == 0) ? I_IN : NL_ * PER_L;
    for (int it = ((part == 1) ? I_IN : 0) + gwx; it < it1; it += ngwx) {
        const int l = it / PER_L; int r = it % PER_L;
        unsigned char* lw = ws + WS_W + (size_t)l * LW_END;
        if (r < I_IN) { const int kb = r % 16, nb = r / 16, d0 = nb * 64;
            cvt_item(p->in[I_WIN] + (size_t)l * 1024 * INC, INC, kb * 64, d0 + (d0 >= LR_COL ? 16 : 0), (bf16_t*)(lw + LW_WIN), 1024, d0, scr, c.lane); continue; }
        r -= I_IN;
        if (r < I_BR) { const int br = r / 128, q = r % 128, kb = q % 8, nb = q / 8;
            cvt_item(p->in[I_WBR] + ((size_t)l * 4 + br) * 512 * 1024, 1024, kb * 64, nb * 64, (bf16_t*)(lw + LW_WBR) + br * 512, 2048, nb * 64, scr, c.lane); continue; }
        r -= I_BR;
        if (r < 4 * I_SQ) { const int w = r / I_SQ, q = r % I_SQ, kb = q % 16, nb = q / 16;
            const float* src = (w == 0 ? p->in[I_WOUT] : w == 1 ? p->in[I_WK] : w == 2 ? p->in[I_WV] : p->in[I_WO]) + (size_t)l * 1024 * 1024;
            bf16_t* dst = (bf16_t*)(lw + (w == 0 ? LW_WOUT : w == 1 ? LW_WKV : w == 2 ? LW_WKV + SZ_W1K : LW_WO));
            cvt_item(src, 1024, kb * 64, nb * 64, dst, 1024, nb * 64, scr, c.lane); continue; }
        r -= 4 * I_SQ;
        if (r < I_M1) { const int e = r / 512, q = r % 512, kb = q % 16, nb = q / 16, d0 = nb * 64, j = d0 >> 8, ii = d0 & 255;
            const int nsrc = (ii < 128) ? (128 * j + ii) : (1024 + 128 * j + (ii - 128));
            cvt_item(p->in[I_W1] + ((size_t)l * 32 + e) * 1024 * 2048, 2048, kb * 64, nsrc, (bf16_t*)(lw + LW_W1) + (size_t)e * 2048 * 1024, 1024, d0, scr, c.lane); continue; }
        r -= I_M1;
        { const int e = r / 256, q = r % 256, kb = q % 16, nb = q / 16;
            cvt_item(p->in[I_W2] + ((size_t)l * 32 + e) * 1024 * 1024, 1024, kb * 64, nb * 64, (bf16_t*)(lw + LW_W2) + (size_t)e * 1024 * 1024, 1024, nb * 64, scr, c.lane); }
    }
}

__device__ __forceinline__ void ph_conv_a(const Ctx& c0, KP p, int l, int item) {
    const Ctx c = relaunder(c0);
    const bf16_t* z = (const bf16_t*)(p->ws + WS_Z); bf16_t* ys = (bf16_t*)(p->ws + WS_YS);
    const int b = item >> 6, t0 = (item & 63) * 64; const size_t rb = (size_t)b * SEQ_;
    LAS bf16_t* ub = (LAS bf16_t*)c.lds;
    LAS float* red = (LAS float*)(c.lds + 96256);
    LAS float* yb = (LAS float*)(c.lds + 96512);
    { const int cg = c.tid & 63;
#pragma unroll 6
      for (int r = c.tid >> 6; r < 94; r += 8) { const int t = t0 - 30 + r; u32x4 o = (u32x4){0u, 0u, 0u, 0u};
          if (t >= 0) { const u32x4 va = *(const u32x4*)(z + (rb + t) * ZC + Z_AVAL + 8 * cg), vg = *(const u32x4*)(z + (rb + t) * ZC + Z_AGATE + 8 * cg);
              o.x = pk2(bflo(va.x) * sigmoidf_(bflo(vg.x)), bfhi(va.x) * sigmoidf_(bfhi(vg.x))); o.y = pk2(bflo(va.y) * sigmoidf_(bflo(vg.y)), bfhi(va.y) * sigmoidf_(bfhi(vg.y)));
              o.z = pk2(bflo(va.z) * sigmoidf_(bflo(vg.z)), bfhi(va.z) * sigmoidf_(bfhi(vg.z))); o.w = pk2(bflo(va.w) * sigmoidf_(bflo(vg.w)), bfhi(va.w) * sigmoidf_(bfhi(vg.w))); }
          *(LAS u32x4*)(ub + r * 512 + 8 * cg) = o; } }
    const int ch = c.tid;
    float w[31];
#pragma unroll
    for (int j = 0; j < 31; ++j) w[j] = p->in[I_CAW][((size_t)l * 31 + j) * 512 + ch];
    const float cb = p->in[I_CAB][l * 512 + ch], lg = p->in[I_LNAG][l * 512 + ch], lb = p->in[I_LNAB][l * 512 + ch];
    __syncthreads();
    for (int g = 0; g < 4; ++g) {
        float u[46];
#pragma unroll
        for (int r = 0; r < 46; ++r) u[r] = bf2f(ub[(16 * g + r) * 512 + ch]);
        float y[16];
#pragma unroll
        for (int i = 0; i < 16; ++i) { float a = cb;
#pragma unroll
            for (int j = 0; j < 31; ++j) a += w[j] * u[i + j];
            y[i] = a; }
#pragma unroll
        for (int i = 0; i < 16; ++i) yb[i * 512 + ch] = y[i];
        __syncthreads();
#pragma unroll
        for (int h2 = 0; h2 < 2; ++h2) { const int tk = c.wave + 8 * h2;
          const f32x4 a0 = *(const LAS f32x4*)(yb + tk * 512 + 8 * c.lane), a1 = *(const LAS f32x4*)(yb + tk * 512 + 8 * c.lane + 4);
          float s1 = ((a0[0] + a0[1]) + (a0[2] + a0[3])) + ((a1[0] + a1[1]) + (a1[2] + a1[3]));
          float s2 = ((a0[0] * a0[0] + a0[1] * a0[1]) + (a0[2] * a0[2] + a0[3] * a0[3])) + ((a1[0] * a1[0] + a1[1] * a1[1]) + (a1[2] * a1[2] + a1[3] * a1[3]));
          s1 = wave_sum(s1); s2 = wave_sum(s2);
          if (c.lane == 0) { const float mean = s1 * (1.f / 512.f); red[tk * 2] = mean; red[tk * 2 + 1] = 1.f / sqrtf(fmaxf(s2 * (1.f / 512.f) - mean * mean, 0.f) + LN_EPS); } }
        __syncthreads();
#pragma unroll
        for (int i = 0; i < 16; ++i) { const float v = (y[i] - red[2 * i]) * red[2 * i + 1] * lg + lb;
            ys[(rb + t0 + 16 * g + i) * 2048 + ch] = (bf16_t)f2bf(v * sigmoidf_(v)); }
    }
    __syncthreads();
}

__device__ __forceinline__ float gelu_tanh(float x) { const float u = 0.7978845608028654f * (x + 0.044715f * x * x * x); const float e = __expf(2.f * u); return 0.5f * x * (2.f - 2.f * __builtin_amdgcn_rcpf(e + 1.f)); }
template <int MODE>
__device__ __forceinline__ void ph_lru(const Ctx& c0, KP p, int l, int item) {
    const Ctx c = relaunder(c0);
    const bf16_t* z = (const bf16_t*)(p->ws + WS_Z); bf16_t* ys = (bf16_t*)(p->ws + WS_YS);
    float* lagg = (float*)(p->ws + WS_LAGG);
    const int b = item >> 6, tile = item & 63, t0 = tile * 64; const size_t rb = (size_t)b * SEQ_;
    LAS bf16_t* xc = (LAS bf16_t*)c.lds;
    LAS bf16_t* dg = (LAS bf16_t*)(c.lds + 66560);
    { const int cg = c.tid & 63, tr = c.tid >> 6;
      f32x4 cw[4][2], cbv[2];
#pragma unroll
      for (int j = 0; j < 4; ++j) { cw[j][0] = *(const f32x4*)(p->in[I_CDW] + ((size_t)l * 4 + j) * 512 + 8 * cg); cw[j][1] = *(const f32x4*)(p->in[I_CDW] + ((size_t)l * 4 + j) * 512 + 8 * cg + 4); }
      cbv[0] = *(const f32x4*)(p->in[I_CDB] + l * 512 + 8 * cg); cbv[1] = *(const f32x4*)(p->in[I_CDB] + l * 512 + 8 * cg + 4);
      u32x4 xr[11]; u32x4 gr[8];
#pragma unroll
      for (int i = 0; i < 11; ++i) { const int t = t0 + tr * 8 - 3 + i; xr[i] = (t >= 0) ? *(const u32x4*)(z + (rb + t) * ZC + Z_DX + 8 * cg) : (u32x4){0u, 0u, 0u, 0u}; }
      if (MODE == 3) {
#pragma unroll
          for (int i = 0; i < 8; ++i) gr[i] = *(const u32x4*)(z + (rb + t0 + tr * 8 + i) * ZC + Z_DG + 8 * cg); }
#pragma unroll
      for (int i = 0; i < 8; ++i) { f32x4 a0 = cbv[0], a1 = cbv[1];
#pragma unroll
          for (int j = 0; j < 4; ++j) { const u32x4 x = xr[i + j];
              a0 += cw[j][0] * (f32x4){bflo(x.x), bfhi(x.x), bflo(x.y), bfhi(x.y)}; a1 += cw[j][1] * (f32x4){bflo(x.z), bfhi(x.z), bflo(x.w), bfhi(x.w)}; }
          u32x4 o; o.x = pk2(a0[0], a0[1]); o.y = pk2(a0[2], a0[3]); o.z = pk2(a1[0], a1[1]); o.w = pk2(a1[2], a1[3]);
          *(LAS u32x4*)(xc + (tr * 8 + i) * 520 + 8 * cg) = o;
          if (MODE == 3) *(LAS u32x4*)(dg + (tr * 8 + i) * 520 + 8 * cg) = gr[i]; } }
    const int n = c.wave, r = c.lane & 15, q = c.lane >> 4;
    bf16x8 wfa[4][2], wfx[4][2];
    { const bf16_t* gw = (const bf16_t*)(p->ws + WS_LGW) + ((size_t)l * 2 * 8 + n) * 4096;
#pragma unroll
      for (int cb = 0; cb < 4; ++cb)
#pragma unroll
          for (int ks = 0; ks < 2; ++ks) { wfa[cb][ks] = *(const bf16x8*)(gw + (16 * cb + r) * 64 + 32 * ks + 8 * q); wfx[cb][ks] = *(const bf16x8*)(gw + 8 * 4096 + (16 * cb + r) * 64 + 32 * ks + 8 * q); } }
    float ba[4], bx[4], ls[4], hst[4], Atot[4];
#pragma unroll
    for (int cb = 0; cb < 4; ++cb) { const int ch = 64 * n + 16 * cb + r; ba[cb] = p->in[I_LBA][l * 512 + ch]; bx[cb] = p->in[I_LBX][l * 512 + ch];
        ls[cb] = -8.0f * softplusf_(-p->in[I_LLAM][l * 512 + ch]);
        hst[cb] = (MODE == 3) ? lagg[(size_t)2 * 4 * 64 * 512 + ((size_t)b * 64 + tile) * 512 + ch] : 0.f; Atot[cb] = 1.f; }
    __syncthreads();
    for (int rbk = 0; rbk < 4; ++rbk) {
        const bf16x8 af0 = *(const LAS bf16x8*)(xc + (16 * rbk + r) * 520 + 64 * n + 8 * q), af1 = *(const LAS bf16x8*)(xc + (16 * rbk + r) * 520 + 64 * n + 32 + 8 * q);
#pragma unroll
        for (int cb = 0; cb < 4; ++cb) {
            f32x4 pr = __builtin_amdgcn_mfma_f32_16x16x32_bf16(af0, wfa[cb][0], (f32x4){0.f, 0.f, 0.f, 0.f}, 0, 0, 0); pr = __builtin_amdgcn_mfma_f32_16x16x32_bf16(af1, wfa[cb][1], pr, 0, 0, 0);
            f32x4 pi = __builtin_amdgcn_mfma_f32_16x16x32_bf16(af0, wfx[cb][0], (f32x4){0.f, 0.f, 0.f, 0.f}, 0, 0, 0); pi = __builtin_amdgcn_mfma_f32_16x16x32_bf16(af1, wfx[cb][1], pi, 0, 0, 0);
            const int chl = 64 * n + 16 * cb + r;
            float a[4], u[4];
#pragma unroll
            for (int j = 0; j < 4; ++j) { const float xv = bf2f(xc[(16 * rbk + 4 * q + j) * 520 + chl]);
                const float rr = sigmoidf_(pr[j] + ba[cb]), ig = sigmoidf_(pi[j] + bx[cb]);
                const float aa = __expf(rr * ls[cb]); a[j] = aa; u[j] = sqrtf(fmaxf(1.f - aa * aa, 0.f)) * (ig * xv); }
            const float Aloc = (a[0] * a[1]) * (a[2] * a[3]), Hloc = ((u[0] * a[1] + u[1]) * a[2] + u[2]) * a[3] + u[3];
            const float A1 = __shfl_xor(Aloc, 16), A2 = __shfl_xor(Aloc, 32), A3 = __shfl_xor(Aloc, 48), H1 = __shfl_xor(Hloc, 16), H2 = __shfl_xor(Hloc, 32), H3 = __shfl_xor(Hloc, 48);
            float h = hst[cb], hstart = h, At = 1.f;
#pragma unroll
            for (int qq = 0; qq < 4; ++qq) { const int idx = qq ^ q;
                const float Ag = (idx == 0) ? Aloc : (idx == 1) ? A1 : (idx == 2) ? A2 : A3, Hg = (idx == 0) ? Hloc : (idx == 1) ? H1 : (idx == 2) ? H2 : H3;
                hstart = (qq == q) ? h : hstart; h = Ag * h + Hg; At *= Ag; }
            hst[cb] = h; Atot[cb] *= At;
            if (MODE == 3) { float hh = hstart;
#pragma unroll
                for (int j = 0; j < 4; ++j) { hh = a[j] * hh + u[j]; LAS bf16_t* dp = dg + (16 * rbk + 4 * q + j) * 520 + chl; *dp = (bf16_t)f2bf(hh * gelu_tanh(bf2f(*dp))); } }
        }
    }
    if (MODE == 1) { if (q == 0) {
#pragma unroll
        for (int cb = 0; cb < 4; ++cb) { const int ch = 64 * n + 16 * cb + r; lagg[((size_t)b * 64 + tile) * 512 + ch] = Atot[cb]; lagg[(size_t)4 * 64 * 512 + ((size_t)b * 64 + tile) * 512 + ch] = hst[cb]; } } }
    if (MODE == 3) { __syncthreads();
        const int cg = c.tid & 63, tr = c.tid >> 6;
#pragma unroll
        for (int i = 0; i < 8; ++i) *(u32x4*)(ys + (rb + t0 + tr * 8 + i) * 2048 + 1536 + 8 * cg) = *(const LAS u32x4*)(dg + (tr * 8 + i) * 520 + 8 * cg); }
    __syncthreads();
}
__device__ __forceinline__ void ph_lru_carry(const Ctx& c, KP p) {
    float* lagg = (float*)(p->ws + WS_LAGG);
    for (int g = c.bid * 512 + c.tid; g < 4 * 512; g += c.G * 512) { const int b = g >> 9, ch = g & 511; float s = 0.f;
        for (int j0 = 0; j0 < 64; j0 += 16) { float av[16], hv[16];
#pragma unroll
            for (int j = 0; j < 16; ++j) { const size_t o = ((size_t)b * 64 + j0 + j) * 512 + ch; av[j] = lagg[o]; hv[j] = lagg[(size_t)4 * 64 * 512 + o]; }
#pragma unroll
            for (int j = 0; j < 16; ++j) { const size_t o = ((size_t)b * 64 + j0 + j) * 512 + ch; lagg[(size_t)2 * 4 * 64 * 512 + o] = s; s = av[j] * s + hv[j]; } } }
}

__device__ __forceinline__ void ph_gla1(const Ctx& c0, KP p, int l, int item) {
    const Ctx c = relaunder(c0);
    const bf16_t* z = (const bf16_t*)(p->ws + WS_Z); const bf16_t* hb = (const bf16_t*)(p->ws + WS_HB);
    float* bcum = (float*)(p->ws + WS_BCUM); float* kvst = (float*)(p->ws + WS_KVST);
    const int b = item >> 6, ck = item & 63; const size_t r0 = (size_t)b * SEQ_ + ck * 64;
    LAS float* lrp = (LAS float*)c.lds;
    LAS float* lrs = (LAS float*)(c.lds + 8192);
    LAS float* tot = (LAS float*)(c.lds + 8192);
    LAS float* bcs = (LAS float*)(c.lds + 12288);
    LAS bf16_t* keT = (LAS bf16_t*)(c.lds + 77824);
    LAS bf16_t* vT = (LAS bf16_t*)(c.lds + 96256);
    const int r = c.lane & 15, q = c.lane >> 4;
    u32x4 nkv[2], nvv[2][2];
#define GLA1_LOAD(hp_) do { const int t_ = c.tid >> 3, k0_ = (c.tid & 7) * 8, v0_ = (c.tid & 7) * 16; \
        _Pragma("unroll") for (int h2_ = 0; h2_ < 2; ++h2_) { const int hh_ = 2 * (hp_) + h2_; nkv[h2_] = *(const u32x4*)(z + (r0 + t_) * ZC + Z_BK + hh_ * 64 + k0_); \
            nvv[h2_][0] = *(const u32x4*)(z + (r0 + t_) * ZC + Z_BV + hh_ * 128 + v0_); nvv[h2_][1] = *(const u32x4*)(z + (r0 + t_) * ZC + Z_BV + hh_ * 128 + v0_ + 8); } } while (0)
    GLA1_LOAD(0);
    { const int rbk = c.wave & 3, kh = c.wave >> 2;
      const bf16_t* ap = hb + (r0 + 16 * rbk + r) * 1024 + 512 * kh + 8 * q; const bf16_t* bp = (const bf16_t*)(p->ws + WS_WLR) + ((size_t)l * 16 + r) * 1024 + 512 * kh + 8 * q;
      f32x4 acc = (f32x4){0.f, 0.f, 0.f, 0.f};
#pragma unroll 8
      for (int ks = 0; ks < 16; ++ks) acc = __builtin_amdgcn_mfma_f32_16x16x32_bf16(*(const bf16x8*)(ap + 32 * ks), *(const bf16x8*)(bp + 32 * ks), acc, 0, 0, 0);
#pragma unroll
      for (int j = 0; j < 4; ++j) lrp[(kh * 64 + 16 * rbk + 4 * q + j) * 16 + r] = acc[j]; }
    __syncthreads();
    { const float* bi = p->in[I_BIN] + (size_t)l * INC + LR_COL;
      for (int i = c.tid; i < 1024; i += 512) lrs[i] = lrp[i] + lrp[1024 + i] + bi[i & 15]; }
    __syncthreads();
    { const int n = c.tid & 255, th = c.tid >> 8; float w2[16];
#pragma unroll
      for (int j = 0; j < 16; ++j) w2[j] = p->in[I_WA2][((size_t)l * 16 + j) * 256 + n];
      const float ba = p->in[I_GBA][l * 256 + n]; float cum = 0.f;
      for (int t = 32 * th; t < 32 * th + 32; ++t) { float pre = ba;
#pragma unroll
          for (int j4 = 0; j4 < 4; ++j4) { const f32x4 lv = *(const LAS f32x4*)(lrs + t * 16 + 4 * j4); pre += lv[0] * w2[4 * j4] + lv[1] * w2[4 * j4 + 1] + lv[2] * w2[4 * j4 + 2] + lv[3] * w2[4 * j4 + 3]; }
          cum += -softplusf_(-pre) * (1.f / 16.f);
          bcs[t * 256 + n] = cum; }
      __syncthreads();
      if (th == 0) tot[n] = cum;
      __syncthreads();
      if (th == 1) { const float a = tot[n]; for (int t = 32; t < 64; ++t) bcs[t * 256 + n] += a; }
      __syncthreads();
      for (int t = 32 * th; t < 32 * th + 32; ++t) bcum[(r0 + t) * 256 + n] = bcs[t * 256 + n]; }
    for (int hp = 0; hp < 2; ++hp) {
        { const int t = c.tid >> 3, k0 = (c.tid & 7) * 8, v0 = (c.tid & 7) * 16;
#pragma unroll
          for (int h2 = 0; h2 < 2; ++h2) { const int hh = 2 * hp + h2;
              const u32x4 kv = nkv[h2]; const unsigned kw[4] = {kv.x, kv.y, kv.z, kv.w};
#pragma unroll
              for (int e = 0; e < 4; ++e) { const int kk = hh * 64 + k0 + 2 * e;
                  keT[(h2 * 64 + k0 + 2 * e) * 72 + t] = (bf16_t)f2bf(bflo(kw[e]) * __expf(bcs[63 * 256 + kk] - bcs[t * 256 + kk]));
                  keT[(h2 * 64 + k0 + 2 * e + 1) * 72 + t] = (bf16_t)f2bf(bfhi(kw[e]) * __expf(bcs[63 * 256 + kk + 1] - bcs[t * 256 + kk + 1])); }
#pragma unroll
              for (int qq = 0; qq < 2; ++qq) { const u32x4 vv = nvv[h2][qq]; const unsigned vw[4] = {vv.x, vv.y, vv.z, vv.w};
#pragma unroll
                  for (int e = 0; e < 4; ++e) { vT[(h2 * 128 + v0 + 8 * qq + 2 * e) * 72 + t] = (bf16_t)(vw[e] & 0xffffu); vT[(h2 * 128 + v0 + 8 * qq + 2 * e + 1) * 72 + t] = (bf16_t)(vw[e] >> 16); } } } }
        __syncthreads();
        if (hp == 0) GLA1_LOAD(1);
        { const int h2 = c.wave >> 2, rbk = c.wave & 3, hh = 2 * hp + h2;
          const bf16x8 a0 = *(const LAS bf16x8*)(keT + (h2 * 64 + 16 * rbk + r) * 72 + 8 * q), a1 = *(const LAS bf16x8*)(keT + (h2 * 64 + 16 * rbk + r) * 72 + 32 + 8 * q);
          float* dst = kvst + ((((size_t)b * 64 + ck) * 4 + hh) * 64 + 16 * rbk + 4 * q) * 128 + r;
#pragma unroll
          for (int cb = 0; cb < 8; ++cb) {
              const bf16x8 b0 = *(const LAS bf16x8*)(vT + (h2 * 128 + 16 * cb + r) * 72 + 8 * q), b1 = *(const LAS bf16x8*)(vT + (h2 * 128 + 16 * cb + r) * 72 + 32 + 8 * q);
              f32x4 d = __builtin_amdgcn_mfma_f32_16x16x32_bf16(a0, b0, (f32x4){0.f, 0.f, 0.f, 0.f}, 0, 0, 0); d = __builtin_amdgcn_mfma_f32_16x16x32_bf16(a1, b1, d, 0, 0, 0);
#pragma unroll
              for (int j = 0; j < 4; ++j) dst[(size_t)j * 128 + 16 * cb] = d[j]; } }
        __syncthreads();
    }
}
__device__ __forceinline__ void ph_gla2(const Ctx& c, KP p) {
    const float* bcum = (const float*)(p->ws + WS_BCUM); const float* kvst = (const float*)(p->ws + WS_KVST); bf16_t* sprev = (bf16_t*)(p->ws + WS_SPREV);
    for (int g = c.bid * 512 + c.tid; g < 4 * 4 * 64 * 128; g += c.G * 512) {
        const int v = g & 127, k = (g >> 7) & 63, hh = (g >> 13) & 3, b = g >> 15; float s = 0.f;
        for (int c0 = 0; c0 < 64; c0 += 16) { float kv[16], dc[16];
#pragma unroll
            for (int j = 0; j < 16; ++j) { const int ck = c0 + j; kv[j] = kvst[((((size_t)b * 64 + ck) * 4 + hh) * 64 + k) * 128 + v]; dc[j] = bcum[((size_t)b * SEQ_ + ck * 64 + 63) * 256 + hh * 64 + k]; }
#pragma unroll
            for (int j = 0; j < 16; ++j) { const int ck = c0 + j; sprev[((((size_t)b * 64 + ck) * 4 + hh) * 64 + k) * 128 + v] = (bf16_t)f2bf(s); s = __expf(dc[j]) * s + kv[j]; } }
    }
}
__device__ __forceinline__ void ph_gla3(const Ctx& c0, KP p, int l, int item) {
    const Ctx c = relaunder(c0);
    const bf16_t* z = (const bf16_t*)(p->ws + WS_Z); const float* bcum = (const float*)(p->ws + WS_BCUM); const bf16_t* sprev = (const bf16_t*)(p->ws + WS_SPREV); bf16_t* ys = (bf16_t*)(p->ws + WS_YS);
    const int b = item >> 6, ck = item & 63; const size_t r0 = (size_t)b * SEQ_ + ck * 64;
    LAS bf16_t* qd = (LAS bf16_t*)c.lds;
    LAS bf16_t* ki = (LAS bf16_t*)(c.lds + 9216);
    LAS bf16_t* vT = (LAS bf16_t*)(c.lds + 18432);
    LAS bf16_t* sT = (LAS bf16_t*)(c.lds + 36864);
    LAS bf16_t* scp = (LAS bf16_t*)(c.lds + 55296) + c.wave * (16 * 72);
    LAS bf16_t* br = (LAS bf16_t*)(c.lds + 73728);
    LAS float* part = (LAS float*)(c.lds + 91136);
    const int r = c.lane & 15, q = c.lane >> 4, rbk = c.wave & 3, half = c.wave >> 2;
    u32x4 nqv, nkv, nvv0, nvv1, nrv0, nrv1, nsq0, nsq1; f32x4 nbc0, nbc1;
#define GLA3_LOAD(hh_) do { const int t_ = c.tid >> 3, k0_ = (c.tid & 7) * 8, v0_ = (c.tid & 7) * 16; \
        nqv = *(const u32x4*)(z + (r0 + t_) * ZC + Z_BQ + (hh_) * 64 + k0_); nkv = *(const u32x4*)(z + (r0 + t_) * ZC + Z_BK + (hh_) * 64 + k0_); \
        nbc0 = *(const f32x4*)(bcum + (r0 + t_) * 256 + (hh_) * 64 + k0_); nbc1 = *(const f32x4*)(bcum + (r0 + t_) * 256 + (hh_) * 64 + k0_ + 4); \
        nvv0 = *(const u32x4*)(z + (r0 + t_) * ZC + Z_BV + (hh_) * 128 + v0_); nvv1 = *(const u32x4*)(z + (r0 + t_) * ZC + Z_BV + (hh_) * 128 + v0_ + 8); \
        nrv0 = *(const u32x4*)(z + (r0 + t_) * ZC + Z_BR + (hh_) * 128 + v0_); nrv1 = *(const u32x4*)(z + (r0 + t_) * ZC + Z_BR + (hh_) * 128 + v0_ + 8); \
        const bf16_t* sps_ = sprev + ((((size_t)b * 64 + ck) * 4 + (hh_)) * 64 + t_) * 128 + v0_;       \
        nsq0 = *(const u32x4*)(sps_); nsq1 = *(const u32x4*)(sps_ + 8); } while (0)
    GLA3_LOAD(0);
    for (int hh = 0; hh < 4; ++hh) {
        { const int t = c.tid >> 3, k0 = (c.tid & 7) * 8, v0 = (c.tid & 7) * 16;
          const u32x4 qv = nqv, kv = nkv, vv0 = nvv0, vv1 = nvv1, rv0 = nrv0, rv1 = nrv1, sq0 = nsq0, sq1 = nsq1; const f32x4 bc0 = nbc0, bc1 = nbc1;
          const unsigned qw[4] = {qv.x, qv.y, qv.z, qv.w}, kw[4] = {kv.x, kv.y, kv.z, kv.w}; const float bcv[8] = {bc0[0], bc0[1], bc0[2], bc0[3], bc1[0], bc1[1], bc1[2], bc1[3]};
          unsigned qo[4], ko[4];
#pragma unroll
          for (int e = 0; e < 4; ++e) { const float e0 = __expf(bcv[2 * e]), e1 = __expf(bcv[2 * e + 1]);
              qo[e] = pk2(bflo(qw[e]) * 0.125f * e0, bfhi(qw[e]) * 0.125f * e1); ko[e] = pk2(bflo(kw[e]) * __builtin_amdgcn_rcpf(e0), bfhi(kw[e]) * __builtin_amdgcn_rcpf(e1)); }
          *(LAS u32x4*)(qd + t * 72 + k0) = (u32x4){qo[0], qo[1], qo[2], qo[3]}; *(LAS u32x4*)(ki + t * 72 + k0) = (u32x4){ko[0], ko[1], ko[2], ko[3]};
          const unsigned vw[8] = {vv0.x, vv0.y, vv0.z, vv0.w, vv1.x, vv1.y, vv1.z, vv1.w};
#pragma unroll
          for (int e = 0; e < 8; ++e) { vT[(v0 + 2 * e) * 72 + t] = (bf16_t)(vw[e] & 0xffffu); vT[(v0 + 2 * e + 1) * 72 + t] = (bf16_t)(vw[e] >> 16); }
          const unsigned sw[8] = {sq0.x, sq0.y, sq0.z, sq0.w, sq1.x, sq1.y, sq1.z, sq1.w};
#pragma unroll
          for (int e = 0; e < 8; ++e) { sT[(v0 + 2 * e) * 72 + t] = (bf16_t)(sw[e] & 0xffffu); sT[(v0 + 2 * e + 1) * 72 + t] = (bf16_t)(sw[e] >> 16); }
          *(LAS u32x4*)(br + t * 136 + v0) = rv0; *(LAS u32x4*)(br + t * 136 + v0 + 8) = rv1; }
        __syncthreads();
        if (hh < 3) GLA3_LOAD(hh + 1);
        const bf16x8 aq0 = *(const LAS bf16x8*)(qd + (16 * rbk + r) * 72 + 8 * q), aq1 = *(const LAS bf16x8*)(qd + (16 * rbk + r) * 72 + 32 + 8 * q);
#pragma unroll
        for (int cb = 0; cb < 4; ++cb) {
            const bf16x8 b0 = *(const LAS bf16x8*)(ki + (16 * cb + r) * 72 + 8 * q), b1 = *(const LAS bf16x8*)(ki + (16 * cb + r) * 72 + 32 + 8 * q);
            f32x4 d = __builtin_amdgcn_mfma_f32_16x16x32_bf16(aq0, b0, (f32x4){0.f, 0.f, 0.f, 0.f}, 0, 0, 0); d = __builtin_amdgcn_mfma_f32_16x16x32_bf16(aq1, b1, d, 0, 0, 0);
#pragma unroll
            for (int j = 0; j < 4; ++j) scp[(4 * q + j) * 72 + 16 * cb + r] = (bf16_t)f2bf((16 * cb + r <= 16 * rbk + 4 * q + j) ? d[j] : 0.f); }
        LDS_WAIT(); __builtin_amdgcn_wave_barrier();
        const bf16x8 as0 = *(const LAS bf16x8*)(scp + r * 72 + 8 * q), as1 = *(const LAS bf16x8*)(scp + r * 72 + 32 + 8 * q);
        f32x4 o[4]; float ssq[4] = {0.f, 0.f, 0.f, 0.f};
#pragma unroll
        for (int cbl = 0; cbl < 4; ++cbl) { const int vr = 16 * (4 * half + cbl) + r;
            const bf16x8 bv0 = *(const LAS bf16x8*)(vT + vr * 72 + 8 * q), bv1 = *(const LAS bf16x8*)(vT + vr * 72 + 32 + 8 * q), bs0 = *(const LAS bf16x8*)(sT + vr * 72 + 8 * q), bs1 = *(const LAS bf16x8*)(sT + vr * 72 + 32 + 8 * q);
            f32x4 d = __builtin_amdgcn_mfma_f32_16x16x32_bf16(as0, bv0, (f32x4){0.f, 0.f, 0.f, 0.f}, 0, 0, 0); d = __builtin_amdgcn_mfma_f32_16x16x32_bf16(as1, bv1, d, 0, 0, 0);
            d = __builtin_amdgcn_mfma_f32_16x16x32_bf16(aq0, bs0, d, 0, 0, 0); d = __builtin_amdgcn_mfma_f32_16x16x32_bf16(aq1, bs1, d, 0, 0, 0);
            o[cbl] = d;
#pragma unroll
            for (int j = 0; j < 4; ++j) ssq[j] += d[j] * d[j]; }
#pragma unroll
        for (int j = 0; j < 4; ++j) { float s = ssq[j]; s += __shfl_xor(s, 1); s += __shfl_xor(s, 2); s += __shfl_xor(s, 4); s += __shfl_xor(s, 8); if (r == 0) part[half * 64 + 16 * rbk + 4 * q + j] = s; }
        __syncthreads();
#pragma unroll
        for (int j = 0; j < 4; ++j) { const int t = 16 * rbk + 4 * q + j; const float rstd = 1.f / sqrtf((part[t] + part[64 + t]) * (1.f / 128.f) + LN_EPS);
#pragma unroll
            for (int cbl = 0; cbl < 4; ++cbl) { const int v = 16 * (4 * half + cbl) + r; LAS bf16_t* bp = br + t * 136 + v; const float x = bf2f(*bp);
                *bp = (bf16_t)f2bf(o[cbl][j] * rstd * p->in[I_GNG][l * 128 + v] * (x * sigmoidf_(x))); } }
        __syncthreads();
        for (int i = c.tid; i < 1024; i += 512) { const int t = i >> 4, ch = i & 15; *(u32x4*)(ys + (r0 + t) * 2048 + 512 + hh * 128 + 8 * ch) = *(const LAS u32x4*)(br + t * 136 + 8 * ch); }
        __syncthreads();
    }
}

__device__ __forceinline__ void ph_stick(const Ctx& c0, KP p, int item) {
    const Ctx c = relaunder(c0);
    const bf16_t* z = (const bf16_t*)(p->ws + WS_Z); bf16_t* ys = (bf16_t*)(p->ws + WS_YS);
    const int b = item >> 7, hh = (item >> 4) & 7, qblk = item & 15; const size_t rb = (size_t)b * SEQ_;
    const int r = c.lane & 15, q = c.lane >> 4;
    const int tq0 = qblk * 256 + 32 * c.wave;
    volatile LAS int* flg = (volatile LAS int*)(c.lds + LDS_MISC + MISC_RED);
    bf16x8 qf[2][2];
#pragma unroll
    for (int qb = 0; qb < 2; ++qb)
#pragma unroll
        for (int ks = 0; ks < 2; ++ks) { const u32x4 v = *(const u32x4*)(z + (rb + tq0 + 16 * qb + r) * ZC + Z_CQ + hh * 64 + 32 * ks + 8 * q);
            u32x4 w; w.x = pk2(bflo(v.x) * 0.125f, bfhi(v.x) * 0.125f); w.y = pk2(bflo(v.y) * 0.125f, bfhi(v.y) * 0.125f); w.z = pk2(bflo(v.z) * 0.125f, bfhi(v.z) * 0.125f); w.w = pk2(bflo(v.w) * 0.125f, bfhi(v.w) * 0.125f);
            qf[qb][ks] = __builtin_bit_cast(bf16x8, w); }
    f32x4 oacc[4][2];
#pragma unroll
    for (int db = 0; db < 4; ++db)
#pragma unroll
        for (int qb = 0; qb < 2; ++qb) oacc[db][qb] = (f32x4){0.f, 0.f, 0.f, 0.f};
    float P[2] = {1.f, 1.f};
    const int kt_hi = qblk * 4 + 3, skey = c.tid >> 3, sd = c.tid & 7;
    u32x4 kreg, vreg;
    { const size_t row = rb + kt_hi * 64 + skey; kreg = *(const u32x4*)(z + row * ZC + Z_CK + hh * 64 + 8 * sd); vreg = *(const u32x4*)(z + row * ZC + Z_CV + hh * 64 + 8 * sd); }
#define STK_WRITE(buf) do { LAS bf16_t* Kt_ = (LAS bf16_t*)(c.lds + (buf) * 18432); LAS bf16_t* Vt_ = (LAS bf16_t*)(c.lds + (buf) * 18432 + 9216); \
        *(LAS u32x4*)(Kt_ + skey * 72 + 8 * sd) = kreg; const unsigned vw_[4] = {vreg.x, vreg.y, vreg.z, vreg.w}; \
        _Pragma("unroll") for (int e_ = 0; e_ < 4; ++e_) { Vt_[(8 * sd + 2 * e_) * 68 + skey] = (bf16_t)(vw_[e_] & 0xffffu); Vt_[(8 * sd + 2 * e_ + 1) * 68 + skey] = (bf16_t)(vw_[e_] >> 16); } } while (0)
    STK_WRITE(0);
    __syncthreads();
    bool wdone = false;
    for (int kt = kt_hi, it = 0; kt >= 0; --kt, ++it) {
        const int cur = it & 1;
        if (kt > 0) { const size_t row = rb + (kt - 1) * 64 + skey; kreg = *(const u32x4*)(z + row * ZC + Z_CK + hh * 64 + 8 * sd); vreg = *(const u32x4*)(z + row * ZC + Z_CV + hh * 64 + 8 * sd); }
        const int k0 = kt * 64;
        if (!wdone && k0 < tq0 + 31) {
            const LAS bf16_t* Kt = (const LAS bf16_t*)(c.lds + cur * 18432); const LAS bf16_t* Vt = (const LAS bf16_t*)(c.lds + cur * 18432 + 9216);
            for (int g = 1; g >= 0; --g) {
                const int g0 = k0 + 32 * g; if (g0 >= tq0 + 31) continue;
                f32x4 s[2][2];
#pragma unroll
                for (int blk = 0; blk < 2; ++blk) {
                    const bf16x8 kf0 = *(const LAS bf16x8*)(Kt + (32 * g + 16 * blk + r) * 72 + 8 * q), kf1 = *(const LAS bf16x8*)(Kt + (32 * g + 16 * blk + r) * 72 + 32 + 8 * q);
#pragma unroll
                    for (int qb = 0; qb < 2; ++qb) { f32x4 a = __builtin_amdgcn_mfma_f32_16x16x32_bf16(kf0, qf[qb][0], (f32x4){0.f, 0.f, 0.f, 0.f}, 0, 0, 0);
                        s[blk][qb] = __builtin_amdgcn_mfma_f32_16x16x32_bf16(kf1, qf[qb][1], a, 0, 0, 0); }
                }
                bf16x8 wf[2];
#pragma unroll
                for (int qb = 0; qb < 2; ++qb) {
                    const int tquery = tq0 + 16 * qb + r;
                    float w[2][4];
#pragma unroll
                    for (int blk = 1; blk >= 0; --blk) {
                        float be[4], kp[4];
#pragma unroll
                        for (int j = 0; j < 4; ++j) { const float zz = s[blk][qb][j]; const float e = __expf(-fabsf(zz)); const float rr = __builtin_amdgcn_rcpf(1.f + e); const float er = e * rr;
                            const bool valid = (g0 + 16 * blk + 4 * q + j) < tquery;
                            be[j] = valid ? (zz >= 0.f ? rr : er) : 0.f; kp[j] = valid ? (zz >= 0.f ? er : rr) : 1.f; }
                        const float p2 = kp[3], p1 = p2 * kp[2], p0 = p1 * kp[1], L = p0 * kp[0];
                        const float L16 = __shfl_xor(L, 16); const float M = L * L16; const float M32 = __shfl_xor(M, 32);
                        const float X = (q == 3) ? 1.f : (q == 2) ? L16 : (q == 1) ? M32 : L16 * M32;
                        const float base = X * P[qb];
                        w[blk][3] = be[3] * base; w[blk][2] = be[2] * p2 * base; w[blk][1] = be[1] * p1 * base; w[blk][0] = be[0] * p0 * base;
                        P[qb] *= M * M32;
                    }
                    u32x4 pw; pw.x = pk2(w[0][0], w[0][1]); pw.y = pk2(w[0][2], w[0][3]); pw.z = pk2(w[1][0], w[1][1]); pw.w = pk2(w[1][2], w[1][3]);
                    wf[qb] = __builtin_bit_cast(bf16x8, pw);
                }
#pragma unroll
                for (int db = 0; db < 4; ++db) {
                    const u32x2 v0 = *(const LAS u32x2*)(Vt + (16 * db + r) * 68 + 32 * g + 4 * q), v1 = *(const LAS u32x2*)(Vt + (16 * db + r) * 68 + 32 * g + 16 + 4 * q);
                    const bf16x8 vf = __builtin_bit_cast(bf16x8, (u32x4){v0.x, v0.y, v1.x, v1.y});
#pragma unroll
                    for (int qb = 0; qb < 2; ++qb) oacc[db][qb] = __builtin_amdgcn_mfma_f32_16x16x32_bf16(vf, wf[qb], oacc[db][qb], 0, 0, 0);
                }
            }
            wdone = __all((P[0] < 1e-30f) && (P[1] < 1e-30f));
        }
        if (c.lane == 0) flg[cur * 8 + c.wave] = wdone ? 1 : 0;
        if (kt > 0) STK_WRITE(cur ^ 1);
        __syncthreads();
        int alld = 1;
#pragma unroll
        for (int w8 = 0; w8 < 8; ++w8) alld &= flg[cur * 8 + w8];
        if (alld) break;
    }
#undef STK_WRITE
#pragma unroll
    for (int qb = 0; qb < 2; ++qb) { bf16_t* op = ys + (rb + tq0 + 16 * qb + r) * 2048 + 1024 + hh * 64 + 4 * q;
#pragma unroll
        for (int db = 0; db < 4; ++db) { const f32x4 o = oacc[db][qb]; u32x2 w; w.x = pk2(o[0], o[1]); w.y = pk2(o[2], o[3]); *(u32x2*)(op + 16 * db) = w; } }
    __syncthreads();
}

__device__ __forceinline__ void ph_ln2_router(const Ctx& c0, KP p, int l, bool fused  ) {
    const Ctx c = relaunder(c0);
    unsigned char* ws = p->ws; float* hf = (float*)(ws + WS_H); bf16_t* hb = (bf16_t*)(ws + WS_HB); const float* pre = fused ? (const float*)hf : (const float*)(ws + WS_PRE);
    int* toke = (int*)(ws + WS_TOKE); int* tokr = (int*)(ws + WS_TOKR); float* tokg = (float*)(ws + WS_TOKG); int* elist = (int*)(ws + WS_ELIST);
    unsigned* cnt = (unsigned*)(ws + WS_CTL) + CW_CNT + l * 32 * 16;
    const float* rw = p->in[I_RW] + (size_t)l * 1024 * 32; const float* rbias = p->in[I_RB] + l * 32;
    const float* g = p->in[I_LN2G] + l * 1024; const float* bb = p->in[I_LN2B] + l * 1024;
    LAS float* arow = (LAS float*)c.lds;
    LAS float* part = (LAS float*)(c.lds + 65792);
    LAS float* lgt = (LAS float*)(c.lds + 65792 + 16384);
    const int r = c.lane & 15, kq = c.lane >> 4;
    float bf0[32], bf1[32];
#pragma unroll
    for (int i = 0; i < 32; ++i) { const int k = 4 * (32 * c.wave + i) + kq; bf0[i] = rw[(size_t)k * 32 + r]; bf1[i] = rw[(size_t)k * 32 + 16 + r]; }
    for (int tile = c.bid; tile < T_ / 64; tile += c.G) {
        f32x4 nv[2][4];
#pragma unroll
        for (int rr = 0; rr < 2; ++rr)
#pragma unroll
            for (int j = 0; j < 4; ++j) nv[rr][j] = *(const f32x4*)(pre + (size_t)(tile * 64 + 2 * c.wave + rr) * 1024 + 4 * c.lane + 256 * j);
        for (int grp = 0; grp < 4; ++grp) {
            const int m0 = tile * 64 + grp * 16;
            f32x4 v[2][4];
#pragma unroll
            for (int rr = 0; rr < 2; ++rr)
#pragma unroll
                for (int j = 0; j < 4; ++j) v[rr][j] = nv[rr][j];
            if (grp < 3) {
#pragma unroll
                for (int rr = 0; rr < 2; ++rr)
#pragma unroll
                    for (int j = 0; j < 4; ++j) nv[rr][j] = *(const f32x4*)(pre + (size_t)(m0 + 16 + 2 * c.wave + rr) * 1024 + 4 * c.lane + 256 * j); }
#pragma unroll
            for (int rr = 0; rr < 2; ++rr) { const int lr = 2 * c.wave + rr, m = m0 + lr;
                if (!fused) ln_row_regs(v[rr], g, bb, c.lane, hf + (size_t)m * 1024, hb + (size_t)m * 1024);
#pragma unroll
                for (int j = 0; j < 4; ++j) *(LAS f32x4*)(arow + lr * 1028 + 4 * c.lane + 256 * j) = v[rr][j]; }
            __syncthreads();
            f32x4 acc0 = (f32x4){0.f, 0.f, 0.f, 0.f}, acc1 = (f32x4){0.f, 0.f, 0.f, 0.f};
#pragma unroll
            for (int i = 0; i < 32; ++i) { const float a = arow[r * 1028 + 4 * (32 * c.wave + i) + kq];
                acc0 = __builtin_amdgcn_mfma_f32_16x16x4f32(a, bf0[i], acc0, 0, 0, 0); acc1 = __builtin_amdgcn_mfma_f32_16x16x4f32(a, bf1[i], acc1, 0, 0, 0); }
#pragma unroll
            for (int j = 0; j < 4; ++j) { part[(c.wave * 16 + 4 * kq + j) * 32 + r] = acc0[j]; part[(c.wave * 16 + 4 * kq + j) * 32 + 16 + r] = acc1[j]; }
            __syncthreads();
            { const int row = c.tid >> 5, e = c.tid & 31; float s = rbias[e];
#pragma unroll
              for (int w = 0; w < 8; ++w) s += part[(w * 16 + row) * 32 + e];
              lgt[row * 32 + e] = s; }
            __syncthreads();
            if (c.tid < 16) { const int m = m0 + c.tid; float lg[32];
#pragma unroll
                for (int e = 0; e < 32; ++e) lg[e] = lgt[c.tid * 32 + e];
                float tv[4]; int ti[4]; unsigned taken = 0u;
#pragma unroll
                for (int k = 0; k < 4; ++k) { float best = -3.0e38f; int bi = 0;
#pragma unroll
                    for (int e = 0; e < 32; ++e) { const bool ok = !((taken >> e) & 1u) && (lg[e] > best); best = ok ? lg[e] : best; bi = ok ? e : bi; }
                    tv[k] = best; ti[k] = bi; taken |= 1u << bi; }
                float ev[4]; ev[0] = 1.f; ev[1] = __expf(tv[1] - tv[0]); ev[2] = __expf(tv[2] - tv[0]); ev[3] = __expf(tv[3] - tv[0]);
                const float inv = 1.f / (ev[0] + ev[1] + ev[2] + ev[3]);
#pragma unroll
                for (int k = 0; k < 4; ++k) { const unsigned rk = atomicAdd(cnt + ti[k] * 16, 1u); toke[m * 4 + k] = ti[k]; tokr[m * 4 + k] = (int)rk; tokg[m * 4 + k] = ev[k] * inv; elist[(size_t)ti[k] * T_ + rk] = m; } }
        }
    }
    __syncthreads();
}
__device__ __forceinline__ void ph_router_fused(const Ctx& c0, KP p, int l) {
    const Ctx c = relaunder(c0);
    unsigned char* ws = p->ws; const float* hf = (const float*)(ws + WS_H);
    int* toke = (int*)(ws + WS_TOKE); int* tokr = (int*)(ws + WS_TOKR); float* tokg = (float*)(ws + WS_TOKG); int* elist = (int*)(ws + WS_ELIST);
    unsigned* cnt = (unsigned*)(ws + WS_CTL) + CW_CNT + l * 32 * 16;
    const bf16_t* rwh = (const bf16_t*)(ws + WS_RWS) + (size_t)l * 2 * 32 * 1024; const bf16_t* rwl = rwh + 32 * 1024; const float* rbias = p->in[I_RB] + l * 32;
    LAS float* part = (LAS float*)c.lds;
    LAS float* lgt = (LAS float*)(c.lds + 16384);
    LAS int* lcnt = (LAS int*)(c.lds + 16384 + 8448);
    LAS int* lbase = lcnt + 32;
    if (c.tid < 32) lcnt[c.tid] = 0;
    __syncthreads();
    const int r = c.lane & 15, q = c.lane >> 4, rbk = c.wave & 3, kh = c.wave >> 2;
    for (int tile = c.bid; tile < T_ / 64; tile += c.G) {
        const int m0 = tile * 64;
        const float* ap = hf + (size_t)(m0 + 16 * rbk + r) * 1024 + 512 * kh + 8 * q;
        const bf16_t* bhp = rwh + (size_t)r * 1024 + 512 * kh + 8 * q; const bf16_t* blp = rwl + (size_t)r * 1024 + 512 * kh + 8 * q;
        f32x4 acc0 = (f32x4){0.f, 0.f, 0.f, 0.f}, acc1 = (f32x4){0.f, 0.f, 0.f, 0.f};
#pragma unroll 4
        for (int ks = 0; ks < 16; ++ks) {
            const f32x4 a0 = *(const f32x4*)(ap + 32 * ks), a1 = *(const f32x4*)(ap + 32 * ks + 4);
            const bf16x8 bh0 = *(const bf16x8*)(bhp + 32 * ks), bl0 = *(const bf16x8*)(blp + 32 * ks), bh1 = *(const bf16x8*)(bhp + 16 * 1024 + 32 * ks), bl1 = *(const bf16x8*)(blp + 16 * 1024 + 32 * ks);
            u32x4 hi, lo; hi.x = pk2(a0[0], a0[1]); hi.y = pk2(a0[2], a0[3]); hi.z = pk2(a1[0], a1[1]); hi.w = pk2(a1[2], a1[3]);
            lo.x = pk2(a0[0] - bflo(hi.x), a0[1] - bfhi(hi.x)); lo.y = pk2(a0[2] - bflo(hi.y), a0[3] - bfhi(hi.y)); lo.z = pk2(a1[0] - bflo(hi.z), a1[1] - bfhi(hi.z)); lo.w = pk2(a1[2] - bflo(hi.w), a1[3] - bfhi(hi.w));
            const bf16x8 ah = __builtin_bit_cast(bf16x8, hi), al = __builtin_bit_cast(bf16x8, lo);
            acc0 = __builtin_amdgcn_mfma_f32_16x16x32_bf16(ah, bh0, acc0, 0, 0, 0); acc0 = __builtin_amdgcn_mfma_f32_16x16x32_bf16(ah, bl0, acc0, 0, 0, 0); acc0 = __builtin_amdgcn_mfma_f32_16x16x32_bf16(al, bh0, acc0, 0, 0, 0);
            acc1 = __builtin_amdgcn_mfma_f32_16x16x32_bf16(ah, bh1, acc1, 0, 0, 0); acc1 = __builtin_amdgcn_mfma_f32_16x16x32_bf16(ah, bl1, acc1, 0, 0, 0); acc1 = __builtin_amdgcn_mfma_f32_16x16x32_bf16(al, bh1, acc1, 0, 0, 0); }
#pragma unroll
        for (int j = 0; j < 4; ++j) { part[(kh * 64 + 16 * rbk + 4 * q + j) * 32 + r] = acc0[j]; part[(kh * 64 + 16 * rbk + 4 * q + j) * 32 + 16 + r] = acc1[j]; }
        __syncthreads();
        for (int i = c.tid; i < 2048; i += 512) { const int row = i >> 5, e = i & 31; lgt[row * 33 + e] = part[i] + part[2048 + i] + rbias[e]; }
        __syncthreads();
        int ti[4] = {0, 0, 0, 0}, lr[4] = {0, 0, 0, 0}; float gt[4] = {0.f, 0.f, 0.f, 0.f};
        if (c.tid < 64) { float lg[32];
#pragma unroll
            for (int e = 0; e < 32; ++e) lg[e] = lgt[c.tid * 33 + e];
            float tv[4]; unsigned taken = 0u;
#pragma unroll
            for (int k = 0; k < 4; ++k) { float best = -3.0e38f; int bi = 0;
#pragma unroll
                for (int e = 0; e < 32; ++e) { const bool ok = !((taken >> e) & 1u) && (lg[e] > best); best = ok ? lg[e] : best; bi = ok ? e : bi; }
                tv[k] = best; ti[k] = bi; taken |= 1u << bi; }
            float ev[4]; ev[0] = 1.f; ev[1] = __expf(tv[1] - tv[0]); ev[2] = __expf(tv[2] - tv[0]); ev[3] = __expf(tv[3] - tv[0]);
            const float inv = 1.f / (ev[0] + ev[1] + ev[2] + ev[3]);
#pragma unroll
            for (int k = 0; k < 4; ++k) { gt[k] = ev[k] * inv; lr[k] = (int)atomicAdd((unsigned*)(lcnt + ti[k]), 1u); } }
        __syncthreads();
        if (c.tid < 32) { const unsigned n = (unsigned)lcnt[c.tid]; lbase[c.tid] = n ? (int)atomicAdd(cnt + c.tid * 16, n) : 0; lcnt[c.tid] = 0; }
        __syncthreads();
        if (c.tid < 64) { const int m = m0 + c.tid;
#pragma unroll
            for (int k = 0; k < 4; ++k) { const int rk = lbase[ti[k]] + lr[k]; toke[m * 4 + k] = ti[k]; tokr[m * 4 + k] = rk; tokg[m * 4 + k] = gt[k]; elist[(size_t)ti[k] * T_ + rk] = m; } }
    }
    __syncthreads();
}
__device__ __forceinline__ void moe_tstart(const Ctx& c, KP p, int l) {
    LAS int* ts = (LAS int*)(c.lds + LDS_MISC + MISC_MOE);
    const unsigned* cnt = (const unsigned*)(p->ws + WS_CTL) + CW_CNT + l * 32 * 16;
    if (c.tid < 64) {
        const int e = c.lane & 31; const int n = (int)__hip_atomic_load(cnt + e * 16, __ATOMIC_RELAXED, __HIP_MEMORY_SCOPE_AGENT); const int tl = (n + 255) >> 8;
        int inc = tl;
#pragma unroll
        for (int o = 1; o < 32; o <<= 1) { const int v = __shfl_up(inc, o); if ((c.lane & 31) >= o) inc += v; }
        if (c.lane < 32) { ts[e] = inc - tl; ts[33 + e] = n; if (e == 31) ts[32] = inc;
            LAS int* r2e = (LAS int*)(c.lds + LDS_MISC + MISC_R2E); for (int rt = inc - tl; rt < inc; ++rt) r2e[rt] = e; } }
    __syncthreads();
}
__device__ __forceinline__ void ph_combine(const Ctx& c0, KP p, int l, float* out_f32, bool hbres  ) {
    const Ctx c = relaunder(c0);
    unsigned char* ws = p->ws; float* hf = (float*)(ws + WS_H); bf16_t* hb = (bf16_t*)(ws + WS_HB); const bf16_t* ysl = (const bf16_t*)(ws + WS_YSL); const int* toke = (const int*)(ws + WS_TOKE); const int* tokr = (const int*)(ws + WS_TOKR); const float* tokg = (const float*)(ws + WS_TOKG);
    moe_tstart(c, p, l);
    const LAS int* ts = (const LAS int*)(c.lds + LDS_MISC + MISC_MOE);
    const float* g = p->in[I_LN3G] + l * 1024; const float* bb = p->in[I_LN3B] + l * 1024;
    const int gw = c.bid * 8 + c.wave, NGW = c.G * 8;
    for (int base = 0; gw + base * NGW < T_; base += 16) {
        const int mr = gw + (base + (c.lane >> 2)) * NGW;
        const int slotv = (mr < T_) ? ts[toke[mr * 4 + (c.lane & 3)]] * 256 + tokr[mr * 4 + (c.lane & 3)] : 0; const float gatev = (mr < T_) ? tokg[mr * 4 + (c.lane & 3)] : 0.f;
        for (int i2 = 0; i2 < 16; i2 += 2) {
            const int mA = gw + (base + i2) * NGW; if (mA >= T_) break;
            const int mB = (mA + NGW < T_) ? mA + NGW : mA;
            f32x4 va[4], vb[4]; u32x4 ya[4][2], yb2[4][2]; float ga[4], gb[4];
#pragma unroll
            for (int k = 0; k < 4; ++k) { const int sa = __builtin_amdgcn_readlane(slotv, 4 * i2 + k), sb = __builtin_amdgcn_readlane(slotv, (mB != mA) ? 4 * i2 + 4 + k : 4 * i2 + k);
                ga[k] = __uint_as_float(__builtin_amdgcn_readlane(__float_as_uint(gatev), 4 * i2 + k)); gb[k] = __uint_as_float(__builtin_amdgcn_readlane(__float_as_uint(gatev), (mB != mA) ? 4 * i2 + 4 + k : 4 * i2 + k));
#pragma unroll
                for (int j = 0; j < 2; ++j) { ya[k][j] = *(const u32x4*)(ysl + (size_t)sa * 1024 + 8 * c.lane + 512 * j); yb2[k][j] = *(const u32x4*)(ysl + (size_t)sb * 1024 + 8 * c.lane + 512 * j); } }
#pragma unroll
            for (int j = 0; j < 2; ++j) {
                if (hbres) { const u32x4 xa = *(const u32x4*)(hb + (size_t)mA * 1024 + 8 * c.lane + 512 * j), xb = *(const u32x4*)(hb + (size_t)mB * 1024 + 8 * c.lane + 512 * j);
                    va[2 * j] = DN_ALPHA * (f32x4){bflo(xa.x), bfhi(xa.x), bflo(xa.y), bfhi(xa.y)}; va[2 * j + 1] = DN_ALPHA * (f32x4){bflo(xa.z), bfhi(xa.z), bflo(xa.w), bfhi(xa.w)};
                    vb[2 * j] = DN_ALPHA * (f32x4){bflo(xb.x), bfhi(xb.x), bflo(xb.y), bfhi(xb.y)}; vb[2 * j + 1] = DN_ALPHA * (f32x4){bflo(xb.z), bfhi(xb.z), bflo(xb.w), bfhi(xb.w)}; }
                else { va[2 * j] = DN_ALPHA * *(const f32x4*)(hf + (size_t)mA * 1024 + 8 * c.lane + 512 * j); va[2 * j + 1] = DN_ALPHA * *(const f32x4*)(hf + (size_t)mA * 1024 + 8 * c.lane + 512 * j + 4);
                    vb[2 * j] = DN_ALPHA * *(const f32x4*)(hf + (size_t)mB * 1024 + 8 * c.lane + 512 * j); vb[2 * j + 1] = DN_ALPHA * *(const f32x4*)(hf + (size_t)mB * 1024 + 8 * c.lane + 512 * j + 4); } }
#pragma unroll
            for (int k = 0; k < 4; ++k)
#pragma unroll
                for (int j = 0; j < 2; ++j) { const u32x4 y = ya[k][j];
                    va[2 * j][0] += ga[k] * bflo(y.x); va[2 * j][1] += ga[k] * bfhi(y.x); va[2 * j][2] += ga[k] * bflo(y.y); va[2 * j][3] += ga[k] * bfhi(y.y);
                    va[2 * j + 1][0] += ga[k] * bflo(y.z); va[2 * j + 1][1] += ga[k] * bfhi(y.z); va[2 * j + 1][2] += ga[k] * bflo(y.w); va[2 * j + 1][3] += ga[k] * bfhi(y.w);
                    const u32x4 y2 = yb2[k][j];
                    vb[2 * j][0] += gb[k] * bflo(y2.x); vb[2 * j][1] += gb[k] * bfhi(y2.x); vb[2 * j][2] += gb[k] * bflo(y2.y); vb[2 * j][3] += gb[k] * bfhi(y2.y);
                    vb[2 * j + 1][0] += gb[k] * bflo(y2.z); vb[2 * j + 1][1] += gb[k] * bfhi(y2.z); vb[2 * j + 1][2] += gb[k] * bflo(y2.w); vb[2 * j + 1][3] += gb[k] * bfhi(y2.w); }
            ln_row_regs<true>(va, g, bb, c.lane, out_f32 ? out_f32 + (size_t)mA * 1024 : (hbres ? nullptr : hf + (size_t)mA * 1024), out_f32 ? nullptr : hb + (size_t)mA * 1024);
            if (mB != mA) ln_row_regs<true>(vb, g, bb, c.lane, out_f32 ? out_f32 + (size_t)mB * 1024 : (hbres ? nullptr : hf + (size_t)mB * 1024), out_f32 ? nullptr : hb + (size_t)mB * 1024);
        }
    }
}
#ifndef MK_MULTI_LAUNCH
#define MK_MULTI_LAUNCH 0
#endif
constexpr int PH_PER_LAYER = 13, NPH = 1 + PH_PER_LAYER * NL_;

#define PHASE_ENTER \
    Ctx c; { int t_ = threadIdx.x; asm volatile("" : "+v"(t_)); c.tid = t_; c.lane = t_ & 63; c.wave = __builtin_amdgcn_readfirstlane(t_ >> 6); { int g_ = gridDim.x, b_ = blockIdx.x; asm volatile("" : "+s"(g_), "+s"(b_)); c.G = g_; c.bid = b_; } c.lds = lds; } \
    KP p = kp0; asm volatile("" : "+s"(p)); int l = l0; asm volatile("" : "+s"(l)); unsigned char* ws = p->ws; (void)l; (void)ws; \
    const char* lw = (const char*)ws + WS_W + (size_t)l * LW_END; (void)lw;

__global__ void __launch_bounds__(512, 2) fwd_kernel(Params p_arg) {
    extern __shared__ __attribute__((aligned(16))) unsigned char lds_raw[];
    LAS unsigned char* lds = (LAS unsigned char*)lds_raw;
    const KP kp0 = (KP)__builtin_amdgcn_kernarg_segment_ptr();
    if (threadIdx.x < 4) ((LAS unsigned*)(lds + LDS_MISC + MISC_BAR))[threadIdx.x] = 0u;
    __syncthreads();
    const int ph_lo = kp0->ph_lo, ph_hi = kp0->ph_hi;
    XcdBarrier bar;
    { unsigned* bw = (unsigned*)(kp0->ws + WS_CTL) + CW_BAR + kp0->li * XCD_BAR_WORDS;
      bar.bar = bw; bar.x = 0; bar.st = (volatile LAS unsigned*)(lds + LDS_MISC + MISC_BAR);
      if (ph_hi - ph_lo > 1) bar = xcd_barrier_post(bw, (volatile LAS unsigned*)(lds + LDS_MISC + MISC_BAR)); }
    int ph = 0;
#define RUN (ph >= kp0->ph_lo && ph < kp0->ph_hi)
#define SEAM do { if (ph + 1 < kp0->ph_hi) xcd_barrier(bar); } while (0)

    { const int l0 = 0;
      if (RUN) { PHASE_ENTER; ph_prologue(c, p, (c.G == 256) ? 0 : 2, c.bid * 8 + c.wave, c.G * 8); SEAM; } ++ph; }

    for (int l0 = 0; l0 < NL_; ++l0) {
        if (RUN) { PHASE_ENTER;
            const bool split = (l == 0) && (c.G == 256); const int cc = (c.bid & 7) + 8 * (c.bid >> 4);
            if (split && ((c.bid >> 3) & 1)) ph_prologue(c, p, 1, cc * 8 + c.wave, 128 * 8);
            else { SchedInProj S{(const char*)ws + WS_HB, lw + LW_WIN, (char*)ws + WS_Z, split ? 128 : c.G, split ? cc : c.bid}; EpiStoreBf16T<true> E{p->in[I_BIN] + (size_t)l * INC, 1.f};
                pg8::gemm_phase(lds, pg8::Gemm{1024, 1024, 1024}, S, E); }
            SEAM; } ++ph;
        if (RUN) { PHASE_ENTER;
            const int skip = p->pad;
            if (!(skip & 1)) for (int it = c.bid; it < 256; it += c.G) ph_conv_a(c, p, l, it);
            if (!(skip & 2)) for (int it = c.bid; it < 256; it += c.G) ph_gla1(c, p, l, it);
            if (!(skip & 4)) for (int it = c.bid; it < 256; it += c.G) ph_lru<1>(c, p, l, it);
            if (!(skip & 8)) for (int it = c.bid; it < 512; it += c.G) ph_stick(c, p, it);
            if (l == 0) { SchedKV S{(const char*)ws, c.G, c.bid}; EpiStoreBf16 E{nullptr, 1.f}; pg8::gemm_phase(lds, pg8::Gemm{1024, 1024, 1024}, S, E); }
            SEAM; } ++ph;
        if (RUN) { PHASE_ENTER; ph_gla2(c, p); ph_lru_carry(c, p); SEAM; } ++ph;
        if (RUN) { PHASE_ENTER;
            const int skip = p->pad;
            if (!(skip & 1)) for (int it = c.bid; it < 256; it += c.G) ph_gla3(c, p, l, it);
            if (!(skip & 2)) for (int it = c.bid; it < 256; it += c.G) ph_lru<3>(c, p, l, it);
            if (l == 0) {
                { SchedMq S{(const char*)ws, c.G, c.bid}; EpiStoreBf16 E{nullptr, 0.0625f}; pg8::gemm_phase(lds, pg8::Gemm{2048, 1024, 256}, S, E); }
                { SchedVw S{(const char*)ws, c.G, c.bid}; EpiStoreBf16 E{nullptr, 1.f}; pg8::gemm_phase(lds, pg8::Gemm{1024, 2048, 256}, S, E); } }
            SEAM; } ++ph;
        if (RUN) { PHASE_ENTER; SchedBranch S{(const char*)ws + WS_YS, lw + LW_WBR, c.G, c.bid}; EpiMerge E{(const bf16_t*)(ws + WS_Z), (bf16_t*)(ws + WS_MB), p->pad};
            pg8::gemm_phase(lds, pg8::Gemm{2048, 2048, 2048}, S, E); SEAM; } ++ph;
        if (RUN) { PHASE_ENTER; SchedSq S{(const char*)ws + WS_MB, lw + LW_WOUT, nullptr, 4, c.G, c.bid};
            if (c.G == 256) { EpiResidLNT<false, false> E{p->in[I_BOUT] + l * 1024, p->in[I_LN1G] + l * 1024, p->in[I_LN1B] + l * 1024, ws,
                    (LAS float*)(lds + LDS_MISC + MISC_XCH), (LAS float*)(lds + LDS_MISC + MISC_STAT), (unsigned*)(ws + WS_CTL) + CW_LN + (l * 2 + 0) * 64 * 16, nullptr, nullptr, 0};
                pg8::gemm_phase(lds, pg8::Gemm{1024, 1024, 1024}, S, E); }
            else { EpiResid E{p->in[I_BOUT] + l * 1024, (const float*)(ws + WS_H), (float*)(ws + WS_PRE)}; pg8::gemm_phase(lds, pg8::Gemm{1024, 1024, 1024}, S, E); }
            SEAM; } ++ph;
        if (RUN && gridDim.x != 256) { PHASE_ENTER; ln_rows_phase(c, (const float*)(ws + WS_PRE), p->in[I_LN1G] + l * 1024, p->in[I_LN1B] + l * 1024, (float*)(ws + WS_H), (bf16_t*)(ws + WS_HB)); SEAM; } ++ph;
        if (RUN) { PHASE_ENTER; SchedXB S{(const char*)ws + WS_HB, (const char*)ws + WS_MQT + (size_t)l * 4 * SZ_W1K, (char*)ws + WS_P, 2, c.G, c.bid}; EpiSoftmax E{(LAS float*)(lds + LDS_MISC + MISC_XCH)};
            pg8::gemm_phase(lds, pg8::Gemm{1024, 1024, 1024}, S, E); SEAM; } ++ph;
        if (RUN) { PHASE_ENTER; SchedXB S{(const char*)ws + WS_P, (const char*)ws + WS_VWT + (size_t)l * 4 * SZ_W1K, nullptr, 4, c.G, c.bid};
            if (c.G == 256) { EpiResidLNT<false, true> E{nullptr, p->in[I_LN2G] + l * 1024, p->in[I_LN2B] + l * 1024, ws,
                    (LAS float*)(lds + LDS_MISC + MISC_XCH), (LAS float*)(lds + LDS_MISC + MISC_STAT), (unsigned*)(ws + WS_CTL) + CW_LN + (l * 2 + 1) * 64 * 16, (LAS char*)lds, p->in[I_RB] + l * 32, l};
                pg8::gemm_phase(lds, pg8::Gemm{1024, 1024, 1024}, S, E); }
            else { EpiResid E{nullptr, (const float*)(ws + WS_H), (float*)(ws + WS_PRE)}; pg8::gemm_phase(lds, pg8::Gemm{1024, 1024, 1024}, S, E); }
            SEAM; } ++ph;
        if (RUN && gridDim.x != 256) { PHASE_ENTER; ph_ln2_router(c, p, l, false); SEAM; } ++ph;
        if (RUN && gridDim.x == 256) { PHASE_ENTER; moe_tstart(c, p, l);
            SchedMoeX S{(const char*)ws + WS_HB, lw + LW_W1, lw + LW_W2, (char*)ws + WS_ACT, (char*)ws + WS_YSL, (const LAS int*)(lds + LDS_MISC + MISC_MOE), (const int*)(ws + WS_ELIST),
                        (unsigned*)(ws + WS_CTL) + CW_MOE + l * 288 * 16, c.G, c.bid};
            EpiMoeX E{p->in[I_B1] + (size_t)l * 32 * 2048, p->in[I_B2] + (size_t)l * 32 * 1024};
            pg8::gemm_phase(lds, pg8::Gemm{1024, 1024, 1024}, S, E); SEAM; }
        else if (RUN) { PHASE_ENTER; moe_tstart(c, p, l);
            SchedMoe<8, 2048, 128, 1, true> S{(const char*)ws + WS_HB, lw + LW_W1, (char*)ws + WS_ACT, (const LAS int*)(lds + LDS_MISC + MISC_MOE), (const int*)(ws + WS_ELIST), c.G, c.bid}; EpiSwiGLU E{p->in[I_B1] + (size_t)l * 32 * 2048};
            pg8::gemm_phase(lds, pg8::Gemm{1024, 1024, 1024}, S, E); SEAM; } ++ph;
        if (RUN && gridDim.x != 256) { PHASE_ENTER; moe_tstart(c, p, l);
            SchedMoe<4, 1024, 256, 1024, false> S{(const char*)ws + WS_ACT, lw + LW_W2, (char*)ws + WS_YSL, (const LAS int*)(lds + LDS_MISC + MISC_MOE), nullptr, c.G, c.bid}; EpiStoreBf16 E{p->in[I_B2] + (size_t)l * 32 * 1024, 1.f};
            pg8::gemm_phase(lds, pg8::Gemm{1024, 1024, 1024}, S, E); SEAM; } ++ph;
        if (RUN) { PHASE_ENTER; ph_combine(c, p, l, (l == NL_ - 1) ? p->out : nullptr, c.G == 256); SEAM; } ++ph;
    }
#undef RUN
#undef SEAM
}

extern "C" void kernel_launch(void* const* d_in, const int* in_sizes, int n_in, void* d_out, int out_size, void* d_ws, size_t ws_size, hipStream_t stream) {
    static int grid = 0;
    if (grid == 0) {
        if (n_in != 39 || in_sizes[0] != T_ * D_ || out_size != T_ * D_ || ws_size < WS_END) {
            fprintf(stderr, "kernel_launch: unexpected shapes (n_in %d, in0 %d, out %d, ws %zu, need %zu)\n", n_in, n_in > 0 ? in_sizes[0] : -1, out_size, ws_size, (size_t)WS_END); grid = -1; return; }
        int dev = 0, cus = 0, per_cu = 0;
        if (hipGetDevice(&dev) != hipSuccess || hipDeviceGetAttribute(&cus, hipDeviceAttributeMultiprocessorCount, dev) != hipSuccess) { grid = -1; return; }
        if (hipFuncSetAttribute((const void*)fwd_kernel, hipFuncAttributeMaxDynamicSharedMemorySize, LDS_BYTES) != hipSuccess) { fprintf(stderr, "kernel_launch: hipFuncSetAttribute failed\n"); grid = -1; return; }
        if (hipOccupancyMaxActiveBlocksPerMultiprocessor(&per_cu, (const void*)fwd_kernel, 512, LDS_BYTES) != hipSuccess || per_cu < 1) { fprintf(stderr, "kernel_launch: occupancy query says %d\n", per_cu); grid = -1; return; }
        grid = cus;
    }
    if (grid <= 0) return;
    (void)hipMemsetAsync((char*)d_ws + WS_CTL, 0, CTL_BYTES, stream);
    Params p{};
    for (int i = 0; i < 39; ++i) p.in[i] = (const float*)d_in[i];
    p.out = (float*)d_out; p.ws = (unsigned char*)d_ws; p.li = 0; p.pad = 0;
#if MK_MULTI_LAUNCH
    for (int ph = 0; ph < NPH; ++ph) { p.ph_lo = ph; p.ph_hi = ph + 1; hipLaunchKernelGGL(fwd_kernel, dim3(grid), dim3(512), LDS_BYTES, stream, p); }
#else
    p.ph_lo = 0; p.ph_hi = NPH;
    hipLaunchKernelGGL(fwd_kernel, dim3(grid), dim3(512), LDS_BYTES, stream, p);
#endif
#if defined(PROBE_K) && PROBE_K > 0
    p.pad = PROBE_SKIP;
    for (int r = 0; r < PROBE_K; ++r) { p.ph_lo = PROBE_PH; p.ph_hi = PROBE_PH + 1; hipLaunchKernelGGL(fwd_kernel, dim3(grid), dim3(512), LDS_BYTES, stream, p); }
#endif
}
```

```cpp
#define MK_MULTI_LAUNCH 0
#include <hip/hip_runtime.h>
#include <stdint.h>
#include <stdio.h>

#define LAS __attribute__((address_space(3)))
typedef unsigned short bf16_t;
typedef short bf16x8 __attribute__((ext_vector_type(8)));
typedef float f32x4 __attribute__((ext_vector_type(4)));
typedef float f32x2 __attribute__((ext_vector_type(2)));
typedef unsigned u32x4 __attribute__((ext_vector_type(4)));
typedef unsigned u32x2 __attribute__((ext_vector_type(2)));

constexpr int T_ = 16384, D_ = 1024, NB_ = 4, SEQ_ = 4096, NL_ = 4;
constexpr int INC = 9232;
constexpr int ZC = 9216;
constexpr int LR_COL = 2560;
constexpr int Z_AVAL = 0, Z_AGATE = 512, Z_BQ = 1024, Z_BK = 1280, Z_BV = 1536, Z_BR = 2048, Z_CQ = 2560, Z_CK = 3072, Z_CV = 3584, Z_DX = 4096, Z_DG = 4608, Z_GM = 5120;
constexpr int NEXP = 32, TOPK = 4;
constexpr int NSLOT = 73728;
constexpr float LN_EPS = 1e-5f;
constexpr float DN_ALPHA = 1.6817928305074290f;

__device__ __forceinline__ float bf2f(unsigned v) { return __uint_as_float(v << 16); }
__device__ __forceinline__ float bflo(unsigned v) { return __uint_as_float(v << 16); }
__device__ __forceinline__ float bfhi(unsigned v) { return __uint_as_float(v & 0xffff0000u); }
__device__ __forceinline__ unsigned f2bf(float f) { unsigned u = __float_as_uint(f); u += 0x7FFFu + ((u >> 16) & 1u); return u >> 16; }
typedef __bf16 bf16x2_t __attribute__((ext_vector_type(2)));
__device__ __forceinline__ unsigned pk2(float lo, float hi) { const f32x2 v = {lo, hi}; return __builtin_bit_cast(unsigned, __builtin_convertvector(v, bf16x2_t)); }
__device__ __forceinline__ float wave_sum(float v) {
#pragma unroll
    for (int o = 1; o < 64; o <<= 1) v += __shfl_xor(v, o);
    return v;
}
__device__ __forceinline__ float sigmoidf_(float x) { return __builtin_amdgcn_rcpf(1.f + __expf(-x)); }
__device__ __forceinline__ float softplusf_(float x) { return fmaxf(x, 0.f) + __logf(1.f + __expf(-fabsf(x))); }
#define LDS_WAIT() asm volatile("s_waitcnt lgkmcnt(0)" ::: "memory")

namespace pg8 {
constexpr int BM = 256, BK = 64, HALF = 128, HTB = HALF * BK * 2, STAGE_BYTES = 8 * HTB;
__host__ __device__ __forceinline__ int lds_byte(int r, int c) { const int st = (r >> 4) * 2 + (c >> 5), rr = r & 15, cc = c & 31, ob = rr * 64 + cc * 2; return st * 1024 + (ob ^ (((ob >> 9) & 1) << 5)); }
__host__ __device__ __forceinline__ void stage_rc(int b, int& R, int& C) { const int st = b / 1024, sb = b % 1024, swz = sb ^ (((sb >> 9) & 1) << 5); R = (st >> 1) * 16 + swz / 64; C = (st & 1) * 32 + (swz % 64) / 2; }
__host__ __device__ __forceinline__ int perm32(int rho) { const int n = rho >> 4, i = rho & 15; return 8 * (i >> 2) + 4 * n + (i & 3); }

struct Unit { const char* a; const char* b; char* c; int ldc, row0, col0, aux, g0, g1, kind; };
struct Gemm { int lda, ldb, K; };

__device__ __forceinline__ void swz_tile(int L, int nM, int nN, int& pm, int& pn) {
    const int nwg = nM * nN; int wgid = L;
    { const int q = nwg / 8, r = nwg % 8, xcd = wgid % 8, off = wgid / 8; wgid = (xcd < r ? xcd * (q + 1) : r * (q + 1) + (xcd - r) * q) + off; }
    const int nig = 8 * nN, gid = wgid / nig, fm = gid * 8, gsz = (nM - fm) < 8 ? (nM - fm) : 8;
    pm = fm + ((wgid % nig) % gsz); pn = (wgid % nig) / gsz;
}

template <class Epi, class Sched>
__device__ __forceinline__ void gemm_phase(LAS unsigned char* lds, const Gemm g, const Sched& S, const Epi& E) {
    int tid_ = threadIdx.x; asm volatile("" : "+v"(tid_));
    const int tid = tid_, wid = __builtin_amdgcn_readfirstlane(tid >> 6), lane = tid & 63, wr = wid >> 2, wc = wid & 3, fr = lane & 15, fq = lane >> 4;
    const int K = g.K, nt = K / BK;
    unsigned voffA[2][2], nvoffA[2][2], voffB[2]; int RA[2], CA[2];
#pragma unroll
    for (int i = 0; i < 2; ++i) { int R, C; stage_rc(tid * 16 + i * 8192, R, C); const int Rb = Epi::PERM ? ((R & ~31) + perm32(R & 31)) : R; RA[i] = R; CA[i] = C;
        voffA[0][i] = (unsigned)(R * g.lda + C) * 2u; voffA[1][i] = (unsigned)((R + HALF) * g.lda + C) * 2u; voffB[i] = (unsigned)(Rb * g.ldb + C) * 2u; }
    const size_t kstep = (size_t)(BK * 2);
    const size_t hstepB = (size_t)HALF * g.ldb * 2;
    const unsigned ldsw = (unsigned)wid * 1024u;
    const int aoff = lds_byte(wr * 64 + fr, fq * 8), boff = lds_byte(wc * 32 + fr, fq * 8);
#define PG8_SA(b, h) (((b) * 2 + (h)) * HTB)
#define PG8_SB(b, h) ((4 + (b) * 2 + (h)) * HTB)
#define PG8_STAGE(bufoff, gbase, voff) do { _Pragma("unroll") for (int _i = 0; _i < 2; ++_i) \
        __builtin_amdgcn_global_load_lds((const unsigned*)((const char*)(gbase) + (voff)[_i]), (LAS unsigned*)(lds + (bufoff) + ldsw + _i * 8192), 16, 0, 0); } while (0)
#define PG8_STAGEA(b, h, gbase, vo) PG8_STAGE(PG8_SA(b, h), gbase, (vo)[h])
#define PG8_LDA(dst, b, h) do { _Pragma("unroll") for (int m = 0; m < 4; ++m) _Pragma("unroll") for (int k = 0; k < 2; ++k) dst[m][k] = *(const LAS bf16x8*)(lds + PG8_SA(b, h) + aoff + m * 2048 + k * 1024); } while (0)
#define PG8_LDB(dst, b, h) do { _Pragma("unroll") for (int n = 0; n < 2; ++n) _Pragma("unroll") for (int k = 0; k < 2; ++k) dst[n][k] = *(const LAS bf16x8*)(lds + PG8_SB(b, h) + boff + n * 2048 + k * 1024); } while (0)
#define PG8_MMA(ai, bj, At, Bt) do { __builtin_amdgcn_s_setprio(1); _Pragma("unroll") for (int m = 0; m < 4; ++m) _Pragma("unroll") for (int n = 0; n < 2; ++n) _Pragma("unroll") for (int k = 0; k < 2; ++k) \
        acc[ai][bj][m][n] = __builtin_amdgcn_mfma_f32_16x16x32_bf16(Bt[n][k], At[m][k], acc[ai][bj][m][n], 0, 0, 0); __builtin_amdgcn_s_setprio(0); } while (0)
#define PG8_WAIT_V(n) asm volatile("s_waitcnt vmcnt(" #n ")" ::: "memory")
#define PG8_WAIT_L(n) asm volatile("s_waitcnt lgkmcnt(" #n ")" ::: "memory")
#define PG8_BAR __builtin_amdgcn_s_barrier()
#define PG8_SCHED __builtin_amdgcn_sched_barrier(0)
    Unit cur, nxt; int ui = 0;
    if (!S.next(0, cur)) return;
    f32x4 acc[2][2][4][2];
#pragma unroll
    for (int a = 0; a < 2; ++a)
#pragma unroll
        for (int b = 0; b < 2; ++b)
#pragma unroll
            for (int m = 0; m < 4; ++m)
#pragma unroll
                for (int n = 0; n < 2; ++n) acc[a][b][m][n] = (f32x4){0.f, 0.f, 0.f, 0.f};
    bf16x8 At[4][2], B0[2][2], B1[2][2];
    const char* cA = cur.a; const char* cB = cur.b;
    int pend = -1;
    if constexpr (Sched::COUNTED) S.a_ready(cur);
    if constexpr (Sched::GATHER) {
#pragma unroll
        for (int h = 0; h < 2; ++h)
#pragma unroll
            for (int i = 0; i < 2; ++i) voffA[h][i] = S.rowoff(cur, h * HALF + RA[i]) + (unsigned)CA[i] * 2u; }
    PG8_STAGE(PG8_SB(0, 0), cB, voffB); PG8_STAGE(PG8_SB(0, 1), cB + hstepB, voffB); PG8_STAGEA(0, 0, cA, voffA); PG8_STAGEA(0, 1, cA, voffA);
    if (wr == 1) PG8_BAR;
    PG8_WAIT_V(2); PG8_BAR;
    PG8_STAGE(PG8_SB(1, 0), cB + kstep, voffB); PG8_STAGEA(1, 0, cA + kstep, voffA); PG8_STAGE(PG8_SB(1, 1), cB + hstepB + kstep, voffB);
    PG8_WAIT_V(6); PG8_BAR;
    for (;;) {
        const bool has_next = S.next(ui + 1, nxt);
        if constexpr (Sched::GATHER) { if (has_next) {
#pragma unroll
            for (int h = 0; h < 2; ++h)
#pragma unroll
                for (int i = 0; i < 2; ++i) nvoffA[h][i] = S.rowoff(nxt, h * HALF + RA[i]) + (unsigned)CA[i] * 2u; } }
        const char* nA = has_next ? nxt.a : cA; const char* nB = has_next ? nxt.b : cB;
#pragma unroll 1
        for (int t = 0; t < nt; t += 2) {
            const bool last = (t == nt - 2);
            if constexpr (Sched::COUNTED) { if (last) {
                if (pend >= 0) { S.publish(pend, lane); pend = -1; }
                if (has_next) S.a_ready(nxt); } }
            const char* a1 = cA + (size_t)(t + 1) * kstep;
            const char* a2 = last ? nA : cA + (size_t)(t + 2) * kstep; const char* b2 = last ? nB : cB + (size_t)(t + 2) * kstep;
            const char* a3 = a2 + kstep; const char* b3 = b2 + kstep;
            unsigned vo2[2][2];
#pragma unroll
            for (int h = 0; h < 2; ++h)
#pragma unroll
                for (int i = 0; i < 2; ++i) vo2[h][i] = (Sched::GATHER && last && has_next) ? nvoffA[h][i] : voffA[h][i];
            PG8_LDB(B0, 0, 0); PG8_LDB(B1, 0, 1); PG8_SCHED; PG8_LDA(At, 0, 0); PG8_STAGEA(1, 1, a1, voffA);
            PG8_WAIT_V(8); PG8_WAIT_L(0); PG8_BAR; PG8_MMA(0, 0, At, B0); PG8_MMA(0, 1, At, B1); PG8_BAR; PG8_SCHED;
            PG8_LDA(At, 0, 1); PG8_STAGE(PG8_SB(0, 0), b2, voffB); PG8_STAGE(PG8_SB(0, 1), b2 + hstepB, voffB); PG8_STAGEA(0, 0, a2, vo2);
            PG8_WAIT_V(8); PG8_WAIT_L(0); PG8_BAR; PG8_MMA(1, 0, At, B0); PG8_MMA(1, 1, At, B1); PG8_BAR; PG8_SCHED;
            PG8_LDB(B0, 1, 0); PG8_LDB(B1, 1, 1); PG8_SCHED; PG8_LDA(At, 1, 0); PG8_STAGEA(0, 1, a2, vo2);
            PG8_WAIT_V(8); PG8_WAIT_L(0); PG8_BAR; PG8_MMA(0, 0, At, B0); PG8_MMA(0, 1, At, B1); PG8_BAR; PG8_SCHED;
            PG8_LDA(At, 1, 1); PG8_STAGE(PG8_SB(1, 0), b3, voffB); PG8_STAGE(PG8_SB(1, 1), b3 + hstepB, voffB); PG8_STAGEA(1, 0, a3, vo2);
            PG8_WAIT_V(8); PG8_WAIT_L(0); PG8_BAR; PG8_MMA(1, 0, At, B0); PG8_MMA(1, 1, At, B1); PG8_BAR; PG8_SCHED;
            if constexpr (Epi::SEG > 0) {
                if (!last && ((t + 2) % Epi::SEG) == 0) { int fr_e = fr, fq_e = fq; asm volatile("" : "+v"(fr_e), "+v"(fq_e)); E.mid(acc, cur, (t + 2) / Epi::SEG - 1, wr, wc, fr_e, fq_e); } }
        }
        if (wr == 0) PG8_BAR;
        { int fr_e = fr, fq_e = fq; asm volatile("" : "+v"(fr_e), "+v"(fq_e));
          E(acc, cur, wr, wc, fr_e, fq_e); }
        if constexpr (Sched::COUNTED) pend = S.pending(cur);
        if (!has_next) break;
#pragma unroll
        for (int a = 0; a < 2; ++a)
#pragma unroll
            for (int b = 0; b < 2; ++b)
#pragma unroll
                for (int m = 0; m < 4; ++m)
#pragma unroll
                    for (int n = 0; n < 2; ++n) acc[a][b][m][n] = (f32x4){0.f, 0.f, 0.f, 0.f};
        cur = nxt; cA = nA; cB = nB; ++ui;
        if constexpr (Sched::GATHER) {
#pragma unroll
            for (int h = 0; h < 2; ++h)
#pragma unroll
                for (int i = 0; i < 2; ++i) voffA[h][i] = nvoffA[h][i]; }
        if (wr == 1) PG8_BAR;
    }
    PG8_WAIT_V(0);
    if constexpr (Sched::COUNTED) { if (pend >= 0) S.publish(pend, lane); }
    PG8_BAR;
#undef PG8_SA
#undef PG8_SB
#undef PG8_STAGE
#undef PG8_STAGEA
#undef PG8_LDA
#undef PG8_LDB
#undef PG8_MMA
#undef PG8_WAIT_V
#undef PG8_WAIT_L
#undef PG8_BAR
#undef PG8_SCHED
}
}

#define XB_TMO      128
#define XB_XCNT(j)  (256  + 64 * (j))
#define XB_XSUB(j)  (1280 + 64 * (j))
#define XB_XGEN(j)  (2304 + 64 * (j))
#define XB_TOP      3328
#define XB_TOPGEN   3392
#define XCD_BAR_WORDS 3456
#define XB_SPIN_CAP (1u << 18)
__device__ __forceinline__ unsigned xb_ld(unsigned* p)              { return __hip_atomic_load(p, __ATOMIC_RELAXED, __HIP_MEMORY_SCOPE_AGENT); }
__device__ __forceinline__ unsigned xb_add(unsigned* p, unsigned v) { return __hip_atomic_fetch_add(p, v, __ATOMIC_RELAXED, __HIP_MEMORY_SCOPE_AGENT); }
__device__ __forceinline__ unsigned xb_xcc_id() { return (unsigned)__builtin_amdgcn_s_getreg((3 << 11) | 20) & 0xFu; }
#define XB_SPIN(cond, bar) do { unsigned _sp = 0; while (cond) { __builtin_amdgcn_s_sleep(1); \
    if ((++_sp & 255u) == 0u) { if (xb_ld(&(bar)[XB_TMO])) break; if (_sp > XB_SPIN_CAP) { atomicAdd(&(bar)[XB_TMO], 1u); break; } } } } while (0)
struct XcdBarrier { unsigned* bar; unsigned x; volatile LAS unsigned* st; };
__device__ __forceinline__ XcdBarrier xcd_barrier_post(unsigned* bar, volatile LAS unsigned* st) {
    XcdBarrier b; b.bar = bar; b.x = xb_xcc_id(); b.st = st;
    if (threadIdx.x == 0) (void)xb_add(&bar[XB_XCNT(b.x)], 1u);
    return b;
}
__device__ __forceinline__ void xcd_barrier_complete(unsigned* bar, unsigned x, unsigned& nloc, unsigned& nx) {
    const unsigned G = gridDim.x * gridDim.y * gridDim.z;
    unsigned sum, cnt, mine, sp = 0u;
    for (;;) {
        sum = 0u; cnt = 0u; mine = 0u;
#pragma unroll
        for (unsigned j = 0; j < 16; ++j) { const unsigned c = xb_ld(&bar[XB_XCNT(j)]); sum += c; cnt += (c > 0u) ? 1u : 0u; mine = (j == x) ? c : mine; }
        if (sum == G) break;
        __builtin_amdgcn_s_sleep(1);
        if ((++sp & 255u) == 0u) { if (xb_ld(&bar[XB_TMO])) break; if (sp > XB_SPIN_CAP) { atomicAdd(&bar[XB_TMO], 1u); break; } }
    }
    nloc = mine > 0u ? mine : 1u; nx = cnt > 0u ? cnt : 1u;
}
__device__ __forceinline__ void xcd_barrier(const XcdBarrier& b) {
    asm volatile("s_waitcnt vmcnt(0)" ::: "memory");
    __syncthreads();
    if (threadIdx.x == 0) {
        unsigned* bar = b.bar;
        __builtin_amdgcn_s_waitcnt(0);
        unsigned nloc = b.st[0], nx = b.st[1];
        if (nloc == 0u) { xcd_barrier_complete(bar, b.x, nloc, nx); b.st[0] = nloc; b.st[1] = nx; }
        const unsigned old = xb_add(&bar[XB_XSUB(b.x)], 1u);
        const unsigned gen = old / nloc;
        if (old + 1u == (gen + 1u) * nloc) {
            __builtin_amdgcn_fence(__ATOMIC_RELEASE, "agent");
            asm volatile("s_waitcnt vmcnt(0)" ::: "memory");
            const unsigned og = xb_add(&bar[XB_TOP], 1u);
            const unsigned tg = og / nx;
            if (og + 1u == (tg + 1u) * nx) xb_add(&bar[XB_TOPGEN], 1u);
            else XB_SPIN(xb_ld(&bar[XB_TOPGEN]) == tg, bar);
            xb_add(&bar[XB_XGEN(b.x)], 1u);
            __builtin_amdgcn_fence(__ATOMIC_ACQUIRE, "agent");
            asm volatile("s_waitcnt vmcnt(0)" ::: "memory");
        } else {
            asm volatile("buffer_inv sc1" ::: "memory");
            XB_SPIN(xb_ld(&bar[XB_XGEN(b.x)]) == gen, bar);
            asm volatile("s_waitcnt vmcnt(0)" ::: "memory");
        }
    }
    __syncthreads();
}
constexpr size_t al256(size_t x) { return (x + 255) & ~(size_t)255; }
constexpr size_t WS_CTL = 0, CTL_BYTES = 256u << 10;
constexpr size_t SZ_WIN = (size_t)ZC * 1024 * 2, SZ_WBR = (size_t)4 * 1024 * 512 * 2, SZ_W1K = (size_t)1024 * 1024 * 2, SZ_WKV = 2 * SZ_W1K;
constexpr size_t SZ_W1 = (size_t)NEXP * 2048 * 1024 * 2, SZ_W2 = (size_t)NEXP * 1024 * 1024 * 2;
constexpr size_t LW_WIN = 0, LW_WBR = LW_WIN + SZ_WIN, LW_WOUT = LW_WBR + SZ_WBR, LW_WQ = LW_WOUT + SZ_W1K, LW_WKV = LW_WQ + SZ_W1K, LW_WO = LW_WKV + SZ_WKV,
                 LW_W1 = LW_WO + SZ_W1K, LW_W2 = LW_W1 + SZ_W1, LW_END = LW_W2 + SZ_W2;
constexpr size_t WS_W = WS_CTL + CTL_BYTES;
constexpr size_t WS_MEMB = WS_W + NL_ * LW_END;
constexpr size_t WS_KMEM = WS_MEMB + SZ_W1K;
constexpr size_t WS_MQT = WS_KMEM + NL_ * 2 * SZ_W1K;
constexpr size_t WS_VWT = WS_MQT + NL_ * 4 * SZ_W1K;
constexpr size_t WS_H = WS_VWT + NL_ * 4 * SZ_W1K;
constexpr size_t WS_HB = WS_H + (size_t)T_ * 1024 * 4;
constexpr size_t WS_Z = WS_HB + (size_t)T_ * 1024 * 2;
constexpr size_t WS_BCUM = WS_Z + (size_t)T_ * ZC * 2;
constexpr size_t WS_KVST = WS_BCUM + (size_t)T_ * 256 * 4;
constexpr size_t WS_SPREV = WS_KVST + (size_t)4 * 64 * 4 * 64 * 128 * 4;
constexpr size_t WS_LAGG = WS_SPREV + (size_t)4 * 64 * 4 * 64 * 128 * 4;
constexpr size_t WS_YS = WS_LAGG + (size_t)3 * 4 * 64 * 512 * 4;
constexpr size_t WS_MF = WS_YS + (size_t)T_ * 2048 * 2;
constexpr size_t WS_MB = WS_MF + (size_t)3 * T_ * 1024 * 2;
constexpr size_t WS_PRE = WS_MB + (size_t)T_ * 1024 * 2;
constexpr size_t WS_Q = WS_PRE + (size_t)T_ * 1024 * 4;
constexpr size_t WS_P = WS_Q + (size_t)T_ * 1024 * 2;
constexpr size_t WS_O = WS_P + (size_t)T_ * 1024 * 2;
constexpr size_t WS_TOKE = WS_O + (size_t)T_ * 1024 * 2;
constexpr size_t WS_TOKR = WS_TOKE + (size_t)T_ * 4 * 4;
constexpr size_t WS_TOKG = WS_TOKR + (size_t)T_ * 4 * 4;
constexpr size_t WS_TOKS = WS_TOKG + (size_t)T_ * 4 * 4;
constexpr size_t WS_SGATE = WS_TOKS + (size_t)T_ * 4 * 4;
constexpr size_t WS_XS = al256(WS_SGATE + (size_t)NSLOT * 4);
constexpr size_t WS_ACT = WS_XS + (size_t)NSLOT * 1024 * 2;
constexpr size_t WS_YSL = WS_ACT + (size_t)NSLOT * 1024 * 2;
constexpr size_t WS_ELIST = WS_YSL + (size_t)NSLOT * 1024 * 2;
constexpr size_t WS_XLN = WS_ELIST + (size_t)NEXP * T_ * 4;
constexpr size_t WS_LGW = WS_XLN + (size_t)64 * 4 * 256 * 8;
constexpr size_t WS_WLR = WS_LGW + (size_t)NL_ * 2 * 8 * 64 * 64 * 2;
constexpr size_t WS_RWS = WS_WLR + (size_t)NL_ * 16 * 1024 * 2;
constexpr size_t WS_XRT = WS_RWS + (size_t)NL_ * 2 * 32 * 1024 * 2;
constexpr size_t WS_END = WS_XRT + (size_t)64 * 4 * 256 * 32 * 4;

constexpr int CW_BAR = 0;
constexpr int CW_CNT = 8 * XCD_BAR_WORDS;
constexpr int CW_LN = CW_CNT + NL_ * 32 * 16;
constexpr int CW_RT = CW_LN + NL_ * 2 * 64 * 16;
constexpr int CW_MOE = CW_RT + NL_ * 64 * 16;
static_assert((CW_MOE + NL_ * 288 * 16) * 4 <= (int)CTL_BYTES, "control words");

constexpr int LDS_STAGE = 0, LDS_MISC = 131072, LDS_BYTES = 147456;
constexpr int MISC_XCH = 0;
constexpr int MISC_MOE = 8192;
constexpr int MISC_RED = 9216;
constexpr int MISC_STAT = 10240;
constexpr int MISC_R2E = 12288;
constexpr int MISC_BAR = 16368;

struct Params { const float* in[39]; float* out; unsigned char* ws; int ph_lo, ph_hi, li, pad; };
typedef const Params __attribute__((address_space(4)))* KP;

enum { I_X = 0, I_MEM, I_LN0G, I_LN0B, I_WIN, I_BIN, I_CAW, I_CAB, I_LNAG, I_LNAB, I_WA2, I_GBA, I_GNG, I_CDW, I_CDB, I_LWA, I_LBA, I_LWX, I_LBX, I_LLAM,
       I_WBR, I_WOUT, I_BOUT, I_LN1G, I_LN1B, I_WQ, I_WK, I_WV, I_WO, I_LN2G, I_LN2B, I_RW, I_RB, I_W1, I_B1, I_W2, I_B2, I_LN3G, I_LN3B };

using pg8::Unit;
typedef f32x4 (AccT)[2][2][4][2];

template <bool SIG = false>
struct EpiStoreBf16T {
    static constexpr bool PERM = true; static constexpr int SEG = 0;
    const float* bias; float scale;
    __device__ __forceinline__ void operator()(f32x4 (&acc)[2][2][4][2], const Unit& u, int wr, int wc, int fr, int fq) const {
        bf16_t* base = (bf16_t*)u.c;
        const int colb = wc * 32 + 8 * fq;
        f32x4 bv[2][2];
#pragma unroll
        for (int bj = 0; bj < 2; ++bj)
#pragma unroll
            for (int n = 0; n < 2; ++n) bv[bj][n] = bias ? *(const f32x4*)(bias + u.col0 + u.aux + colb + bj * 128 + 4 * n) : (f32x4){0.f, 0.f, 0.f, 0.f};
#pragma unroll
        for (int ai = 0; ai < 2; ++ai)
#pragma unroll
            for (int m = 0; m < 4; ++m) {
                bf16_t* rowp = base + (size_t)(ai * 128 + wr * 64 + m * 16 + fr) * u.ldc + colb;
#pragma unroll
                for (int bj = 0; bj < 2; ++bj) {
                    f32x4 v0 = (acc[ai][bj][m][0] + bv[bj][0]) * scale, v1 = (acc[ai][bj][m][1] + bv[bj][1]) * scale;
                    if (SIG && u.col0 >= Z_GM) {
#pragma unroll
                        for (int e4 = 0; e4 < 4; ++e4) { v0[e4] = fminf(1.f + __expf(-v0[e4]), 1048576.f); v1[e4] = fminf(1.f + __expf(-v1[e4]), 1048576.f); } }
                    u32x4 w; w.x = pk2(v0[0], v0[1]); w.y = pk2(v0[2], v0[3]); w.z = pk2(v1[0], v1[1]); w.w = pk2(v1[2], v1[3]);
                    *(u32x4*)(rowp + bj * 128) = w;
                }
            }
    }
};
typedef EpiStoreBf16T<false> EpiStoreBf16;

struct EpiMerge {
    static constexpr bool PERM = true; static constexpr int SEG = 8;
    const bf16_t* z; bf16_t* mb; int dbg;
    static __device__ __forceinline__ float gfl(float g) { return fmaxf(g, 9.5367431640625e-7f); }
    __device__ __forceinline__ void mid(f32x4 (&acc)[2][2][4][2], const Unit& u, int seg, int wr, int wc, int fr, int fq) const {
        const int colb = u.col0 + wc * 32 + 8 * fq;
#pragma unroll
        for (int ai = 0; ai < 2; ++ai) {
            u32x4 ga[4][2], gb[4][2];
#pragma unroll
            for (int m = 0; m < 4; ++m)
#pragma unroll
                for (int bj = 0; bj < 2; ++bj) { const bf16_t* gp = z + (size_t)(u.row0 + ai * 128 + wr * 64 + m * 16 + fr) * ZC + Z_GM + seg * 1024 + colb + bj * 128;
                    ga[m][bj] = *(const u32x4*)gp; gb[m][bj] = *(const u32x4*)(gp + 1024); }
#pragma unroll
            for (int m = 0; m < 4; ++m)
#pragma unroll
                for (int bj = 0; bj < 2; ++bj) { const u32x4 a = ga[m][bj], b = gb[m][bj];
                    const unsigned aw[4] = {a.x, a.y, a.z, a.w}, bw[4] = {b.x, b.y, b.z, b.w};
#pragma unroll
                    for (int e = 0; e < 4; ++e) { const float r0 = bflo(bw[e]) * __builtin_amdgcn_rcpf(bflo(aw[e])), r1 = bfhi(bw[e]) * __builtin_amdgcn_rcpf(bfhi(aw[e]));
                        acc[ai][bj][m][e >> 1][2 * (e & 1)] *= r0; acc[ai][bj][m][e >> 1][2 * (e & 1) + 1] *= r1; } }
        }
    }
    __device__ __forceinline__ void operator()(f32x4 (&acc)[2][2][4][2], const Unit& u, int wr, int wc, int fr, int fq) const {
        if (dbg & 16) return;
        const int colb = u.col0 + wc * 32 + 8 * fq;
#pragma unroll
        for (int ai = 0; ai < 2; ++ai) {
            u32x4 gz[4][2];
#pragma unroll
            for (int m = 0; m < 4; ++m)
#pragma unroll
                for (int bj = 0; bj < 2; ++bj) gz[m][bj] = *(const u32x4*)(z + (size_t)(u.row0 + ai * 128 + wr * 64 + m * 16 + fr) * ZC + Z_GM + 3 * 1024 + colb + bj * 128);
#pragma unroll
            for (int m = 0; m < 4; ++m)
#pragma unroll
                for (int bj = 0; bj < 2; ++bj) { const u32x4 g4 = gz[m][bj]; const f32x4 a0 = acc[ai][bj][m][0], a1 = acc[ai][bj][m][1];
                    u32x4 w; w.x = pk2(a0[0] * __builtin_amdgcn_rcpf(bflo(g4.x)), a0[1] * __builtin_amdgcn_rcpf(bfhi(g4.x))); w.y = pk2(a0[2] * __builtin_amdgcn_rcpf(bflo(g4.y)), a0[3] * __builtin_amdgcn_rcpf(bfhi(g4.y)));
                    w.z = pk2(a1[0] * __builtin_amdgcn_rcpf(bflo(g4.z)), a1[1] * __builtin_amdgcn_rcpf(bfhi(g4.z))); w.w = pk2(a1[2] * __builtin_amdgcn_rcpf(bflo(g4.w)), a1[3] * __builtin_amdgcn_rcpf(bfhi(g4.w)));
                    *(u32x4*)(mb + (size_t)(u.row0 + ai * 128 + wr * 64 + m * 16 + fr) * 1024 + colb + bj * 128) = w; }
        }
    }
};

struct EpiResid {
    static constexpr bool PERM = false; static constexpr int SEG = 0;
    const float* bias; const float* h; float* pre;
    __device__ __forceinline__ void operator()(f32x4 (&acc)[2][2][4][2], const Unit& u, int wr, int wc, int fr, int fq) const {
        const int colb = u.col0 + wc * 32 + 4 * fq;
        f32x4 bv[2][2];
#pragma unroll
        for (int bj = 0; bj < 2; ++bj)
#pragma unroll
            for (int n = 0; n < 2; ++n) bv[bj][n] = bias ? *(const f32x4*)(bias + colb + bj * 128 + n * 16) : (f32x4){0.f, 0.f, 0.f, 0.f};
#pragma unroll
        for (int ai = 0; ai < 2; ++ai)
#pragma unroll
            for (int mh = 0; mh < 2; ++mh) {
                f32x4 hv[2][2][2];
#pragma unroll
                for (int mm = 0; mm < 2; ++mm) { const int row = u.row0 + ai * 128 + wr * 64 + (2 * mh + mm) * 16 + fr;
#pragma unroll
                    for (int bj = 0; bj < 2; ++bj)
#pragma unroll
                        for (int n = 0; n < 2; ++n) hv[mm][bj][n] = *(const f32x4*)(h + (size_t)row * 1024 + colb + bj * 128 + n * 16); }
#pragma unroll
                for (int mm = 0; mm < 2; ++mm) { const int row = u.row0 + ai * 128 + wr * 64 + (2 * mh + mm) * 16 + fr;
#pragma unroll
                    for (int bj = 0; bj < 2; ++bj)
#pragma unroll
                        for (int n = 0; n < 2; ++n) *(f32x4*)(pre + (size_t)row * 1024 + colb + bj * 128 + n * 16) = acc[ai][bj][2 * mh + mm][n] + DN_ALPHA * hv[mm][bj][n] + bv[bj][n]; }
            }
    }
};

template <bool WF32  , bool ROUTE  >
struct EpiResidLNT {
    static constexpr bool PERM = true; static constexpr int SEG = 0;
    const float* bias; const float* g; const float* b; unsigned char* ws; LAS float* xch; LAS float* stats; unsigned* cnt;
    LAS char* sl; const float* rbias; int l;
    __device__ __forceinline__ void operator()(f32x4 (&acc)[2][2][4][2], const Unit& u, int wr, int wc, int fr, int fq) const {
        float* hf = (float*)(ws + WS_H); bf16_t* hb = (bf16_t*)(ws + WS_HB); unsigned long long* xbuf = (unsigned long long*)(ws + WS_XLN);
        const int tid = threadIdx.x, colb = u.col0 + wc * 32 + 8 * fq, panel = u.row0 >> 8, pn = u.col0 >> 8;
        const unsigned e0 = (unsigned)((u.row0 + wr * 64 + fr) * 1024 + colb);
#pragma unroll
        for (int bj = 0; bj < 2; ++bj) {
            u32x4 hv[2][4];
#pragma unroll
            for (int ai = 0; ai < 2; ++ai)
#pragma unroll
                for (int m = 0; m < 4; ++m) hv[ai][m] = *(const u32x4*)((const char*)hb + (size_t)((e0 + (unsigned)((ai * 128 + m * 16) * 1024 + bj * 128)) * 2u));
            const f32x4 bv0 = bias ? *(const f32x4*)(bias + colb + bj * 128) : (f32x4){0.f, 0.f, 0.f, 0.f}, bv1 = bias ? *(const f32x4*)(bias + colb + bj * 128 + 4) : (f32x4){0.f, 0.f, 0.f, 0.f};
#pragma unroll
            for (int ai = 0; ai < 2; ++ai) {
#pragma unroll
                for (int m = 0; m < 4; ++m) { const u32x4 x = hv[ai][m];
                    acc[ai][bj][m][0] = acc[ai][bj][m][0] + DN_ALPHA * (f32x4){bflo(x.x), bfhi(x.x), bflo(x.y), bfhi(x.y)} + bv0;
                    acc[ai][bj][m][1] = acc[ai][bj][m][1] + DN_ALPHA * (f32x4){bflo(x.z), bfhi(x.z), bflo(x.w), bfhi(x.w)} + bv1; }
                asm volatile("" : "+v"(acc[ai][bj][0][0]), "+v"(acc[ai][bj][1][0]), "+v"(acc[ai][bj][2][0]), "+v"(acc[ai][bj][3][0]), "+v"(acc[ai][bj][0][1]), "+v"(acc[ai][bj][1][1]), "+v"(acc[ai][bj][2][1]), "+v"(acc[ai][bj][3][1]) :: "memory"); }
        }
#pragma unroll
        for (int ai = 0; ai < 2; ++ai)
#pragma unroll
            for (int m = 0; m < 4; ++m) { float s1 = 0.f, s2 = 0.f;
#pragma unroll
                for (int bj = 0; bj < 2; ++bj)
#pragma unroll
                    for (int n = 0; n < 2; ++n) { const f32x4 a = acc[ai][bj][m][n]; s1 += (a[0] + a[1]) + (a[2] + a[3]); s2 += (a[0] * a[0] + a[1] * a[1]) + (a[2] * a[2] + a[3] * a[3]); }
                s1 += __shfl_xor(s1, 16); s1 += __shfl_xor(s1, 32); s2 += __shfl_xor(s2, 16); s2 += __shfl_xor(s2, 32);
                if (fq == 0) { const int r = ai * 128 + wr * 64 + m * 16 + fr; xch[wc * 256 + r] = s1; xch[1024 + wc * 256 + r] = s2; } }
        LDS_WAIT(); __builtin_amdgcn_s_barrier(); asm volatile("" ::: "memory");
        if (tid < 256) { const float s1 = (xch[tid] + xch[256 + tid]) + (xch[512 + tid] + xch[768 + tid]), s2 = (xch[1024 + tid] + xch[1280 + tid]) + (xch[1536 + tid] + xch[1792 + tid]);
            __hip_atomic_store(xbuf + ((size_t)panel * 4 + pn) * 256 + tid, ((unsigned long long)__float_as_uint(s2) << 32) | (unsigned long long)__float_as_uint(s1), __ATOMIC_RELAXED, __HIP_MEMORY_SCOPE_AGENT); }
        asm volatile("s_waitcnt vmcnt(0)" ::: "memory"); __builtin_amdgcn_s_barrier(); asm volatile("" ::: "memory");
        if (tid == 0) { unsigned* cp = cnt + panel * 16; __hip_atomic_fetch_add(cp, 1u, __ATOMIC_RELAXED, __HIP_MEMORY_SCOPE_AGENT);
            unsigned sp = 0; while (__hip_atomic_load(cp, __ATOMIC_RELAXED, __HIP_MEMORY_SCOPE_AGENT) < 4u && ++sp < (1u << 22)) __builtin_amdgcn_s_sleep(1); }
        asm volatile("s_waitcnt vmcnt(0) lgkmcnt(0)" ::: "memory"); __builtin_amdgcn_s_barrier(); asm volatile("" ::: "memory");
        if (tid < 256) { float S1 = 0.f, S2 = 0.f;
#pragma unroll
            for (int j = 0; j < 4; ++j) { const unsigned long long x = __hip_atomic_load(xbuf + ((size_t)panel * 4 + j) * 256 + tid, __ATOMIC_RELAXED, __HIP_MEMORY_SCOPE_AGENT); S1 += __uint_as_float((unsigned)x); S2 += __uint_as_float((unsigned)(x >> 32)); }
            const float mean = S1 * (1.f / 1024.f); stats[2 * tid] = mean; stats[2 * tid + 1] = 1.f / sqrtf(fmaxf(S2 * (1.f / 1024.f) - mean * mean, 0.f) + LN_EPS); }
        LDS_WAIT(); __builtin_amdgcn_s_barrier(); asm volatile("" ::: "memory");
        unsigned e2 = e0; asm volatile("" : "+v"(e2));
        const int col2 = (int)(e2 & 1023u);
        if (ROUTE) {
            const bf16_t* rwh = (const bf16_t*)(ws + WS_RWS) + (size_t)l * 2 * 32 * 1024; const bf16_t* rwl = rwh + 32 * 1024;
            bf16x8 Bh[2][2], Bl[2][2]; f32x4 gv[2][2], bb[2][2];
#pragma unroll
            for (int bj = 0; bj < 2; ++bj) { gv[bj][0] = *(const f32x4*)(g + col2 + bj * 128); gv[bj][1] = *(const f32x4*)(g + col2 + bj * 128 + 4); bb[bj][0] = *(const f32x4*)(b + col2 + bj * 128); bb[bj][1] = *(const f32x4*)(b + col2 + bj * 128 + 4);
#pragma unroll
                for (int eb = 0; eb < 2; ++eb) { Bh[bj][eb] = *(const bf16x8*)(rwh + (size_t)(16 * eb + fr) * 1024 + col2 + bj * 128); Bl[bj][eb] = *(const bf16x8*)(rwl + (size_t)(16 * eb + fr) * 1024 + col2 + bj * 128); } }
            LAS float* plog = (LAS float*)sl;
#pragma unroll
            for (int ai = 0; ai < 2; ++ai)
#pragma unroll
                for (int m = 0; m < 4; ++m) { const int r = ai * 128 + wr * 64 + m * 16 + fr; const float mean = stats[2 * r], rstd = stats[2 * r + 1];
                    f32x4 L0 = (f32x4){0.f, 0.f, 0.f, 0.f}, L1 = (f32x4){0.f, 0.f, 0.f, 0.f};
#pragma unroll
                    for (int bj = 0; bj < 2; ++bj) { const unsigned eo = e2 + (unsigned)((ai * 128 + m * 16) * 1024 + bj * 128);
                        const f32x4 y0 = (acc[ai][bj][m][0] - mean) * rstd * gv[bj][0] + bb[bj][0], y1 = (acc[ai][bj][m][1] - mean) * rstd * gv[bj][1] + bb[bj][1];
                        if (WF32) { *(f32x4*)((char*)hf + (size_t)(eo * 4u)) = y0; *(f32x4*)((char*)hf + (size_t)(eo * 4u) + 16) = y1; }
                        u32x4 w; w.x = pk2(y0[0], y0[1]); w.y = pk2(y0[2], y0[3]); w.z = pk2(y1[0], y1[1]); w.w = pk2(y1[2], y1[3]); *(u32x4*)((char*)hb + (size_t)(eo * 2u)) = w;
                        u32x4 lo; lo.x = pk2(y0[0] - bflo(w.x), y0[1] - bfhi(w.x)); lo.y = pk2(y0[2] - bflo(w.y), y0[3] - bfhi(w.y)); lo.z = pk2(y1[0] - bflo(w.z), y1[1] - bfhi(w.z)); lo.w = pk2(y1[2] - bflo(w.w), y1[3] - bfhi(w.w));
                        const bf16x8 ah = __builtin_bit_cast(bf16x8, w), al = __builtin_bit_cast(bf16x8, lo);
                        L0 = __builtin_amdgcn_mfma_f32_16x16x32_bf16(ah, Bh[bj][0], L0, 0, 0, 0); L0 = __builtin_amdgcn_mfma_f32_16x16x32_bf16(ah, Bl[bj][0], L0, 0, 0, 0); L0 = __builtin_amdgcn_mfma_f32_16x16x32_bf16(al, Bh[bj][0], L0, 0, 0, 0);
                        L1 = __builtin_amdgcn_mfma_f32_16x16x32_bf16(ah, Bh[bj][1], L1, 0, 0, 0); L1 = __builtin_amdgcn_mfma_f32_16x16x32_bf16(ah, Bl[bj][1], L1, 0, 0, 0); L1 = __builtin_amdgcn_mfma_f32_16x16x32_bf16(al, Bh[bj][1], L1, 0, 0, 0); }
                    const int rt = wc * 256 + ai * 128 + wr * 64 + m * 16 + 4 * fq;
#pragma unroll
                    for (int j = 0; j < 4; ++j) { plog[(rt + j) * 32 + fr] = L0[j]; plog[(rt + j) * 32 + 16 + fr] = L1[j]; } }
            LDS_WAIT(); __builtin_amdgcn_s_barrier(); asm volatile("" ::: "memory");
            int t2 = tid; asm volatile("" : "+v"(t2));
            unsigned long long* xrt = (unsigned long long*)(ws + WS_XRT);
            { unsigned long long* dst = xrt + ((size_t)panel * 4 + pn) * 4096;
#pragma unroll
                for (int k = 0; k < 8; ++k) { const int o = (k * 512 + t2) * 2;
                    const f32x2 s = (*(const LAS f32x2*)(plog + o) + *(const LAS f32x2*)(plog + 8192 + o)) + (*(const LAS f32x2*)(plog + 16384 + o) + *(const LAS f32x2*)(plog + 24576 + o));
                    __hip_atomic_store(dst + k * 512 + t2, ((unsigned long long)__float_as_uint(s[1]) << 32) | (unsigned long long)__float_as_uint(s[0]), __ATOMIC_RELAXED, __HIP_MEMORY_SCOPE_AGENT); } }
            asm volatile("s_waitcnt vmcnt(0) lgkmcnt(0)" ::: "memory"); __builtin_amdgcn_s_barrier(); asm volatile("" ::: "memory");
            LAS int* lcnt = (LAS int*)sl; LAS int* lbase = lcnt + 32;
            if (t2 < 32) lcnt[t2] = 0;
            if (t2 == 0) { unsigned* cp = (unsigned*)(ws + WS_CTL) + CW_RT + (l * 64 + panel) * 16; __hip_atomic_fetch_add(cp, 1u, __ATOMIC_RELAXED, __HIP_MEMORY_SCOPE_AGENT);
                unsigned sp = 0; while (__hip_atomic_load(cp, __ATOMIC_RELAXED, __HIP_MEMORY_SCOPE_AGENT) < 4u && ++sp < (1u << 22)) __builtin_amdgcn_s_sleep(1); }
            asm volatile("s_waitcnt vmcnt(0) lgkmcnt(0)" ::: "memory"); __builtin_amdgcn_s_barrier(); asm volatile("" ::: "memory");
            const int rowl = t2 >> 3, sub = t2 & 7, e4 = sub * 4;
            float v[4]; v[0] = rbias[e4]; v[1] = rbias[e4 + 1]; v[2] = rbias[e4 + 2]; v[3] = rbias[e4 + 3];
#pragma unroll
            for (int j = 0; j < 4; ++j) { const unsigned long long* src = xrt + ((((size_t)panel * 4 + j) * 256 + pn * 64 + rowl) * 32 + e4) / 2;
                const unsigned long long x0 = __hip_atomic_load(src, __ATOMIC_RELAXED, __HIP_MEMORY_SCOPE_AGENT), x1 = __hip_atomic_load(src + 1, __ATOMIC_RELAXED, __HIP_MEMORY_SCOPE_AGENT);
                v[0] += __uint_as_float((unsigned)x0); v[1] += __uint_as_float((unsigned)(x0 >> 32)); v[2] += __uint_as_float((unsigned)x1); v[3] += __uint_as_float((unsigned)(x1 >> 32)); }
            int ti[4]; float tv[4];
#pragma unroll
            for (int k = 0; k < 4; ++k) { float best = v[0]; int bi = e4;
#pragma unroll
                for (int i = 1; i < 4; ++i) { const bool ok = v[i] > best; best = ok ? v[i] : best; bi = ok ? e4 + i : bi; }
#pragma unroll
                for (int d = 1; d < 8; d <<= 1) { const float ob = __shfl_xor(best, d); const int oi = __shfl_xor(bi, d); const bool tk = (ob > best) || (ob == best && oi < bi); best = tk ? ob : best; bi = tk ? oi : bi; }
                tv[k] = best; ti[k] = bi;
#pragma unroll
                for (int i = 0; i < 4; ++i) v[i] = (bi == e4 + i) ? -3.0e38f : v[i]; }
            const float ev1 = __expf(tv[1] - tv[0]), ev2 = __expf(tv[2] - tv[0]), ev3 = __expf(tv[3] - tv[0]);
            const float inv = 1.f / (1.f + ev1 + ev2 + ev3);
            const int myi = sub == 0 ? ti[0] : sub == 1 ? ti[1] : sub == 2 ? ti[2] : ti[3]; const float myg = (sub == 0 ? 1.f : sub == 1 ? ev1 : sub == 2 ? ev2 : ev3) * inv;
            int lr = 0; if (sub < 4) lr = (int)atomicAdd((unsigned*)(lcnt + myi), 1u);
            LDS_WAIT(); __builtin_amdgcn_s_barrier(); asm volatile("" ::: "memory");
            unsigned* ecnt = (unsigned*)(ws + WS_CTL) + CW_CNT + l * 32 * 16;
            if (t2 < 32) { const unsigned n = (unsigned)lcnt[t2]; lbase[t2] = n ? (int)atomicAdd(ecnt + t2 * 16, n) : 0; }
            asm volatile("s_waitcnt vmcnt(0) lgkmcnt(0)" ::: "memory"); __builtin_amdgcn_s_barrier(); asm volatile("" ::: "memory");
            if (sub < 4) { const int mm = u.row0 + pn * 64 + rowl; const int rk = lbase[myi] + lr;
                ((int*)(ws + WS_TOKE))[mm * 4 + sub] = myi; ((int*)(ws + WS_TOKR))[mm * 4 + sub] = rk; ((float*)(ws + WS_TOKG))[mm * 4 + sub] = myg; ((int*)(ws + WS_ELIST))[(size_t)myi * T_ + rk] = mm; }
        } else {
#pragma unroll
        for (int bj = 0; bj < 2; ++bj) { const f32x4 g0 = *(const f32x4*)(g + col2 + bj * 128), g1 = *(const f32x4*)(g + col2 + bj * 128 + 4), b0 = *(const f32x4*)(b + col2 + bj * 128), b1 = *(const f32x4*)(b + col2 + bj * 128 + 4);
#pragma unroll
            for (int ai = 0; ai < 2; ++ai)
#pragma unroll
                for (int m = 0; m < 4; ++m) { const int r = ai * 128 + wr * 64 + m * 16 + fr; const float mean = stats[2 * r], rstd = stats[2 * r + 1];
                    const unsigned eo = e2 + (unsigned)((ai * 128 + m * 16) * 1024 + bj * 128);
                    const f32x4 y0 = (acc[ai][bj][m][0] - mean) * rstd * g0 + b0, y1 = (acc[ai][bj][m][1] - mean) * rstd * g1 + b1;
                    if (WF32) { *(f32x4*)((char*)hf + (size_t)(eo * 4u)) = y0; *(f32x4*)((char*)hf + (size_t)(eo * 4u) + 16) = y1; }
                    u32x4 w; w.x = pk2(y0[0], y0[1]); w.y = pk2(y0[2], y0[3]); w.z = pk2(y1[0], y1[1]); w.w = pk2(y1[2], y1[3]); *(u32x4*)((char*)hb + (size_t)(eo * 2u)) = w; } }

        }
    }
};

struct EpiSoftmax {
    static constexpr bool PERM = true; static constexpr int SEG = 0;
    LAS float* xch;
    __device__ __forceinline__ void operator()(f32x4 (&acc)[2][2][4][2], const Unit& u, int wr, int wc, int fr, int fq) const {
        LAS float* xm = xch; LAS float* xs = xch + 1024;
#pragma unroll
        for (int ai = 0; ai < 2; ++ai)
#pragma unroll
            for (int m = 0; m < 4; ++m) {
                float v = -3.0e38f;
#pragma unroll
                for (int bj = 0; bj < 2; ++bj)
#pragma unroll
                    for (int n = 0; n < 2; ++n) { const f32x4 a = acc[ai][bj][m][n]; v = fmaxf(v, fmaxf(fmaxf(a[0], a[1]), fmaxf(a[2], a[3]))); }
                v = fmaxf(v, __shfl_xor(v, 16)); v = fmaxf(v, __shfl_xor(v, 32));
                if (fq == 0) xm[wc * 256 + ai * 128 + wr * 64 + m * 16 + fr] = v;
            }
        LDS_WAIT(); __builtin_amdgcn_s_barrier(); asm volatile("" ::: "memory");
#pragma unroll
        for (int ai = 0; ai < 2; ++ai)
#pragma unroll
            for (int m = 0; m < 4; ++m) {
                const int r = ai * 128 + wr * 64 + m * 16 + fr;
                const float M = fmaxf(fmaxf(xm[r], xm[256 + r]), fmaxf(xm[512 + r], xm[768 + r]));
                float s = 0.f;
#pragma unroll
                for (int bj = 0; bj < 2; ++bj)
#pragma unroll
                    for (int n = 0; n < 2; ++n) { f32x4 a = acc[ai][bj][m][n];
                        a[0] = __expf(a[0] - M); a[1] = __expf(a[1] - M); a[2] = __expf(a[2] - M); a[3] = __expf(a[3] - M);
                        acc[ai][bj][m][n] = a; s += (a[0] + a[1]) + (a[2] + a[3]); }
                s += __shfl_xor(s, 16); s += __shfl_xor(s, 32);
                if (fq == 0) xs[wc * 256 + r] = s;
            }
        LDS_WAIT(); __builtin_amdgcn_s_barrier(); asm volatile("" ::: "memory");
        bf16_t* base = (bf16_t*)u.c;
#pragma unroll
        for (int ai = 0; ai < 2; ++ai)
#pragma unroll
            for (int m = 0; m < 4; ++m) {
                const int r = ai * 128 + wr * 64 + m * 16 + fr;
                const float inv = 1.f / ((xs[r] + xs[256 + r]) + (xs[512 + r] + xs[768 + r]));
#pragma unroll
                for (int bj = 0; bj < 2; ++bj) { const f32x4 a0 = acc[ai][bj][m][0] * inv, a1 = acc[ai][bj][m][1] * inv;
                    u32x4 w; w.x = pk2(a0[0], a0[1]); w.y = pk2(a0[2], a0[3]); w.z = pk2(a1[0], a1[1]); w.w = pk2(a1[2], a1[3]);
                    *(u32x4*)(base + (size_t)r * u.ldc + bj * 128 + wc * 32 + 8 * fq) = w; }
            }
    }
};

struct EpiSwiGLU {
    static constexpr bool PERM = true; static constexpr int SEG = 0;
    const float* b1;
    __device__ __forceinline__ void operator()(f32x4 (&acc)[2][2][4][2], const Unit& u, int wr, int wc, int fr, int fq) const {
        bf16_t* base = (bf16_t*)u.c;
        const int colb = wc * 32 + 8 * fq;
        const float* bb = b1 + (size_t)u.aux * 2048 + u.col0 + colb;
        f32x4 bg[2], bl[2];
#pragma unroll
        for (int n = 0; n < 2; ++n) { bg[n] = *(const f32x4*)(bb + 4 * n); bl[n] = *(const f32x4*)(bb + 1024 + 4 * n); }
#pragma unroll
        for (int ai = 0; ai < 2; ++ai)
#pragma unroll
            for (int m = 0; m < 4; ++m) {
                float o[8];
#pragma unroll
                for (int n = 0; n < 2; ++n) {
                    const f32x4 gv = acc[ai][0][m][n] + bg[n], lv = acc[ai][1][m][n] + bl[n];
#pragma unroll
                    for (int e = 0; e < 4; ++e) { const float gg = fminf(gv[e], 7.0f), ll = fminf(fmaxf(lv[e], -7.0f), 7.0f); o[4 * n + e] = gg * sigmoidf_(1.702f * gg) * (ll + 1.0f); }
                }
                u32x4 w; w.x = pk2(o[0], o[1]); w.y = pk2(o[2], o[3]); w.z = pk2(o[4], o[5]); w.w = pk2(o[6], o[7]);
                *(u32x4*)(base + (size_t)(ai * 128 + wr * 64 + m * 16 + fr) * u.ldc + colb) = w;
            }
    }
};


struct EpiMoeX {
    static constexpr bool PERM = true; static constexpr int SEG = 0;
    const float* b1; const float* b2;
    __device__ __forceinline__ void operator()(f32x4 (&acc)[2][2][4][2], const Unit& u, int wr, int wc, int fr, int fq) const {
        if (u.kind) { EpiStoreBf16 E2{b2, 1.f}; E2(acc, u, wr, wc, fr, fq); return; }
        bf16_t* base = (bf16_t*)u.c;
        const int colb = wc * 32 + 8 * fq;
        const float* bb = b1 + (size_t)u.aux * 2048 + u.col0 + colb;
        f32x4 bg[2], bl[2];
#pragma unroll
        for (int n = 0; n < 2; ++n) { bg[n] = *(const f32x4*)(bb + 4 * n); bl[n] = *(const f32x4*)(bb + 1024 + 4 * n); }
#pragma unroll
        for (int ai = 0; ai < 2; ++ai)
#pragma unroll
            for (int m = 0; m < 4; ++m) {
                float o[8];
#pragma unroll
                for (int n = 0; n < 2; ++n) {
                    const f32x4 gv = acc[ai][0][m][n] + bg[n], lv = acc[ai][1][m][n] + bl[n];
#pragma unroll
                    for (int e = 0; e < 4; ++e) { const float gg = fminf(gv[e], 7.0f), ll = fminf(fmaxf(lv[e], -7.0f), 7.0f); o[4 * n + e] = gg * sigmoidf_(1.702f * gg) * (ll + 1.0f); }
                }
                u32x4 w; w.x = pk2(o[0], o[1]); w.y = pk2(o[2], o[3]); w.z = pk2(o[4], o[5]); w.w = pk2(o[6], o[7]);
                bf16_t* dst = base + (size_t)(ai * 128 + wr * 64 + m * 16 + fr) * u.ldc + colb;
                asm volatile("global_store_dwordx4 %0, %1, off sc1\n\ts_nop 1" :: "v"(dst), "v"(w) : "memory");
            }
    }
};
struct SchedInProj {
    static constexpr bool GATHER = false; static constexpr bool COUNTED = false;
    const char* A; const char* B; char* C; int G, c;
    __device__ __forceinline__ bool next(int i, Unit& u) const {
        const int L = i * G + c; if (L >= 64 * 36) return false;
        int pm, pn; pg8::swz_tile(L, 64, 36, pm, pn);
        u.a = A + (size_t)pm * 256 * 1024 * 2; u.b = B + (size_t)pn * 256 * 1024 * 2; u.c = C + ((size_t)pm * 256 * ZC + pn * 256) * 2;
        u.ldc = ZC; u.row0 = pm * 256; u.col0 = pn * 256; u.aux = (pn * 256 >= LR_COL) ? 16 : 0; return true;
    }
};
struct SchedKV {
    static constexpr bool GATHER = false; static constexpr bool COUNTED = false;
    const char* ws; int G, c;
    __device__ __forceinline__ bool next(int i, Unit& u) const {
        const int L = i * G + c; if (L >= NL_ * 32) return false;
        const int l = L >> 5, r = L & 31, pm = r >> 3, pn = r & 7;
        u.a = ws + WS_MEMB + (size_t)pm * 256 * 1024 * 2; u.b = ws + WS_W + (size_t)l * LW_END + LW_WKV + (size_t)pn * 256 * 1024 * 2;
        u.c = (char*)ws + WS_KMEM + (size_t)l * 2 * SZ_W1K + ((size_t)pm * 256 * 2048 + pn * 256) * 2; u.ldc = 2048; u.row0 = 0; u.col0 = 0; u.aux = 0; u.g0 = 0; u.g1 = 0; return true;
    }
};
struct SchedMq {
    static constexpr bool GATHER = false; static constexpr bool COUNTED = false;
    const char* ws; int G, c;
    __device__ __forceinline__ bool next(int i, Unit& u) const {
        const int L = i * G + c; if (L >= NL_ * 64) return false;
        const int l = L >> 6, r = L & 63, bb = r >> 4, hh = (r >> 2) & 3, pn = r & 3;
        u.a = ws + WS_KMEM + (size_t)l * 2 * SZ_W1K + ((size_t)bb * 256 * 2048 + hh * 256) * 2; u.b = ws + WS_W + (size_t)l * LW_END + LW_WQ + ((size_t)pn * 256 * 1024 + hh * 256) * 2;
        u.c = (char*)ws + WS_MQT + ((size_t)l * 4 + bb) * SZ_W1K + ((size_t)hh * 256 * 1024 + pn * 256) * 2; u.ldc = 1024; u.row0 = 0; u.col0 = 0; u.aux = 0; u.g0 = 0; u.g1 = 0; return true;
    }
};
struct SchedVw {
    static constexpr bool GATHER = false; static constexpr bool COUNTED = false;
    const char* ws; int G, c;
    __device__ __forceinline__ bool next(int i, Unit& u) const {
        const int L = i * G + c; if (L >= NL_ * 64) return false;
        const int l = L >> 6, r = L & 63, bb = r >> 4, hh = (r >> 2) & 3, pm = r & 3;
        u.a = ws + WS_W + (size_t)l * LW_END + LW_WO + ((size_t)pm * 256 * 1024 + hh * 256) * 2; u.b = ws + WS_KMEM + (size_t)l * 2 * SZ_W1K + ((size_t)bb * 256 * 2048 + 1024 + hh * 256) * 2;
        u.c = (char*)ws + WS_VWT + ((size_t)l * 4 + bb) * SZ_W1K + ((size_t)pm * 256 * 1024 + hh * 256) * 2; u.ldc = 1024; u.row0 = 0; u.col0 = 0; u.aux = 0; u.g0 = 0; u.g1 = 0; return true;
    }
};
struct SchedBranch {
    static constexpr bool GATHER = false; static constexpr bool COUNTED = false;
    const char* ys; const char* wbr; int G, c;
    __device__ __forceinline__ bool next(int i, Unit& u) const {
        const int L = i * G + c; if (L >= 256) return false;
        int pm, pn; pg8::swz_tile(L, 64, 4, pm, pn);
        u.a = ys + (size_t)pm * 256 * 2048 * 2; u.b = wbr + (size_t)pn * 256 * 2048 * 2; u.c = nullptr;
        u.ldc = 1024; u.row0 = pm * 256; u.col0 = pn * 256; u.aux = 0; return true;
    }
};
struct SchedSq {
    static constexpr bool GATHER = false; static constexpr bool COUNTED = false;
    const char* A; const char* B; char* C; int csz, G, c;
    __device__ __forceinline__ bool next(int i, Unit& u) const {
        const int L = i * G + c; if (L >= 256) return false;
        int pm, pn; pg8::swz_tile(L, 64, 4, pm, pn);
        u.a = A + (size_t)pm * 256 * 1024 * 2; u.b = B + (size_t)pn * 256 * 1024 * 2; u.c = C + ((size_t)pm * 256 * 1024 + pn * 256) * csz;
        u.ldc = 1024; u.row0 = pm * 256; u.col0 = pn * 256; u.aux = 0; return true;
    }
};
struct SchedXB {
    static constexpr bool GATHER = false; static constexpr bool COUNTED = false;
    const char* A; const char* B; char* C; int csz, G, c;
    __device__ __forceinline__ bool next(int i, Unit& u) const {
        const int L = i * G + c; if (L >= 256) return false;
        int pm, pn; pg8::swz_tile(L, 64, 4, pm, pn); const int bb = pm >> 4;
        u.a = A + (size_t)pm * 256 * 1024 * 2; u.b = B + (size_t)bb * SZ_W1K + (size_t)pn * 256 * 1024 * 2; u.c = C + ((size_t)pm * 256 * 1024 + pn * 256) * csz;
        u.ldc = 1024; u.row0 = pm * 256; u.col0 = pn * 256; u.aux = 0; u.g0 = 0; u.g1 = 0; return true;
    }
};
template <int NCOL, int BROWS  , int CW  , int AUXMUL  , bool GATH  >
struct SchedMoe {
    static constexpr bool GATHER = GATH; static constexpr bool COUNTED = false;
    const char* A; const char* B; char* C; const LAS int* tstart; const int* elist; int G, c;
    __device__ __forceinline__ bool next(int i, Unit& u) const {
        const int rtiles = tstart[32]; constexpr int CS = NCOL / 4;
        int rt, ct;
        if ((G & 7) == 0 && G >= 256) { const int x = c & 7, j = c >> 3, per = G >> 3;
            const int slot = i * per + j; const int st = (slot >> 5) * 8 + x, w = slot & 31;
            const int rg = st / CS, cs = st % CS; rt = rg * 8 + (w & 7); ct = cs * 4 + (w >> 3);
            if (rt >= rtiles) return false; }
        else { const int L = i * G + c; if (L >= rtiles * NCOL) return false; rt = L / NCOL; ct = L % NCOL; }
        const int e = tstart[(MISC_R2E - MISC_MOE) / 4 + rt];
        u.a = GATH ? A : A + (size_t)rt * 256 * 1024 * 2; u.b = B + ((size_t)e * BROWS + ct * 256) * 1024 * 2; u.c = C + ((size_t)rt * 256 * 1024 + ct * CW) * 2;
        u.ldc = 1024; u.row0 = rt * 256; u.col0 = ct * CW; u.aux = e * AUXMUL;
        u.g0 = e * T_ + (rt - tstart[e]) * 256; u.g1 = e * T_ + tstart[33 + e]; return true;
    }
    __device__ __forceinline__ unsigned rowoff(const Unit& u, int row) const { const int idx = u.g0 + row; const int tok = (idx < u.g1) ? elist[idx] : 0; return (unsigned)tok * 2048u; }
};

struct SchedMoeX {
    static constexpr bool GATHER = true; static constexpr bool COUNTED = true;
    const char* hb; const char* w1; const char* w2; char* act; char* ysl; const LAS int* tstart; const int* elist; unsigned* cnt; int G, c;
    __device__ __forceinline__ bool next(int i, Unit& u) const {
        const int rtiles = tstart[32], ng = (rtiles + 7) >> 3, nst1 = 2 * ng, rem = rtiles & 7;
        const int x = c & 7, j = c >> 3, rsub = j & 7, csub = j >> 3;
        int k = i;
        if (rem != 0 && rsub >= rem) {
            const int qa = nst1 - 2, qb = nst1 - 1, qc = nst1 + ng - 1;
            if ((qa & 7) == x && (qa >> 3) <= k) ++k;
            if ((qb & 7) == x && (qb >> 3) <= k) ++k;
            if ((qc & 7) == x && (qc >> 3) <= k) ++k; }
        const int q = 8 * k + x; if (q >= 3 * ng) return false;
        int rt, e;
        if (q < nst1) { const int rg = q >> 1, ct = (q & 1) * 4 + csub; rt = rg * 8 + rsub; e = tstart[(MISC_R2E - MISC_MOE) / 4 + rt];
            u.a = hb; u.b = w1 + ((size_t)e * 2048 + ct * 256) * 1024 * 2; u.c = act + ((size_t)rt * 256 * 1024 + ct * 128) * 2; u.col0 = ct * 128; u.aux = e; u.kind = 0; }
        else { const int rg = q - nst1, ct = csub; rt = rg * 8 + rsub; e = tstart[(MISC_R2E - MISC_MOE) / 4 + rt];
            u.a = act + (size_t)rt * 256 * 1024 * 2; u.b = w2 + ((size_t)e * 1024 + ct * 256) * 1024 * 2; u.c = ysl + ((size_t)rt * 256 * 1024 + ct * 256) * 2; u.col0 = ct * 256; u.aux = e * 1024; u.kind = 1; }
        u.ldc = 1024; u.row0 = rt * 256; u.g0 = e * T_ + (rt - tstart[e]) * 256; u.g1 = e * T_ + tstart[33 + e]; return true;
    }
    __device__ __forceinline__ unsigned rowoff(const Unit& u, int row) const {
        if (u.kind) return (unsigned)row * 2048u;
        const int idx = u.g0 + row; const int tok = (idx < u.g1) ? elist[idx] : 0; return (unsigned)tok * 2048u; }
    __device__ __forceinline__ int pending(const Unit& u) const { return u.kind ? -1 : (u.row0 >> 8); }
    __device__ __forceinline__ void publish(int rt, int lane) const { if (lane == 0) __hip_atomic_fetch_add(cnt + rt * 16, 1u, __ATOMIC_RELAXED, __HIP_MEMORY_SCOPE_AGENT); }
    __device__ __forceinline__ void a_ready(const Unit& u) const {
        if (u.kind == 0) return;
        if (threadIdx.x < 64) {
            const unsigned* cp = cnt + (u.row0 >> 8) * 16; unsigned sp = 0;
            while ((unsigned)__builtin_amdgcn_readfirstlane((int)__hip_atomic_load(cp, __ATOMIC_RELAXED, __HIP_MEMORY_SCOPE_AGENT)) < 64u && ++sp < (1u << 22)) __builtin_amdgcn_s_sleep(2);
            __builtin_amdgcn_fence(__ATOMIC_ACQUIRE, "agent");
            asm volatile("s_waitcnt vmcnt(0)" ::: "memory"); }
        asm volatile("" ::: "memory"); __builtin_amdgcn_s_barrier(); asm volatile("" ::: "memory");
    }
};
struct Ctx { int tid, lane, wave, G, bid; LAS unsigned char* lds; };
__device__ __forceinline__ Ctx relaunder(const Ctx& c0) { Ctx c = c0; int t_ = c0.tid; asm volatile("" : "+v"(t_)); c.tid = t_; c.lane = t_ & 63; c.wave = __builtin_amdgcn_readfirstlane(t_ >> 6); return c; }

template <bool WIDE = false>
__device__ __forceinline__ void ln_row_regs(f32x4 (&v)[4], const float* g, const float* b, int lane, float* of32, bf16_t* obf) {
    float s = 0.f;
#pragma unroll
    for (int j = 0; j < 4; ++j) s += (v[j][0] + v[j][1]) + (v[j][2] + v[j][3]);
    const float mean = wave_sum(s) * (1.f / 1024.f); float s2 = 0.f;
#pragma unroll
    for (int j = 0; j < 4; ++j) { v[j] = v[j] - mean; s2 += (v[j][0] * v[j][0] + v[j][1] * v[j][1]) + (v[j][2] * v[j][2] + v[j][3] * v[j][3]); }
    const float rstd = 1.f / sqrtf(wave_sum(s2) * (1.f / 1024.f) + LN_EPS);
#pragma unroll
    for (int j = 0; j < 4; ++j) { const int col = WIDE ? 8 * lane + 4 * (j & 1) + 512 * (j >> 1) : 4 * lane + 256 * j;
        const f32x4 gg = *(const f32x4*)(g + col), bb = *(const f32x4*)(b + col);
        v[j] = v[j] * rstd * gg + bb;
        if (of32) *(f32x4*)(of32 + col) = v[j];
        if (obf && !WIDE) { u32x2 w; w.x = pk2(v[j][0], v[j][1]); w.y = pk2(v[j][2], v[j][3]); *(u32x2*)(obf + col) = w; }
    }
    if (obf && WIDE) {
#pragma unroll
        for (int jj = 0; jj < 2; ++jj) { u32x4 w; w.x = pk2(v[2 * jj][0], v[2 * jj][1]); w.y = pk2(v[2 * jj][2], v[2 * jj][3]); w.z = pk2(v[2 * jj + 1][0], v[2 * jj + 1][1]); w.w = pk2(v[2 * jj + 1][2], v[2 * jj + 1][3]);
            *(u32x4*)(obf + 8 * lane + 512 * jj) = w; } }
}
__device__ __forceinline__ void ln_rows_phase(const Ctx& c, const float* src, const float* g, const float* b, float* of32, bf16_t* obf) {
    const int gw = c.bid * 8 + c.wave, NGW = c.G * 8;
    for (int m = gw; m < T_; m += NGW) {
        f32x4 v[4];
#pragma unroll
        for (int j = 0; j < 4; ++j) v[j] = *(const f32x4*)(src + (size_t)m * 1024 + 4 * c.lane + 256 * j);
        ln_row_regs(v, g, b, c.lane, of32 ? of32 + (size_t)m * 1024 : nullptr, obf ? obf + (size_t)m * 1024 : nullptr);
    }
}

__device__ __forceinline__ void cvt_item(const float* W, int ldw, int k0, int nsrc, bf16_t* WT, int ldt, int ndst, LAS float* scr, int lane) {
    const int cq = lane & 15, kr = lane >> 4;
    f32x4 v[16];
#pragma unroll
    for (int i = 0; i < 16; ++i) v[i] = __builtin_nontemporal_load((const f32x4*)(W + (size_t)(k0 + kr + 4 * i) * ldw + nsrc + 4 * cq));
#pragma unroll
    for (int i = 0; i < 16; ++i) { LAS float* s = scr + (kr + 4 * i) * 65 + 4 * cq; s[0] = v[i][0]; s[1] = v[i][1]; s[2] = v[i][2]; s[3] = v[i][3]; }
    LDS_WAIT();
    const int ch = lane & 7;
#pragma unroll
    for (int j = 0; j < 8; ++j) { const int n = (lane >> 3) + 8 * j; const LAS float* s = scr + (8 * ch) * 65 + n;
        u32x4 o; o.x = pk2(s[0], s[65]); o.y = pk2(s[2 * 65], s[3 * 65]); o.z = pk2(s[4 * 65], s[5 * 65]); o.w = pk2(s[6 * 65], s[7 * 65]);
        *(u32x4*)(WT + (size_t)(ndst + n) * ldt + k0 + 8 * ch) = o; }
    LDS_WAIT();
}

constexpr int CVT_IN0 = 16 * 144, CVT_END = NL_ * (16 * 144 + 4 * 8 * 16 + 4 * 16 * 16 + 32 * 16 * 32 + 32 * 16 * 16);
constexpr int CVT_SPLIT = CVT_IN0 + 93 * 1024;
__device__ __forceinline__ void ph_prologue(const Ctx& c, KP p, int part, int gwx, int ngwx, int lo, int hi, bool kvfirst) {
    unsigned char* ws = p->ws;
    if (part != 1) {
    ln_rows_phase(c, p->in[I_X], p->in[I_LN0G], p->in[I_LN0B], (c.G == 256) ? nullptr : (float*)(ws + WS_H), (bf16_t*)(ws + WS_HB));
    { const float* mem = p->in[I_MEM]; bf16_t* mb = (bf16_t*)(ws + WS_MEMB);
      for (int i = c.bid * 512 + c.tid; i < 1024 * 1024 / 4; i += c.G * 512) { const f32x4 v = *(const f32x4*)(mem + 4 * (size_t)i); u32x2 w; w.x = pk2(v[0], v[1]); w.y = pk2(v[2], v[3]); *(u32x2*)(mb + 4 * (size_t)i) = w; } }
    { bf16_t* lgw = (bf16_t*)(ws + WS_LGW);
      for (int i = c.bid * 512 + c.tid; i < NL_ * 2 * 8 * 64 * 64; i += c.G * 512) { const int k = i & 63, d = (i >> 6) & 63, n = (i >> 12) & 7, g = (i >> 15) & 1, l = i >> 16;
          lgw[i] = (bf16_t)f2bf((g ? p->in[I_LWX] : p->in[I_LWA])[(((size_t)l * 8 + n) * 64 + k) * 64 + d]); }
      for (int i = c.bid * 512 + c.tid; i < NL_ * 1024 * 1024 / 4; i += c.G * 512) { const int l = i >> 18, o = (i & 262143) * 4;
          const f32x4 v = *(const f32x4*)(p->in[I_WQ] + (size_t)l * 1024 * 1024 + o); u32x2 w; w.x = pk2(v[0], v[1]); w.y = pk2(v[2], v[3]); *(u32x2*)((bf16_t*)(ws + WS_W + (size_t)l * LW_END + LW_WQ) + o) = w; }
      { bf16_t* rws = (bf16_t*)(ws + WS_RWS);
        for (int i = c.bid * 512 + c.tid; i < NL_ * 32 * 1024; i += c.G * 512) { const int k = i & 1023, e = (i >> 10) & 31, l = i >> 15;
            const float w = p->in[I_RW][((size_t)l * 1024 + k) * 32 + e]; const unsigned hi = f2bf(w);
            rws[((size_t)l * 2 * 32 + e) * 1024 + k] = (bf16_t)hi; rws[((size_t)l * 2 * 32 + 32 + e) * 1024 + k] = (bf16_t)f2bf(w - bf2f(hi)); } }
      bf16_t* wlr = (bf16_t*)(ws + WS_WLR);
      for (int i = c.bid * 512 + c.tid; i < NL_ * 16 * 1024; i += c.G * 512) { const int k = i & 1023, j = (i >> 10) & 15, l = i >> 14;
          wlr[i] = (bf16_t)f2bf(p->in[I_WIN][((size_t)l * 1024 + k) * INC + LR_COL + j]); } }
    }
    LAS float* scr = (LAS float*)(c.lds) + c.wave * (64 * 65);
    constexpr int I_IN = 16 * 144, I_BR = 4 * 8 * 16, I_SQ = 16 * 16, I_M1 = 32 * 16 * 32, I_M2 = 32 * 16 * 16;
    constexpr int PER_L = I_IN + I_BR + 4 * I_SQ + I_M1 + I_M2;
    static_assert(I_IN == CVT_IN0 && NL_ * PER_L == CVT_END, "conversion item counts");
    if (kvfirst && part == 0) {
        for (int it2 = gwx; it2 < NL_ * 2 * I_SQ; it2 += ngwx) { const int l = it2 / (2 * I_SQ), w = 1 + (it2 % (2 * I_SQ)) / I_SQ, q = it2 % I_SQ, kb = q % 16, nb = q / 16;
            unsigned char* lw = ws + WS_W + (size_t)l * LW_END;
            cvt_item((w == 1 ? p->in[I_WK] : p->in[I_WV]) + (size_t)l * 1024 * 1024, 1024, kb * 64, nb * 64, (bf16_t*)(lw + (w == 1 ? LW_WKV : LW_WKV + SZ_W1K)), 1024, nb * 64, scr, c.lane); } }
    for (int it = lo + gwx; it < hi; it += ngwx) {
        const int l = it / PER_L; int r = it % PER_L;
        unsigned char* lw = ws + WS_W + (size_t)l * LW_END;
        if (r < I_IN) { const int kb = r % 16, nb = r / 16, d0 = nb * 64;
            cvt_item(p->in[I_WIN] + (size_t)l * 1024 * INC, INC, kb * 64, d0 + (d0 >= LR_COL ? 16 : 0), (bf16_t*)(lw + LW_WIN), 1024, d0, scr, c.lane); continue; }
        r -= I_IN;
        if (r < I_BR) { const int br = r / 128, q = r % 128, kb = q % 8, nb = q / 8;
            cvt_item(p->in[I_WBR] + ((size_t)l * 4 + br) * 512 * 1024, 1024, kb * 64, nb * 64, (bf16_t*)(lw + LW_WBR) + br * 512, 2048, nb * 64, scr, c.lane); continue; }
        r -= I_BR;
        if (r < 4 * I_SQ) { const int w = r / I_SQ, q = r % I_SQ, kb = q % 16, nb = q / 16;
            if (kvfirst && part == 1 && (w == 1 || w == 2)) continue;
            const float* src = (w == 0 ? p->in[I_WOUT] : w == 1 ? p->in[I_WK] : w == 2 ? p->in[I_WV] : p->in[I_WO]) + (size_t)l * 1024 * 1024;
            bf16_t* dst = (bf16_t*)(lw + (w == 0 ? LW_WOUT : w == 1 ? LW_WKV : w == 2 ? LW_WKV + SZ_W1K : LW_WO));
            cvt_item(src, 1024, kb * 64, nb * 64, dst, 1024, nb * 64, scr, c.lane); continue; }
        r -= 4 * I_SQ;
        if (r < I_M1) { const int e = r / 512, q = r % 512, kb = q % 16, nb = q / 16, d0 = nb * 64, j = d0 >> 8, ii = d0 & 255;
            const int nsrc = (ii < 128) ? (128 * j + ii) : (1024 + 128 * j + (ii - 128));
            cvt_item(p->in[I_W1] + ((size_t)l * 32 + e) * 1024 * 2048, 2048, kb * 64, nsrc, (bf16_t*)(lw + LW_W1) + (size_t)e * 2048 * 1024, 1024, d0, scr, c.lane); continue; }
        r -= I_M1;
        { const int e = r / 256, q = r % 256, kb = q % 16, nb = q / 16;
            cvt_item(p->in[I_W2] + ((size_t)l * 32 + e) * 1024 * 1024, 1024, kb * 64, nb * 64, (bf16_t*)(lw + LW_W2) + (size_t)e * 1024 * 1024, 1024, nb * 64, scr, c.lane); }
    }
}

__device__ __forceinline__ void ph_conv_a(const Ctx& c0, KP p, int l, int item) {
    const Ctx c = relaunder(c0);
    const bf16_t* z = (const bf16_t*)(p->ws + WS_Z); bf16_t* ys = (bf16_t*)(p->ws + WS_YS);
    const int b = item >> 6, t0 = (item & 63) * 64; const size_t rb = (size_t)b * SEQ_;
    LAS bf16_t* ub = (LAS bf16_t*)c.lds;
    LAS float* red = (LAS float*)(c.lds + 96256);
    LAS float* yb = (LAS float*)(c.lds + 96512);
    { const int cg = c.tid & 63;
#pragma unroll 6
      for (int r = c.tid >> 6; r < 94; r += 8) { const int t = t0 - 30 + r; u32x4 o = (u32x4){0u, 0u, 0u, 0u};
          if (t >= 0) { const u32x4 va = *(const u32x4*)(z + (rb + t) * ZC + Z_AVAL + 8 * cg), vg = *(const u32x4*)(z + (rb + t) * ZC + Z_AGATE + 8 * cg);
              o.x = pk2(bflo(va.x) * sigmoidf_(bflo(vg.x)), bfhi(va.x) * sigmoidf_(bfhi(vg.x))); o.y = pk2(bflo(va.y) * sigmoidf_(bflo(vg.y)), bfhi(va.y) * sigmoidf_(bfhi(vg.y)));
              o.z = pk2(bflo(va.z) * sigmoidf_(bflo(vg.z)), bfhi(va.z) * sigmoidf_(bfhi(vg.z))); o.w = pk2(bflo(va.w) * sigmoidf_(bflo(vg.w)), bfhi(va.w) * sigmoidf_(bfhi(vg.w))); }
          *(LAS u32x4*)(ub + r * 512 + 8 * cg) = o; } }
    const int ch = c.tid;
    float w[31];
#pragma unroll
    for (int j = 0; j < 31; ++j) w[j] = p->in[I_CAW][((size_t)l * 31 + j) * 512 + ch];
    const float cb = p->in[I_CAB][l * 512 + ch], lg = p->in[I_LNAG][l * 512 + ch], lb = p->in[I_LNAB][l * 512 + ch];
    __syncthreads();
    for (int g = 0; g < 4; ++g) {
        float u[46];
#pragma unroll
        for (int r = 0; r < 46; ++r) u[r] = bf2f(ub[(16 * g + r) * 512 + ch]);
        float y[16];
#pragma unroll
        for (int i = 0; i < 16; ++i) { float a = cb;
#pragma unroll
            for (int j = 0; j < 31; ++j) a += w[j] * u[i + j];
            y[i] = a; }
#pragma unroll
        for (int i = 0; i < 16; ++i) yb[i * 512 + ch] = y[i];
        __syncthreads();
#pragma unroll
        for (int h2 = 0; h2 < 2; ++h2) { const int tk = c.wave + 8 * h2;
          const f32x4 a0 = *(const LAS f32x4*)(yb + tk * 512 + 8 * c.lane), a1 = *(const LAS f32x4*)(yb + tk * 512 + 8 * c.lane + 4);
          float s1 = ((a0[0] + a0[1]) + (a0[2] + a0[3])) + ((a1[0] + a1[1]) + (a1[2] + a1[3]));
          float s2 = ((a0[0] * a0[0] + a0[1] * a0[1]) + (a0[2] * a0[2] + a0[3] * a0[3])) + ((a1[0] * a1[0] + a1[1] * a1[1]) + (a1[2] * a1[2] + a1[3] * a1[3]));
          s1 = wave_sum(s1); s2 = wave_sum(s2);
          if (c.lane == 0) { const float mean = s1 * (1.f / 512.f); red[tk * 2] = mean; red[tk * 2 + 1] = 1.f / sqrtf(fmaxf(s2 * (1.f / 512.f) - mean * mean, 0.f) + LN_EPS); } }
        __syncthreads();
#pragma unroll
        for (int i = 0; i < 16; ++i) { const float v = (y[i] - red[2 * i]) * red[2 * i + 1] * lg + lb;
            ys[(rb + t0 + 16 * g + i) * 2048 + ch] = (bf16_t)f2bf(v * sigmoidf_(v)); }
    }
    __syncthreads();
}

__device__ __forceinline__ float gelu_tanh(float x) { const float u = 0.7978845608028654f * (x + 0.044715f * x * x * x); const float e = __expf(2.f * u); return 0.5f * x * (2.f - 2.f * __builtin_amdgcn_rcpf(e + 1.f)); }
template <int MODE>
__device__ __forceinline__ void ph_lru(const Ctx& c0, KP p, int l, int item) {
    const Ctx c = relaunder(c0);
    const bf16_t* z = (const bf16_t*)(p->ws + WS_Z); bf16_t* ys = (bf16_t*)(p->ws + WS_YS);
    float* lagg = (float*)(p->ws + WS_LAGG);
    const int b = item >> 6, tile = item & 63, t0 = tile * 64; const size_t rb = (size_t)b * SEQ_;
    LAS bf16_t* xc = (LAS bf16_t*)c.lds;
    LAS bf16_t* dg = (LAS bf16_t*)(c.lds + 66560);
    { const int cg = c.tid & 63, tr = c.tid >> 6;
      f32x4 cw[4][2], cbv[2];
#pragma unroll
      for (int j = 0; j < 4; ++j) { cw[j][0] = *(const f32x4*)(p->in[I_CDW] + ((size_t)l * 4 + j) * 512 + 8 * cg); cw[j][1] = *(const f32x4*)(p->in[I_CDW] + ((size_t)l * 4 + j) * 512 + 8 * cg + 4); }
      cbv[0] = *(const f32x4*)(p->in[I_CDB] + l * 512 + 8 * cg); cbv[1] = *(const f32x4*)(p->in[I_CDB] + l * 512 + 8 * cg + 4);
      u32x4 xr[11]; u32x4 gr[8];
#pragma unroll
      for (int i = 0; i < 11; ++i) { const int t = t0 + tr * 8 - 3 + i; xr[i] = (t >= 0) ? *(const u32x4*)(z + (rb + t) * ZC + Z_DX + 8 * cg) : (u32x4){0u, 0u, 0u, 0u}; }
      if (MODE == 3) {
#pragma unroll
          for (int i = 0; i < 8; ++i) gr[i] = *(const u32x4*)(z + (rb + t0 + tr * 8 + i) * ZC + Z_DG + 8 * cg); }
#pragma unroll
      for (int i = 0; i < 8; ++i) { f32x4 a0 = cbv[0], a1 = cbv[1];
#pragma unroll
          for (int j = 0; j < 4; ++j) { const u32x4 x = xr[i + j];
              a0 += cw[j][0] * (f32x4){bflo(x.x), bfhi(x.x), bflo(x.y), bfhi(x.y)}; a1 += cw[j][1] * (f32x4){bflo(x.z), bfhi(x.z), bflo(x.w), bfhi(x.w)}; }
          u32x4 o; o.x = pk2(a0[0], a0[1]); o.y = pk2(a0[2], a0[3]); o.z = pk2(a1[0], a1[1]); o.w = pk2(a1[2], a1[3]);
          *(LAS u32x4*)(xc + (tr * 8 + i) * 520 + 8 * cg) = o;
          if (MODE == 3) *(LAS u32x4*)(dg + (tr * 8 + i) * 520 + 8 * cg) = gr[i]; } }
    const int n = c.wave, r = c.lane & 15, q = c.lane >> 4;
    bf16x8 wfa[4][2], wfx[4][2];
    { const bf16_t* gw = (const bf16_t*)(p->ws + WS_LGW) + ((size_t)l * 2 * 8 + n) * 4096;
#pragma unroll
      for (int cb = 0; cb < 4; ++cb)
#pragma unroll
          for (int ks = 0; ks < 2; ++ks) { wfa[cb][ks] = *(const bf16x8*)(gw + (16 * cb + r) * 64 + 32 * ks + 8 * q); wfx[cb][ks] = *(const bf16x8*)(gw + 8 * 4096 + (16 * cb + r) * 64 + 32 * ks + 8 * q); } }
    float ba[4], bx[4], ls[4], hst[4], Atot[4];
#pragma unroll
    for (int cb = 0; cb < 4; ++cb) { const int ch = 64 * n + 16 * cb + r; ba[cb] = p->in[I_LBA][l * 512 + ch]; bx[cb] = p->in[I_LBX][l * 512 + ch];
        ls[cb] = -8.0f * softplusf_(-p->in[I_LLAM][l * 512 + ch]);
        hst[cb] = (MODE == 3) ? lagg[(size_t)2 * 4 * 64 * 512 + ((size_t)b * 64 + tile) * 512 + ch] : 0.f; Atot[cb] = 1.f; }
    __syncthreads();
    for (int rbk = 0; rbk < 4; ++rbk) {
        const bf16x8 af0 = *(const LAS bf16x8*)(xc + (16 * rbk + r) * 520 + 64 * n + 8 * q), af1 = *(const LAS bf16x8*)(xc + (16 * rbk + r) * 520 + 64 * n + 32 + 8 * q);
#pragma unroll
        for (int cb = 0; cb < 4; ++cb) {
            f32x4 pr = __builtin_amdgcn_mfma_f32_16x16x32_bf16(af0, wfa[cb][0], (f32x4){0.f, 0.f, 0.f, 0.f}, 0, 0, 0); pr = __builtin_amdgcn_mfma_f32_16x16x32_bf16(af1, wfa[cb][1], pr, 0, 0, 0);
            f32x4 pi = __builtin_amdgcn_mfma_f32_16x16x32_bf16(af0, wfx[cb][0], (f32x4){0.f, 0.f, 0.f, 0.f}, 0, 0, 0); pi = __builtin_amdgcn_mfma_f32_16x16x32_bf16(af1, wfx[cb][1], pi, 0, 0, 0);
            const int chl = 64 * n + 16 * cb + r;
            float a[4], u[4];
#pragma unroll
            for (int j = 0; j < 4; ++j) { const float xv = bf2f(xc[(16 * rbk + 4 * q + j) * 520 + chl]);
                const float rr = sigmoidf_(pr[j] + ba[cb]), ig = sigmoidf_(pi[j] + bx[cb]);
                const float aa = __expf(rr * ls[cb]); a[j] = aa; u[j] = sqrtf(fmaxf(1.f - aa * aa, 0.f)) * (ig * xv); }
            const float Aloc = (a[0] * a[1]) * (a[2] * a[3]), Hloc = ((u[0] * a[1] + u[1]) * a[2] + u[2]) * a[3] + u[3];
            const float A1 = __shfl_xor(Aloc, 16), A2 = __shfl_xor(Aloc, 32), A3 = __shfl_xor(Aloc, 48), H1 = __shfl_xor(Hloc, 16), H2 = __shfl_xor(Hloc, 32), H3 = __shfl_xor(Hloc, 48);
            float h = hst[cb], hstart = h, At = 1.f;
#pragma unroll
            for (int qq = 0; qq < 4; ++qq) { const int idx = qq ^ q;
                const float Ag = (idx == 0) ? Aloc : (idx == 1) ? A1 : (idx == 2) ? A2 : A3, Hg = (idx == 0) ? Hloc : (idx == 1) ? H1 : (idx == 2) ? H2 : H3;
                hstart = (qq == q) ? h : hstart; h = Ag * h + Hg; At *= Ag; }
            hst[cb] = h; Atot[cb] *= At;
            if (MODE == 3) { float hh = hstart;
#pragma unroll
                for (int j = 0; j < 4; ++j) { hh = a[j] * hh + u[j]; LAS bf16_t* dp = dg + (16 * rbk + 4 * q + j) * 520 + chl; *dp = (bf16_t)f2bf(hh * gelu_tanh(bf2f(*dp))); } }
        }
    }
    if (MODE == 1) { if (q == 0) {
#pragma unroll
        for (int cb = 0; cb < 4; ++cb) { const int ch = 64 * n + 16 * cb + r; lagg[((size_t)b * 64 + tile) * 512 + ch] = Atot[cb]; lagg[(size_t)4 * 64 * 512 + ((size_t)b * 64 + tile) * 512 + ch] = hst[cb]; } } }
    if (MODE == 3) { __syncthreads();
        const int cg = c.tid & 63, tr = c.tid >> 6;
#pragma unroll
        for (int i = 0; i < 8; ++i) *(u32x4*)(ys + (rb + t0 + tr * 8 + i) * 2048 + 1536 + 8 * cg) = *(const LAS u32x4*)(dg + (tr * 8 + i) * 520 + 8 * cg); }
    __syncthreads();
}
__device__ __forceinline__ void ph_lru_carry(const Ctx& c, KP p) {
    float* lagg = (float*)(p->ws + WS_LAGG);
    for (int g = c.bid * 512 + c.tid; g < 4 * 512; g += c.G * 512) { const int b = g >> 9, ch = g & 511; float s = 0.f;
        for (int j0 = 0; j0 < 64; j0 += 16) { float av[16], hv[16];
#pragma unroll
            for (int j = 0; j < 16; ++j) { const size_t o = ((size_t)b * 64 + j0 + j) * 512 + ch; av[j] = lagg[o]; hv[j] = lagg[(size_t)4 * 64 * 512 + o]; }
#pragma unroll
            for (int j = 0; j < 16; ++j) { const size_t o = ((size_t)b * 64 + j0 + j) * 512 + ch; lagg[(size_t)2 * 4 * 64 * 512 + o] = s; s = av[j] * s + hv[j]; } } }
}

__device__ __forceinline__ void ph_gla1(const Ctx& c0, KP p, int l, int item) {
    const Ctx c = relaunder(c0);
    const bf16_t* z = (const bf16_t*)(p->ws + WS_Z); const bf16_t* hb = (const bf16_t*)(p->ws + WS_HB);
    float* bcum = (float*)(p->ws + WS_BCUM); float* kvst = (float*)(p->ws + WS_KVST);
    const int b = item >> 6, ck = item & 63; const size_t r0 = (size_t)b * SEQ_ + ck * 64;
    LAS float* lrp = (LAS float*)c.lds;
    LAS float* lrs = (LAS float*)(c.lds + 8192);
    LAS float* tot = (LAS float*)(c.lds + 8192);
    LAS float* bcs = (LAS float*)(c.lds + 12288);
    LAS bf16_t* keT = (LAS bf16_t*)(c.lds + 77824);
    LAS bf16_t* vT = (LAS bf16_t*)(c.lds + 96256);
    const int r = c.lane & 15, q = c.lane >> 4;
    u32x4 nkv[2], nvv[2][2];
#define GLA1_LOAD(hp_) do { const int t_ = c.tid >> 3, k0_ = (c.tid & 7) * 8, v0_ = (c.tid & 7) * 16; \
        _Pragma("unroll") for (int h2_ = 0; h2_ < 2; ++h2_) { const int hh_ = 2 * (hp_) + h2_; nkv[h2_] = *(const u32x4*)(z + (r0 + t_) * ZC + Z_BK + hh_ * 64 + k0_); \
            nvv[h2_][0] = *(const u32x4*)(z + (r0 + t_) * ZC + Z_BV + hh_ * 128 + v0_); nvv[h2_][1] = *(const u32x4*)(z + (r0 + t_) * ZC + Z_BV + hh_ * 128 + v0_ + 8); } } while (0)
    GLA1_LOAD(0);
    { const int rbk = c.wave & 3, kh = c.wave >> 2;
      const bf16_t* ap = hb + (r0 + 16 * rbk + r) * 1024 + 512 * kh + 8 * q; const bf16_t* bp = (const bf16_t*)(p->ws + WS_WLR) + ((size_t)l * 16 + r) * 1024 + 512 * kh + 8 * q;
      f32x4 acc = (f32x4){0.f, 0.f, 0.f, 0.f};
#pragma unroll 8
      for (int ks = 0; ks < 16; ++ks) acc = __builtin_amdgcn_mfma_f32_16x16x32_bf16(*(const bf16x8*)(ap + 32 * ks), *(const bf16x8*)(bp + 32 * ks), acc, 0, 0, 0);
#pragma unroll
      for (int j = 0; j < 4; ++j) lrp[(kh * 64 + 16 * rbk + 4 * q + j) * 16 + r] = acc[j]; }
    __syncthreads();
    { const float* bi = p->in[I_BIN] + (size_t)l * INC + LR_COL;
      for (int i = c.tid; i < 1024; i += 512) lrs[i] = lrp[i] + lrp[1024 + i] + bi[i & 15]; }
    __syncthreads();
    { const int n = c.tid & 255, th = c.tid >> 8; float w2[16];
#pragma unroll
      for (int j = 0; j < 16; ++j) w2[j] = p->in[I_WA2][((size_t)l * 16 + j) * 256 + n];
      const float ba = p->in[I_GBA][l * 256 + n]; float cum = 0.f;
      for (int t = 32 * th; t < 32 * th + 32; ++t) { float pre = ba;
#pragma unroll
          for (int j4 = 0; j4 < 4; ++j4) { const f32x4 lv = *(const LAS f32x4*)(lrs + t * 16 + 4 * j4); pre += lv[0] * w2[4 * j4] + lv[1] * w2[4 * j4 + 1] + lv[2] * w2[4 * j4 + 2] + lv[3] * w2[4 * j4 + 3]; }
          cum += -softplusf_(-pre) * (1.f / 16.f);
          bcs[t * 256 + n] = cum; }
      __syncthreads();
      if (th == 0) tot[n] = cum;
      __syncthreads();
      if (th == 1) { const float a = tot[n]; for (int t = 32; t < 64; ++t) bcs[t * 256 + n] += a; }
      __syncthreads();
      for (int t = 32 * th; t < 32 * th + 32; ++t) bcum[(r0 + t) * 256 + n] = bcs[t * 256 + n]; }
    for (int hp = 0; hp < 2; ++hp) {
        { const int t = c.tid >> 3, k0 = (c.tid & 7) * 8, v0 = (c.tid & 7) * 16;
#pragma unroll
          for (int h2 = 0; h2 < 2; ++h2) { const int hh = 2 * hp + h2;
              const u32x4 kv = nkv[h2]; const unsigned kw[4] = {kv.x, kv.y, kv.z, kv.w};
#pragma unroll
              for (int e = 0; e < 4; ++e) { const int kk = hh * 64 + k0 + 2 * e;
                  keT[(h2 * 64 + k0 + 2 * e) * 72 + t] = (bf16_t)f2bf(bflo(kw[e]) * __expf(bcs[63 * 256 + kk] - bcs[t * 256 + kk]));
                  keT[(h2 * 64 + k0 + 2 * e + 1) * 72 + t] = (bf16_t)f2bf(bfhi(kw[e]) * __expf(bcs[63 * 256 + kk + 1] - bcs[t * 256 + kk + 1])); }
#pragma unroll
              for (int qq = 0; qq < 2; ++qq) { const u32x4 vv = nvv[h2][qq]; const unsigned vw[4] = {vv.x, vv.y, vv.z, vv.w};
#pragma unroll
                  for (int e = 0; e < 4; ++e) { vT[(h2 * 128 + v0 + 8 * qq + 2 * e) * 72 + t] = (bf16_t)(vw[e] & 0xffffu); vT[(h2 * 128 + v0 + 8 * qq + 2 * e + 1) * 72 + t] = (bf16_t)(vw[e] >> 16); } } } }
        __syncthreads();
        if (hp == 0) GLA1_LOAD(1);
        { const int h2 = c.wave >> 2, rbk = c.wave & 3, hh = 2 * hp + h2;
          const bf16x8 a0 = *(const LAS bf16x8*)(keT + (h2 * 64 + 16 * rbk + r) * 72 + 8 * q), a1 = *(const LAS bf16x8*)(keT + (h2 * 64 + 16 * rbk + r) * 72 + 32 + 8 * q);
          float* dst = kvst + ((((size_t)b * 64 + ck) * 4 + hh) * 64 + 16 * rbk + 4 * q) * 128 + r;
#pragma unroll
          for (int cb = 0; cb < 8; ++cb) {
              const bf16x8 b0 = *(const LAS bf16x8*)(vT + (h2 * 128 + 16 * cb + r) * 72 + 8 * q), b1 = *(const LAS bf16x8*)(vT + (h2 * 128 + 16 * cb + r) * 72 + 32 + 8 * q);
              f32x4 d = __builtin_amdgcn_mfma_f32_16x16x32_bf16(a0, b0, (f32x4){0.f, 0.f, 0.f, 0.f}, 0, 0, 0); d = __builtin_amdgcn_mfma_f32_16x16x32_bf16(a1, b1, d, 0, 0, 0);
#pragma unroll
              for (int j = 0; j < 4; ++j) dst[(size_t)j * 128 + 16 * cb] = d[j]; } }
        __syncthreads();
    }
}
__device__ __forceinline__ void ph_gla2(const Ctx& c, KP p) {
    const float* bcum = (const float*)(p->ws + WS_BCUM); const float* kvst = (const float*)(p->ws + WS_KVST); bf16_t* sprev = (bf16_t*)(p->ws + WS_SPREV);
    for (int g = c.bid * 512 + c.tid; g < 4 * 4 * 64 * 128; g += c.G * 512) {
        const int v = g & 127, k = (g >> 7) & 63, hh = (g >> 13) & 3, b = g >> 15; float s = 0.f;
        for (int c0 = 0; c0 < 64; c0 += 16) { float kv[16], dc[16];
#pragma unroll
            for (int j = 0; j < 16; ++j) { const int ck = c0 + j; kv[j] = kvst[((((size_t)b * 64 + ck) * 4 + hh) * 64 + k) * 128 + v]; dc[j] = bcum[((size_t)b * SEQ_ + ck * 64 + 63) * 256 + hh * 64 + k]; }
#pragma unroll
            for (int j = 0; j < 16; ++j) { const int ck = c0 + j; sprev[((((size_t)b * 64 + ck) * 4 + hh) * 64 + k) * 128 + v] = (bf16_t)f2bf(s); s = __expf(dc[j]) * s + kv[j]; } }
    }
}
__device__ __forceinline__ void ph_gla3(const Ctx& c0, KP p, int l, int item) {
    const Ctx c = relaunder(c0);
    const bf16_t* z = (const bf16_t*)(p->ws + WS_Z); const float* bcum = (const float*)(p->ws + WS_BCUM); const bf16_t* sprev = (const bf16_t*)(p->ws + WS_SPREV); bf16_t* ys = (bf16_t*)(p->ws + WS_YS);
    const int b = item >> 6, ck = item & 63; const size_t r0 = (size_t)b * SEQ_ + ck * 64;
    LAS bf16_t* qd = (LAS bf16_t*)c.lds;
    LAS bf16_t* ki = (LAS bf16_t*)(c.lds + 9216);
    LAS bf16_t* vT = (LAS bf16_t*)(c.lds + 18432);
    LAS bf16_t* sT = (LAS bf16_t*)(c.lds + 36864);
    LAS bf16_t* scp = (LAS bf16_t*)(c.lds + 55296) + c.wave * (16 * 72);
    LAS bf16_t* br = (LAS bf16_t*)(c.lds + 73728);
    LAS float* part = (LAS float*)(c.lds + 91136);
    const int r = c.lane & 15, q = c.lane >> 4, rbk = c.wave & 3, half = c.wave >> 2;
    u32x4 nqv, nkv, nvv0, nvv1, nrv0, nrv1, nsq0, nsq1; f32x4 nbc0, nbc1;
#define GLA3_LOAD(hh_) do { const int t_ = c.tid >> 3, k0_ = (c.tid & 7) * 8, v0_ = (c.tid & 7) * 16; \
        nqv = *(const u32x4*)(z + (r0 + t_) * ZC + Z_BQ + (hh_) * 64 + k0_); nkv = *(const u32x4*)(z + (r0 + t_) * ZC + Z_BK + (hh_) * 64 + k0_); \
        nbc0 = *(const f32x4*)(bcum + (r0 + t_) * 256 + (hh_) * 64 + k0_); nbc1 = *(const f32x4*)(bcum + (r0 + t_) * 256 + (hh_) * 64 + k0_ + 4); \
        nvv0 = *(const u32x4*)(z + (r0 + t_) * ZC + Z_BV + (hh_) * 128 + v0_); nvv1 = *(const u32x4*)(z + (r0 + t_) * ZC + Z_BV + (hh_) * 128 + v0_ + 8); \
        nrv0 = *(const u32x4*)(z + (r0 + t_) * ZC + Z_BR + (hh_) * 128 + v0_); nrv1 = *(const u32x4*)(z + (r0 + t_) * ZC + Z_BR + (hh_) * 128 + v0_ + 8); \
        const bf16_t* sps_ = sprev + ((((size_t)b * 64 + ck) * 4 + (hh_)) * 64 + t_) * 128 + v0_;       \
        nsq0 = *(const u32x4*)(sps_); nsq1 = *(const u32x4*)(sps_ + 8); } while (0)
    GLA3_LOAD(0);
    for (int hh = 0; hh < 4; ++hh) {
        { const int t = c.tid >> 3, k0 = (c.tid & 7) * 8, v0 = (c.tid & 7) * 16;
          const u32x4 qv = nqv, kv = nkv, vv0 = nvv0, vv1 = nvv1, rv0 = nrv0, rv1 = nrv1, sq0 = nsq0, sq1 = nsq1; const f32x4 bc0 = nbc0, bc1 = nbc1;
          const unsigned qw[4] = {qv.x, qv.y, qv.z, qv.w}, kw[4] = {kv.x, kv.y, kv.z, kv.w}; const float bcv[8] = {bc0[0], bc0[1], bc0[2], bc0[3], bc1[0], bc1[1], bc1[2], bc1[3]};
          unsigned qo[4], ko[4];
#pragma unroll
          for (int e = 0; e < 4; ++e) { const float e0 = __expf(bcv[2 * e]), e1 = __expf(bcv[2 * e + 1]);
              qo[e] = pk2(bflo(qw[e]) * 0.125f * e0, bfhi(qw[e]) * 0.125f * e1); ko[e] = pk2(bflo(kw[e]) * __builtin_amdgcn_rcpf(e0), bfhi(kw[e]) * __builtin_amdgcn_rcpf(e1)); }
          *(LAS u32x4*)(qd + t * 72 + k0) = (u32x4){qo[0], qo[1], qo[2], qo[3]}; *(LAS u32x4*)(ki + t * 72 + k0) = (u32x4){ko[0], ko[1], ko[2], ko[3]};
          const unsigned vw[8] = {vv0.x, vv0.y, vv0.z, vv0.w, vv1.x, vv1.y, vv1.z, vv1.w};
#pragma unroll
          for (int e = 0; e < 8; ++e) { vT[(v0 + 2 * e) * 72 + t] = (bf16_t)(vw[e] & 0xffffu); vT[(v0 + 2 * e + 1) * 72 + t] = (bf16_t)(vw[e] >> 16); }
          const unsigned sw[8] = {sq0.x, sq0.y, sq0.z, sq0.w, sq1.x, sq1.y, sq1.z, sq1.w};
#pragma unroll
          for (int e = 0; e < 8; ++e) { sT[(v0 + 2 * e) * 72 + t] = (bf16_t)(sw[e] & 0xffffu); sT[(v0 + 2 * e + 1) * 72 + t] = (bf16_t)(sw[e] >> 16); }
          *(LAS u32x4*)(br + t * 136 + v0) = rv0; *(LAS u32x4*)(br + t * 136 + v0 + 8) = rv1; }
        __syncthreads();
        if (hh < 3) GLA3_LOAD(hh + 1);
        const bf16x8 aq0 = *(const LAS bf16x8*)(qd + (16 * rbk + r) * 72 + 8 * q), aq1 = *(const LAS bf16x8*)(qd + (16 * rbk + r) * 72 + 32 + 8 * q);
#pragma unroll
        for (int cb = 0; cb < 4; ++cb) {
            const bf16x8 b0 = *(const LAS bf16x8*)(ki + (16 * cb + r) * 72 + 8 * q), b1 = *(const LAS bf16x8*)(ki + (16 * cb + r) * 72 + 32 + 8 * q);
            f32x4 d = __builtin_amdgcn_mfma_f32_16x16x32_bf16(aq0, b0, (f32x4){0.f, 0.f, 0.f, 0.f}, 0, 0, 0); d = __builtin_amdgcn_mfma_f32_16x16x32_bf16(aq1, b1, d, 0, 0, 0);
#pragma unroll
            for (int j = 0; j < 4; ++j) scp[(4 * q + j) * 72 + 16 * cb + r] = (bf16_t)f2bf((16 * cb + r <= 16 * rbk + 4 * q + j) ? d[j] : 0.f); }
        LDS_WAIT(); __builtin_amdgcn_wave_barrier();
        const bf16x8 as0 = *(const LAS bf16x8*)(scp + r * 72 + 8 * q), as1 = *(const LAS bf16x8*)(scp + r * 72 + 32 + 8 * q);
        f32x4 o[4]; float ssq[4] = {0.f, 0.f, 0.f, 0.f};
#pragma unroll
        for (int cbl = 0; cbl < 4; ++cbl) { const int vr = 16 * (4 * half + cbl) + r;
            const bf16x8 bv0 = *(const LAS bf16x8*)(vT + vr * 72 + 8 * q), bv1 = *(const LAS bf16x8*)(vT + vr * 72 + 32 + 8 * q), bs0 = *(const LAS bf16x8*)(sT + vr * 72 + 8 * q), bs1 = *(const LAS bf16x8*)(sT + vr * 72 + 32 + 8 * q);
            f32x4 d = __builtin_amdgcn_mfma_f32_16x16x32_bf16(as0, bv0, (f32x4){0.f, 0.f, 0.f, 0.f}, 0, 0, 0); d = __builtin_amdgcn_mfma_f32_16x16x32_bf16(as1, bv1, d, 0, 0, 0);
            d = __builtin_amdgcn_mfma_f32_16x16x32_bf16(aq0, bs0, d, 0, 0, 0); d = __builtin_amdgcn_mfma_f32_16x16x32_bf16(aq1, bs1, d, 0, 0, 0);
            o[cbl] = d;
#pragma unroll
            for (int j = 0; j < 4; ++j) ssq[j] += d[j] * d[j]; }
#pragma unroll
        for (int j = 0; j < 4; ++j) { float s = ssq[j]; s += __shfl_xor(s, 1); s += __shfl_xor(s, 2); s += __shfl_xor(s, 4); s += __shfl_xor(s, 8); if (r == 0) part[half * 64 + 16 * rbk + 4 * q + j] = s; }
        __syncthreads();
#pragma unroll
        for (int j = 0; j < 4; ++j) { const int t = 16 * rbk + 4 * q + j; const float rstd = 1.f / sqrtf((part[t] + part[64 + t]) * (1.f / 128.f) + LN_EPS);
#pragma unroll
            for (int cbl = 0; cbl < 4; ++cbl) { const int v = 16 * (4 * half + cbl) + r; LAS bf16_t* bp = br + t * 136 + v; const float x = bf2f(*bp);
                *bp = (bf16_t)f2bf(o[cbl][j] * rstd * p->in[I_GNG][l * 128 + v] * (x * sigmoidf_(x))); } }
        __syncthreads();
        for (int i = c.tid; i < 1024; i += 512) { const int t = i >> 4, ch = i & 15; *(u32x4*)(ys + (r0 + t) * 2048 + 512 + hh * 128 + 8 * ch) = *(const LAS u32x4*)(br + t * 136 + 8 * ch); }
        __syncthreads();
    }
}

__device__ __forceinline__ void ph_stick(const Ctx& c0, KP p, int item) {
    const Ctx c = relaunder(c0);
    const bf16_t* z = (const bf16_t*)(p->ws + WS_Z); bf16_t* ys = (bf16_t*)(p->ws + WS_YS);
    const int b = item >> 7, hh = (item >> 4) & 7, qblk = item & 15; const size_t rb = (size_t)b * SEQ_;
    const int r = c.lane & 15, q = c.lane >> 4;
    const int tq0 = qblk * 256 + 32 * c.wave;
    volatile LAS int* flg = (volatile LAS int*)(c.lds + LDS_MISC + MISC_RED);
    bf16x8 qf[2][2];
#pragma unroll
    for (int qb = 0; qb < 2; ++qb)
#pragma unroll
        for (int ks = 0; ks < 2; ++ks) { const u32x4 v = *(const u32x4*)(z + (rb + tq0 + 16 * qb + r) * ZC + Z_CQ + hh * 64 + 32 * ks + 8 * q);
            u32x4 w; w.x = pk2(bflo(v.x) * 0.125f, bfhi(v.x) * 0.125f); w.y = pk2(bflo(v.y) * 0.125f, bfhi(v.y) * 0.125f); w.z = pk2(bflo(v.z) * 0.125f, bfhi(v.z) * 0.125f); w.w = pk2(bflo(v.w) * 0.125f, bfhi(v.w) * 0.125f);
            qf[qb][ks] = __builtin_bit_cast(bf16x8, w); }
    f32x4 oacc[4][2];
#pragma unroll
    for (int db = 0; db < 4; ++db)
#pragma unroll
        for (int qb = 0; qb < 2; ++qb) oacc[db][qb] = (f32x4){0.f, 0.f, 0.f, 0.f};
    float P[2] = {1.f, 1.f};
    const int kt_hi = qblk * 4 + 3, skey = c.tid >> 3, sd = c.tid & 7;
    u32x4 kreg, vreg;
    { const size_t row = rb + kt_hi * 64 + skey; kreg = *(const u32x4*)(z + row * ZC + Z_CK + hh * 64 + 8 * sd); vreg = *(const u32x4*)(z + row * ZC + Z_CV + hh * 64 + 8 * sd); }
#define STK_WRITE(buf) do { LAS bf16_t* Kt_ = (LAS bf16_t*)(c.lds + (buf) * 18432); LAS bf16_t* Vt_ = (LAS bf16_t*)(c.lds + (buf) * 18432 + 9216); \
        *(LAS u32x4*)(Kt_ + skey * 72 + 8 * sd) = kreg; const unsigned vw_[4] = {vreg.x, vreg.y, vreg.z, vreg.w}; \
        _Pragma("unroll") for (int e_ = 0; e_ < 4; ++e_) { Vt_[(8 * sd + 2 * e_) * 68 + skey] = (bf16_t)(vw_[e_] & 0xffffu); Vt_[(8 * sd + 2 * e_ + 1) * 68 + skey] = (bf16_t)(vw_[e_] >> 16); } } while (0)
    STK_WRITE(0);
    __syncthreads();
    bool wdone = false;
    for (int kt = kt_hi, it = 0; kt >= 0; --kt, ++it) {
        const int cur = it & 1;
        if (kt > 0) { const size_t row = rb + (kt - 1) * 64 + skey; kreg = *(const u32x4*)(z + row * ZC + Z_CK + hh * 64 + 8 * sd); vreg = *(const u32x4*)(z + row * ZC + Z_CV + hh * 64 + 8 * sd); }
        const int k0 = kt * 64;
        if (!wdone && k0 < tq0 + 31) {
            const LAS bf16_t* Kt = (const LAS bf16_t*)(c.lds + cur * 18432); const LAS bf16_t* Vt = (const LAS bf16_t*)(c.lds + cur * 18432 + 9216);
            for (int g = 1; g >= 0; --g) {
                const int g0 = k0 + 32 * g; if (g0 >= tq0 + 31) continue;
                f32x4 s[2][2];
#pragma unroll
                for (int blk = 0; blk < 2; ++blk) {
                    const bf16x8 kf0 = *(const LAS bf16x8*)(Kt + (32 * g + 16 * blk + r) * 72 + 8 * q), kf1 = *(const LAS bf16x8*)(Kt + (32 * g + 16 * blk + r) * 72 + 32 + 8 * q);
#pragma unroll
                    for (int qb = 0; qb < 2; ++qb) { f32x4 a = __builtin_amdgcn_mfma_f32_16x16x32_bf16(kf0, qf[qb][0], (f32x4){0.f, 0.f, 0.f, 0.f}, 0, 0, 0);
                        s[blk][qb] = __builtin_amdgcn_mfma_f32_16x16x32_bf16(kf1, qf[qb][1], a, 0, 0, 0); }
                }
                bf16x8 wf[2];
#pragma unroll
                for (int qb = 0; qb < 2; ++qb) {
                    const int tquery = tq0 + 16 * qb + r;
                    float w[2][4];
#pragma unroll
                    for (int blk = 1; blk >= 0; --blk) {
                        float be[4], kp[4];
#pragma unroll
                        for (int j = 0; j < 4; ++j) { const float zz = s[blk][qb][j]; const float e = __expf(-fabsf(zz)); const float rr = __builtin_amdgcn_rcpf(1.f + e); const float er = e * rr;
                            const bool valid = (g0 + 16 * blk + 4 * q + j) < tquery;
                            be[j] = valid ? (zz >= 0.f ? rr : er) : 0.f; kp[j] = valid ? (zz >= 0.f ? er : rr) : 1.f; }
                        const float p2 = kp[3], p1 = p2 * kp[2], p0 = p1 * kp[1], L = p0 * kp[0];
                        const float L16 = __shfl_xor(L, 16); const float M = L * L16; const float M32 = __shfl_xor(M, 32);
                        const float X = (q == 3) ? 1.f : (q == 2) ? L16 : (q == 1) ? M32 : L16 * M32;
                        const float base = X * P[qb];
                        w[blk][3] = be[3] * base; w[blk][2] = be[2] * p2 * base; w[blk][1] = be[1] * p1 * base; w[blk][0] = be[0] * p0 * base;
                        P[qb] *= M * M32;
                    }
                    u32x4 pw; pw.x = pk2(w[0][0], w[0][1]); pw.y = pk2(w[0][2], w[0][3]); pw.z = pk2(w[1][0], w[1][1]); pw.w = pk2(w[1][2], w[1][3]);
                    wf[qb] = __builtin_bit_cast(bf16x8, pw);
                }
#pragma unroll
                for (int db = 0; db < 4; ++db) {
                    const u32x2 v0 = *(const LAS u32x2*)(Vt + (16 * db + r) * 68 + 32 * g + 4 * q), v1 = *(const LAS u32x2*)(Vt + (16 * db + r) * 68 + 32 * g + 16 + 4 * q);
                    const bf16x8 vf = __builtin_bit_cast(bf16x8, (u32x4){v0.x, v0.y, v1.x, v1.y});
#pragma unroll
                    for (int qb = 0; qb < 2; ++qb) oacc[db][qb] = __builtin_amdgcn_mfma_f32_16x16x32_bf16(vf, wf[qb], oacc[db][qb], 0, 0, 0);
                }
            }
            wdone = __all((P[0] < 1e-30f) && (P[1] < 1e-30f));
        }
        if (c.lane == 0) flg[cur * 8 + c.wave] = wdone ? 1 : 0;
        if (kt > 0) STK_WRITE(cur ^ 1);
        __syncthreads();
        int alld = 1;
#pragma unroll
        for (int w8 = 0; w8 < 8; ++w8) alld &= flg[cur * 8 + w8];
        if (alld) break;
    }
#undef STK_WRITE
#pragma unroll
    for (int qb = 0; qb < 2; ++qb) { bf16_t* op = ys + (rb + tq0 + 16 * qb + r) * 2048 + 1024 + hh * 64 + 4 * q;
#pragma unroll
        for (int db = 0; db < 4; ++db) { const f32x4 o = oacc[db][qb]; u32x2 w; w.x = pk2(o[0], o[1]); w.y = pk2(o[2], o[3]); *(u32x2*)(op + 16 * db) = w; } }
    __syncthreads();
}

__device__ __forceinline__ void ph_ln2_router(const Ctx& c0, KP p, int l, bool fused  ) {
    const Ctx c = relaunder(c0);
    unsigned char* ws = p->ws; float* hf = (float*)(ws + WS_H); bf16_t* hb = (bf16_t*)(ws + WS_HB); const float* pre = fused ? (const float*)hf : (const float*)(ws + WS_PRE);
    int* toke = (int*)(ws + WS_TOKE); int* tokr = (int*)(ws + WS_TOKR); float* tokg = (float*)(ws + WS_TOKG); int* elist = (int*)(ws + WS_ELIST);
    unsigned* cnt = (unsigned*)(ws + WS_CTL) + CW_CNT + l * 32 * 16;
    const float* rw = p->in[I_RW] + (size_t)l * 1024 * 32; const float* rbias = p->in[I_RB] + l * 32;
    const float* g = p->in[I_LN2G] + l * 1024; const float* bb = p->in[I_LN2B] + l * 1024;
    LAS float* arow = (LAS float*)c.lds;
    LAS float* part = (LAS float*)(c.lds + 65792);
    LAS float* lgt = (LAS float*)(c.lds + 65792 + 16384);
    const int r = c.lane & 15, kq = c.lane >> 4;
    float bf0[32], bf1[32];
#pragma unroll
    for (int i = 0; i < 32; ++i) { const int k = 4 * (32 * c.wave + i) + kq; bf0[i] = rw[(size_t)k * 32 + r]; bf1[i] = rw[(size_t)k * 32 + 16 + r]; }
    for (int tile = c.bid; tile < T_ / 64; tile += c.G) {
        f32x4 nv[2][4];
#pragma unroll
        for (int rr = 0; rr < 2; ++rr)
#pragma unroll
            for (int j = 0; j < 4; ++j) nv[rr][j] = *(const f32x4*)(pre + (size_t)(tile * 64 + 2 * c.wave + rr) * 1024 + 4 * c.lane + 256 * j);
        for (int grp = 0; grp < 4; ++grp) {
            const int m0 = tile * 64 + grp * 16;
            f32x4 v[2][4];
#pragma unroll
            for (int rr = 0; rr < 2; ++rr)
#pragma unroll
                for (int j = 0; j < 4; ++j) v[rr][j] = nv[rr][j];
            if (grp < 3) {
#pragma unroll
                for (int rr = 0; rr < 2; ++rr)
#pragma unroll
                    for (int j = 0; j < 4; ++j) nv[rr][j] = *(const f32x4*)(pre + (size_t)(m0 + 16 + 2 * c.wave + rr) * 1024 + 4 * c.lane + 256 * j); }
#pragma unroll
            for (int rr = 0; rr < 2; ++rr) { const int lr = 2 * c.wave + rr, m = m0 + lr;
                if (!fused) ln_row_regs(v[rr], g, bb, c.lane, hf + (size_t)m * 1024, hb + (size_t)m * 1024);
#pragma unroll
                for (int j = 0; j < 4; ++j) *(LAS f32x4*)(arow + lr * 1028 + 4 * c.lane + 256 * j) = v[rr][j]; }
            __syncthreads();
            f32x4 acc0 = (f32x4){0.f, 0.f, 0.f, 0.f}, acc1 = (f32x4){0.f, 0.f, 0.f, 0.f};
#pragma unroll
            for (int i = 0; i < 32; ++i) { const float a = arow[r * 1028 + 4 * (32 * c.wave + i) + kq];
                acc0 = __builtin_amdgcn_mfma_f32_16x16x4f32(a, bf0[i], acc0, 0, 0, 0); acc1 = __builtin_amdgcn_mfma_f32_16x16x4f32(a, bf1[i], acc1, 0, 0, 0); }
#pragma unroll
            for (int j = 0; j < 4; ++j) { part[(c.wave * 16 + 4 * kq + j) * 32 + r] = acc0[j]; part[(c.wave * 16 + 4 * kq + j) * 32 + 16 + r] = acc1[j]; }
            __syncthreads();
            { const int row = c.tid >> 5, e = c.tid & 31; float s = rbias[e];
#pragma unroll
              for (int w = 0; w < 8; ++w) s += part[(w * 16 + row) * 32 + e];
              lgt[row * 32 + e] = s; }
            __syncthreads();
            if (c.tid < 16) { const int m = m0 + c.tid; float lg[32];
#pragma unroll
                for (int e = 0; e < 32; ++e) lg[e] = lgt[c.tid * 32 + e];
                float tv[4]; int ti[4]; unsigned taken = 0u;
#pragma unroll
                for (int k = 0; k < 4; ++k) { float best = -3.0e38f; int bi = 0;
#pragma unroll
                    for (int e = 0; e < 32; ++e) { const bool ok = !((taken >> e) & 1u) && (lg[e] > best); best = ok ? lg[e] : best; bi = ok ? e : bi; }
                    tv[k] = best; ti[k] = bi; taken |= 1u << bi; }
                float ev[4]; ev[0] = 1.f; ev[1] = __expf(tv[1] - tv[0]); ev[2] = __expf(tv[2] - tv[0]); ev[3] = __expf(tv[3] - tv[0]);
                const float inv = 1.f / (ev[0] + ev[1] + ev[2] + ev[3]);
#pragma unroll
                for (int k = 0; k < 4; ++k) { const unsigned rk = atomicAdd(cnt + ti[k] * 16, 1u); toke[m * 4 + k] = ti[k]; tokr[m * 4 + k] = (int)rk; tokg[m * 4 + k] = ev[k] * inv; elist[(size_t)ti[k] * T_ + rk] = m; } }
        }
    }
    __syncthreads();
}
__device__ __forceinline__ void ph_router_fused(const Ctx& c0, KP p, int l) {
    const Ctx c = relaunder(c0);
    unsigned char* ws = p->ws; const float* hf = (const float*)(ws + WS_H);
    int* toke = (int*)(ws + WS_TOKE); int* tokr = (int*)(ws + WS_TOKR); float* tokg = (float*)(ws + WS_TOKG); int* elist = (int*)(ws + WS_ELIST);
    unsigned* cnt = (unsigned*)(ws + WS_CTL) + CW_CNT + l * 32 * 16;
    const bf16_t* rwh = (const bf16_t*)(ws + WS_RWS) + (size_t)l * 2 * 32 * 1024; const bf16_t* rwl = rwh + 32 * 1024; const float* rbias = p->in[I_RB] + l * 32;
    LAS float* part = (LAS float*)c.lds;
    LAS float* lgt = (LAS float*)(c.lds + 16384);
    LAS int* lcnt = (LAS int*)(c.lds + 16384 + 8448);
    LAS int* lbase = lcnt + 32;
    if (c.tid < 32) lcnt[c.tid] = 0;
    __syncthreads();
    const int r = c.lane & 15, q = c.lane >> 4, rbk = c.wave & 3, kh = c.wave >> 2;
    for (int tile = c.bid; tile < T_ / 64; tile += c.G) {
        const int m0 = tile * 64;
        const float* ap = hf + (size_t)(m0 + 16 * rbk + r) * 1024 + 512 * kh + 8 * q;
        const bf16_t* bhp = rwh + (size_t)r * 1024 + 512 * kh + 8 * q; const bf16_t* blp = rwl + (size_t)r * 1024 + 512 * kh + 8 * q;
        f32x4 acc0 = (f32x4){0.f, 0.f, 0.f, 0.f}, acc1 = (f32x4){0.f, 0.f, 0.f, 0.f};
#pragma unroll 4
        for (int ks = 0; ks < 16; ++ks) {
            const f32x4 a0 = *(const f32x4*)(ap + 32 * ks), a1 = *(const f32x4*)(ap + 32 * ks + 4);
            const bf16x8 bh0 = *(const bf16x8*)(bhp + 32 * ks), bl0 = *(const bf16x8*)(blp + 32 * ks), bh1 = *(const bf16x8*)(bhp + 16 * 1024 + 32 * ks), bl1 = *(const bf16x8*)(blp + 16 * 1024 + 32 * ks);
            u32x4 hi, lo; hi.x = pk2(a0[0], a0[1]); hi.y = pk2(a0[2], a0[3]); hi.z = pk2(a1[0], a1[1]); hi.w = pk2(a1[2], a1[3]);
            lo.x = pk2(a0[0] - bflo(hi.x), a0[1] - bfhi(hi.x)); lo.y = pk2(a0[2] - bflo(hi.y), a0[3] - bfhi(hi.y)); lo.z = pk2(a1[0] - bflo(hi.z), a1[1] - bfhi(hi.z)); lo.w = pk2(a1[2] - bflo(hi.w), a1[3] - bfhi(hi.w));
            const bf16x8 ah = __builtin_bit_cast(bf16x8, hi), al = __builtin_bit_cast(bf16x8, lo);
            acc0 = __builtin_amdgcn_mfma_f32_16x16x32_bf16(ah, bh0, acc0, 0, 0, 0); acc0 = __builtin_amdgcn_mfma_f32_16x16x32_bf16(ah, bl0, acc0, 0, 0, 0); acc0 = __builtin_amdgcn_mfma_f32_16x16x32_bf16(al, bh0, acc0, 0, 0, 0);
            acc1 = __builtin_amdgcn_mfma_f32_16x16x32_bf16(ah, bh1, acc1, 0, 0, 0); acc1 = __builtin_amdgcn_mfma_f32_16x16x32_bf16(ah, bl1, acc1, 0, 0, 0); acc1 = __builtin_amdgcn_mfma_f32_16x16x32_bf16(al, bh1, acc1, 0, 0, 0); }
#pragma unroll
        for (int j = 0; j < 4; ++j) { part[(kh * 64 + 16 * rbk + 4 * q + j) * 32 + r] = acc0[j]; part[(kh * 64 + 16 * rbk + 4 * q + j) * 32 + 16 + r] = acc1[j]; }
        __syncthreads();
        for (int i = c.tid; i < 2048; i += 512) { const int row = i >> 5, e = i & 31; lgt[row * 33 + e] = part[i] + part[2048 + i] + rbias[e]; }
        __syncthreads();
        int ti[4] = {0, 0, 0, 0}, lr[4] = {0, 0, 0, 0}; float gt[4] = {0.f, 0.f, 0.f, 0.f};
        if (c.tid < 64) { float lg[32];
#pragma unroll
            for (int e = 0; e < 32; ++e) lg[e] = lgt[c.tid * 33 + e];
            float tv[4]; unsigned taken = 0u;
#pragma unroll
            for (int k = 0; k < 4; ++k) { float best = -3.0e38f; int bi = 0;
#pragma unroll
                for (int e = 0; e < 32; ++e) { const bool ok = !((taken >> e) & 1u) && (lg[e] > best); best = ok ? lg[e] : best; bi = ok ? e : bi; }
                tv[k] = best; ti[k] = bi; taken |= 1u << bi; }
            float ev[4]; ev[0] = 1.f; ev[1] = __expf(tv[1] - tv[0]); ev[2] = __expf(tv[2] - tv[0]); ev[3] = __expf(tv[3] - tv[0]);
            const float inv = 1.f / (ev[0] + ev[1] + ev[2] + ev[3]);
#pragma unroll
            for (int k = 0; k < 4; ++k) { gt[k] = ev[k] * inv; lr[k] = (int)atomicAdd((unsigned*)(lcnt + ti[k]), 1u); } }
        __syncthreads();
        if (c.tid < 32) { const unsigned n = (unsigned)lcnt[c.tid]; lbase[c.tid] = n ? (int)atomicAdd(cnt + c.tid * 16, n) : 0; lcnt[c.tid] = 0; }
        __syncthreads();
        if (c.tid < 64) { const int m = m0 + c.tid;
#pragma unroll
            for (int k = 0; k < 4; ++k) { const int rk = lbase[ti[k]] + lr[k]; toke[m * 4 + k] = ti[k]; tokr[m * 4 + k] = rk; tokg[m * 4 + k] = gt[k]; elist[(size_t)ti[k] * T_ + rk] = m; } }
    }
    __syncthreads();
}
__device__ __forceinline__ void moe_tstart(const Ctx& c, KP p, int l) {
    LAS int* ts = (LAS int*)(c.lds + LDS_MISC + MISC_MOE);
    const unsigned* cnt = (const unsigned*)(p->ws + WS_CTL) + CW_CNT + l * 32 * 16;
    if (c.tid < 64) {
        const int e = c.lane & 31; const int n = (int)__hip_atomic_load(cnt + e * 16, __ATOMIC_RELAXED, __HIP_MEMORY_SCOPE_AGENT); const int tl = (n + 255) >> 8;
        int inc = tl;
#pragma unroll
        for (int o = 1; o < 32; o <<= 1) { const int v = __shfl_up(inc, o); if ((c.lane & 31) >= o) inc += v; }
        if (c.lane < 32) { ts[e] = inc - tl; ts[33 + e] = n; if (e == 31) ts[32] = inc;
            LAS int* r2e = (LAS int*)(c.lds + LDS_MISC + MISC_R2E); for (int rt = inc - tl; rt < inc; ++rt) r2e[rt] = e; } }
    __syncthreads();
}
__device__ __forceinline__ void ph_combine(const Ctx& c0, KP p, int l, float* out_f32, bool hbres  ) {
    const Ctx c = relaunder(c0);
    unsigned char* ws = p->ws; float* hf = (float*)(ws + WS_H); bf16_t* hb = (bf16_t*)(ws + WS_HB); const bf16_t* ysl = (const bf16_t*)(ws + WS_YSL); const int* toke = (const int*)(ws + WS_TOKE); const int* tokr = (const int*)(ws + WS_TOKR); const float* tokg = (const float*)(ws + WS_TOKG);
    moe_tstart(c, p, l);
    const LAS int* ts = (const LAS int*)(c.lds + LDS_MISC + MISC_MOE);
    const float* g = p->in[I_LN3G] + l * 1024; const float* bb = p->in[I_LN3B] + l * 1024;
    const int gw = c.bid * 8 + c.wave, NGW = c.G * 8;
    for (int base = 0; gw + base * NGW < T_; base += 16) {
        const int mr = gw + (base + (c.lane >> 2)) * NGW;
        const int slotv = (mr < T_) ? ts[toke[mr * 4 + (c.lane & 3)]] * 256 + tokr[mr * 4 + (c.lane & 3)] : 0; const float gatev = (mr < T_) ? tokg[mr * 4 + (c.lane & 3)] : 0.f;
        for (int i2 = 0; i2 < 16; i2 += 2) {
            const int mA = gw + (base + i2) * NGW; if (mA >= T_) break;
            const int mB = (mA + NGW < T_) ? mA + NGW : mA;
            f32x4 va[4], vb[4]; u32x4 ya[4][2], yb2[4][2]; float ga[4], gb[4];
#pragma unroll
            for (int k = 0; k < 4; ++k) { const int sa = __builtin_amdgcn_readlane(slotv, 4 * i2 + k), sb = __builtin_amdgcn_readlane(slotv, (mB != mA) ? 4 * i2 + 4 + k : 4 * i2 + k);
                ga[k] = __uint_as_float(__builtin_amdgcn_readlane(__float_as_uint(gatev), 4 * i2 + k)); gb[k] = __uint_as_float(__builtin_amdgcn_readlane(__float_as_uint(gatev), (mB != mA) ? 4 * i2 + 4 + k : 4 * i2 + k));
#pragma unroll
                for (int j = 0; j < 2; ++j) { ya[k][j] = *(const u32x4*)(ysl + (size_t)sa * 1024 + 8 * c.lane + 512 * j); yb2[k][j] = *(const u32x4*)(ysl + (size_t)sb * 1024 + 8 * c.lane + 512 * j); } }
#pragma unroll
            for (int j = 0; j < 2; ++j) {
                if (hbres) { const u32x4 xa = *(const u32x4*)(hb + (size_t)mA * 1024 + 8 * c.lane + 512 * j), xb = *(const u32x4*)(hb + (size_t)mB * 1024 + 8 * c.lane + 512 * j);
                    va[2 * j] = DN_ALPHA * (f32x4){bflo(xa.x), bfhi(xa.x), bflo(xa.y), bfhi(xa.y)}; va[2 * j + 1] = DN_ALPHA * (f32x4){bflo(xa.z), bfhi(xa.z), bflo(xa.w), bfhi(xa.w)};
                    vb[2 * j] = DN_ALPHA * (f32x4){bflo(xb.x), bfhi(xb.x), bflo(xb.y), bfhi(xb.y)}; vb[2 * j + 1] = DN_ALPHA * (f32x4){bflo(xb.z), bfhi(xb.z), bflo(xb.w), bfhi(xb.w)}; }
                else { va[2 * j] = DN_ALPHA * *(const f32x4*)(hf + (size_t)mA * 1024 + 8 * c.lane + 512 * j); va[2 * j + 1] = DN_ALPHA * *(const f32x4*)(hf + (size_t)mA * 1024 + 8 * c.lane + 512 * j + 4);
                    vb[2 * j] = DN_ALPHA * *(const f32x4*)(hf + (size_t)mB * 1024 + 8 * c.lane + 512 * j); vb[2 * j + 1] = DN_ALPHA * *(const f32x4*)(hf + (size_t)mB * 1024 + 8 * c.lane + 512 * j + 4); } }
#pragma unroll
            for (int k = 0; k < 4; ++k)
#pragma unroll
                for (int j = 0; j < 2; ++j) { const u32x4 y = ya[k][j];
                    va[2 * j][0] += ga[k] * bflo(y.x); va[2 * j][1] += ga[k] * bfhi(y.x); va[2 * j][2] += ga[k] * bflo(y.y); va[2 * j][3] += ga[k] * bfhi(y.y);
                    va[2 * j + 1][0] += ga[k] * bflo(y.z); va[2 * j + 1][1] += ga[k] * bfhi(y.z); va[2 * j + 1][2] += ga[k] * bflo(y.w); va[2 * j + 1][3] += ga[k] * bfhi(y.w);
                    const u32x4 y2 = yb2[k][j];
                    vb[2 * j][0] += gb[k] * bflo(y2.x); vb[2 * j][1] += gb[k] * bfhi(y2.x); vb[2 * j][2] += gb[k] * bflo(y2.y); vb[2 * j][3] += gb[k] * bfhi(y2.y);
                    vb[2 * j + 1][0] += gb[k] * bflo(y2.z); vb[2 * j + 1][1] += gb[k] * bfhi(y2.z); vb[2 * j + 1][2] += gb[k] * bflo(y2.w); vb[2 * j + 1][3] += gb[k] * bfhi(y2.w); }
            ln_row_regs<true>(va, g, bb, c.lane, out_f32 ? out_f32 + (size_t)mA * 1024 : (hbres ? nullptr : hf + (size_t)mA * 1024), out_f32 ? nullptr : hb + (size_t)mA * 1024);
            if (mB != mA) ln_row_regs<true>(vb, g, bb, c.lane, out_f32 ? out_f32 + (size_t)mB * 1024 : (hbres ? nullptr : hf + (size_t)mB * 1024), out_f32 ? nullptr : hb + (size_t)mB * 1024);
        }
    }
}
#ifndef MK_MULTI_LAUNCH
#define MK_MULTI_LAUNCH 0
#endif
constexpr int PH_PER_LAYER = 13, NPH = 1 + PH_PER_LAYER * NL_;

#define PHASE_ENTER \
    Ctx c; { int t_ = threadIdx.x; asm volatile("" : "+v"(t_)); c.tid = t_; c.lane = t_ & 63; c.wave = __builtin_amdgcn_readfirstlane(t_ >> 6); { int g_ = gridDim.x, b_ = blockIdx.x; asm volatile("" : "+s"(g_), "+s"(b_)); c.G = g_; c.bid = b_; } c.lds = lds; } \
    KP p = kp0; asm volatile("" : "+s"(p)); int l = l0; asm volatile("" : "+s"(l)); unsigned char* ws = p->ws; (void)l; (void)ws; \
    const char* lw = (const char*)ws + WS_W + (size_t)l * LW_END; (void)lw;

__global__ void __launch_bounds__(512, 2) fwd_kernel(Params p_arg) {
    extern __shared__ __attribute__((aligned(16))) unsigned char lds_raw[];
    LAS unsigned char* lds = (LAS unsigned char*)lds_raw;
    const KP kp0 = (KP)__builtin_amdgcn_kernarg_segment_ptr();
    if (threadIdx.x < 4) ((LAS unsigned*)(lds + LDS_MISC + MISC_BAR))[threadIdx.x] = 0u;
    __syncthreads();
    const int ph_lo = kp0->ph_lo, ph_hi = kp0->ph_hi;
    XcdBarrier bar;
    { unsigned* bw = (unsigned*)(kp0->ws + WS_CTL) + CW_BAR + kp0->li * XCD_BAR_WORDS;
      bar.bar = bw; bar.x = 0; bar.st = (volatile LAS unsigned*)(lds + LDS_MISC + MISC_BAR);
      if (ph_hi - ph_lo > 1) bar = xcd_barrier_post(bw, (volatile LAS unsigned*)(lds + LDS_MISC + MISC_BAR)); }
    int ph = 0;
#define RUN (ph >= kp0->ph_lo && ph < kp0->ph_hi)
#define SEAM do { if (ph + 1 < kp0->ph_hi) xcd_barrier(bar); } while (0)

    { const int l0 = 0;
      if (RUN) { PHASE_ENTER; ph_prologue(c, p, (c.G == 256) ? 0 : 2, c.bid * 8 + c.wave, c.G * 8, 0, (c.G == 256) ? CVT_IN0 : CVT_END, c.G == 256); SEAM; } ++ph; }

    for (int l0 = 0; l0 < NL_; ++l0) {
        if (RUN) { PHASE_ENTER;
            const bool split = (l == 0) && (c.G == 256); const int cc = (c.bid & 7) + 8 * (c.bid >> 4);
            if (split && ((c.bid >> 3) & 1)) {
                { SchedKV S{(const char*)ws, 128, cc}; EpiStoreBf16 E{nullptr, 1.f}; pg8::gemm_phase(lds, pg8::Gemm{1024, 1024, 1024}, S, E); }
                ph_prologue(c, p, 1, cc * 8 + c.wave, 128 * 8, CVT_IN0, CVT_SPLIT, true); }
            else { SchedInProj S{(const char*)ws + WS_HB, lw + LW_WIN, (char*)ws + WS_Z, split ? 128 : c.G, split ? cc : c.bid}; EpiStoreBf16T<true> E{p->in[I_BIN] + (size_t)l * INC, 1.f};
                pg8::gemm_phase(lds, pg8::Gemm{1024, 1024, 1024}, S, E);
                if (split) ph_prologue(c, p, 1, cc * 8 + c.wave, 128 * 8, CVT_SPLIT, CVT_END, true); }
            SEAM; } ++ph;
        if (RUN) { PHASE_ENTER;
            const int skip = p->pad;
            if (!(skip & 1)) for (int it = c.bid; it < 256; it += c.G) ph_conv_a(c, p, l, it);
            if (!(skip & 2)) for (int it = c.bid; it < 256; it += c.G) ph_gla1(c, p, l, it);
            if (!(skip & 4)) for (int it = c.bid; it < 256; it += c.G) ph_lru<1>(c, p, l, it);
            if (!(skip & 8)) for (int it = c.bid; it < 512; it += c.G) ph_stick(c, p, it);
            if (l == 0 && c.G != 256) { SchedKV S{(const char*)ws, c.G, c.bid}; EpiStoreBf16 E{nullptr, 1.f}; pg8::gemm_phase(lds, pg8::Gemm{1024, 1024, 1024}, S, E); }
            SEAM; } ++ph;
        if (RUN) { PHASE_ENTER; ph_gla2(c, p); ph_lru_carry(c, p); SEAM; } ++ph;
        if (RUN) { PHASE_ENTER;
            const int skip = p->pad;
            if (!(skip & 1)) for (int it = c.bid; it < 256; it += c.G) ph_gla3(c, p, l, it);
            if (!(skip & 2)) for (int it = c.bid; it < 256; it += c.G) ph_lru<3>(c, p, l, it);
            if (l == 0) {
                { SchedMq S{(const char*)ws, c.G, c.bid}; EpiStoreBf16 E{nullptr, 0.0625f}; pg8::gemm_phase(lds, pg8::Gemm{2048, 1024, 256}, S, E); }
                { SchedVw S{(const char*)ws, c.G, c.bid}; EpiStoreBf16 E{nullptr, 1.f}; pg8::gemm_phase(lds, pg8::Gemm{1024, 2048, 256}, S, E); } }
            SEAM; } ++ph;
        if (RUN) { PHASE_ENTER; SchedBranch S{(const char*)ws + WS_YS, lw + LW_WBR, c.G, c.bid}; EpiMerge E{(const bf16_t*)(ws + WS_Z), (bf16_t*)(ws + WS_MB), p->pad};
            pg8::gemm_phase(lds, pg8::Gemm{2048, 2048, 2048}, S, E); SEAM; } ++ph;
        if (RUN) { PHASE_ENTER; SchedSq S{(const char*)ws + WS_MB, lw + LW_WOUT, nullptr, 4, c.G, c.bid};
            if (c.G == 256) { EpiResidLNT<false, false> E{p->in[I_BOUT] + l * 1024, p->in[I_LN1G] + l * 1024, p->in[I_LN1B] + l * 1024, ws,
                    (LAS float*)(lds + LDS_MISC + MISC_XCH), (LAS float*)(lds + LDS_MISC + MISC_STAT), (unsigned*)(ws + WS_CTL) + CW_LN + (l * 2 + 0) * 64 * 16, nullptr, nullptr, 0};
                pg8::gemm_phase(lds, pg8::Gemm{1024, 1024, 1024}, S, E); }
            else { EpiResid E{p->in[I_BOUT] + l * 1024, (const float*)(ws + WS_H), (float*)(ws + WS_PRE)}; pg8::gemm_phase(lds, pg8::Gemm{1024, 1024, 1024}, S, E); }
            SEAM; } ++ph;
        if (RUN && gridDim.x != 256) { PHASE_ENTER; ln_rows_phase(c, (const float*)(ws + WS_PRE), p->in[I_LN1G] + l * 1024, p->in[I_LN1B] + l * 1024, (float*)(ws + WS_H), (bf16_t*)(ws + WS_HB)); SEAM; } ++ph;
        if (RUN) { PHASE_ENTER; SchedXB S{(const char*)ws + WS_HB, (const char*)ws + WS_MQT + (size_t)l * 4 * SZ_W1K, (char*)ws + WS_P, 2, c.G, c.bid}; EpiSoftmax E{(LAS float*)(lds + LDS_MISC + MISC_XCH)};
            pg8::gemm_phase(lds, pg8::Gemm{1024, 1024, 1024}, S, E); SEAM; } ++ph;
        if (RUN) { PHASE_ENTER; SchedXB S{(const char*)ws + WS_P, (const char*)ws + WS_VWT + (size_t)l * 4 * SZ_W1K, nullptr, 4, c.G, c.bid};
            if (c.G == 256) { EpiResidLNT<false, true> E{nullptr, p->in[I_LN2G] + l * 1024, p->in[I_LN2B] + l * 1024, ws,
                    (LAS float*)(lds + LDS_MISC + MISC_XCH), (LAS float*)(lds + LDS_MISC + MISC_STAT), (unsigned*)(ws + WS_CTL) + CW_LN + (l * 2 + 1) * 64 * 16, (LAS char*)lds, p->in[I_RB] + l * 32, l};
                pg8::gemm_phase(lds, pg8::Gemm{1024, 1024, 1024}, S, E); }
            else { EpiResid E{nullptr, (const float*)(ws + WS_H), (float*)(ws + WS_PRE)}; pg8::gemm_phase(lds, pg8::Gemm{1024, 1024, 1024}, S, E); }
            SEAM; } ++ph;
        if (RUN && gridDim.x != 256) { PHASE_ENTER; ph_ln2_router(c, p, l, false); SEAM; } ++ph;
        if (RUN && gridDim.x == 256) { PHASE_ENTER; moe_tstart(c, p, l);
            SchedMoeX S{(const char*)ws + WS_HB, lw + LW_W1, lw + LW_W2, (char*)ws + WS_ACT, (char*)ws + WS_YSL, (const LAS int*)(lds + LDS_MISC + MISC_MOE), (const int*)(ws + WS_ELIST),
                        (unsigned*)(ws + WS_CTL) + CW_MOE + l * 288 * 16, c.G, c.bid};
            EpiMoeX E{p->in[I_B1] + (size_t)l * 32 * 2048, p->in[I_B2] + (size_t)l * 32 * 1024};
            pg8::gemm_phase(lds, pg8::Gemm{1024, 1024, 1024}, S, E); SEAM; }
        else if (RUN) { PHASE_ENTER; moe_tstart(c, p, l);
            SchedMoe<8, 2048, 128, 1, true> S{(const char*)ws + WS_HB, lw + LW_W1, (char*)ws + WS_ACT, (const LAS int*)(lds + LDS_MISC + MISC_MOE), (const int*)(ws + WS_ELIST), c.G, c.bid}; EpiSwiGLU E{p->in[I_B1] + (size_t)l * 32 * 2048};
            pg8::gemm_phase(lds, pg8::Gemm{1024, 1024, 1024}, S, E); SEAM; } ++ph;
        if (RUN && gridDim.x != 256) { PHASE_ENTER; moe_tstart(c, p, l);
            SchedMoe<4, 1024, 256, 1024, false> S{(const char*)ws + WS_ACT, lw + LW_W2, (char*)ws + WS_YSL, (const LAS int*)(lds + LDS_MISC + MISC_MOE), nullptr, c.G, c.bid}; EpiStoreBf16 E{p->in[I_B2] + (size_t)l * 32 * 1024, 1.f};
            pg8::gemm_phase(lds, pg8::Gemm{1024, 1024, 1024}, S, E); SEAM; } ++ph;
        if (RUN) { PHASE_ENTER; ph_combine(c, p, l, (l == NL_ - 1) ? p->out : nullptr, c.G == 256); SEAM; } ++ph;
    }
#undef RUN
#undef SEAM
}

extern "C" void kernel_launch(void* const* d_in, const int* in_sizes, int n_in, void* d_out, int out_size, void* d_ws, size_t ws_size, hipStream_t stream) {
    static int grid = 0;
    if (grid == 0) {
        if (n_in != 39 || in_sizes[0] != T_ * D_ || out_size != T_ * D_ || ws_size < WS_END) {
            fprintf(stderr, "kernel_launch: unexpected shapes (n_in %d, in0 %d, out %d, ws %zu, need %zu)\n", n_in, n_in > 0 ? in_sizes[0] : -1, out_size, ws_size, (size_t)WS_END); grid = -1; return; }
        int dev = 0, cus = 0, per_cu = 0;
        if (hipGetDevice(&dev) != hipSuccess || hipDeviceGetAttribute(&cus, hipDeviceAttributeMultiprocessorCount, dev) != hipSuccess) { grid = -1; return; }
        if (hipFuncSetAttribute((const void*)fwd_kernel, hipFuncAttributeMaxDynamicSharedMemorySize, LDS_BYTES) != hipSuccess) { fprintf(stderr, "kernel_launch: hipFuncSetAttribute failed\n"); grid = -1; return; }
        if (hipOccupancyMaxActiveBlocksPerMultiprocessor(&per_cu, (const void*)fwd_kernel, 512, LDS_BYTES) != hipSuccess || per_cu < 1) { fprintf(stderr, "kernel_launch: occupancy query says %d\n", per_cu); grid = -1; return; }
        grid = cus;
    }
    if (grid <= 0) return;
    (void)hipMemsetAsync((char*)d_ws + WS_CTL, 0, CTL_BYTES, stream);
    Params p{};
    for (int i = 0; i < 39; ++i) p.in[i] = (const float*)d_in[i];
    p.out = (float*)d_out; p.ws = (unsigned char*)d_ws; p.li = 0; p.pad = 0;
#if MK_MULTI_LAUNCH
    for (int ph = 0; ph < NPH; ++ph) { p.ph_lo = ph; p.ph_hi = ph + 1; hipLaunchKernelGGL(fwd_kernel, dim3(grid), dim3(512), LDS_BYTES, stream, p); }
#else
    p.ph_lo = 0; p.ph_hi = NPH;
    hipLaunchKernelGGL(fwd_kernel, dim3(grid), dim3(512), LDS_BYTES, stream, p);
#endif
#if defined(PROBE_K) && PROBE_K > 0
    p.pad = PROBE_SKIP;
    for (int r = 0; r < PROBE_K; ++r) { p.ph_lo = PROBE_PH; p.ph_hi = PROBE_PH + 1; hipLaunchKernelGGL(fwd_kernel, dim3(grid), dim3(512), LDS_BYTES, stream, p); }
#endif
}
```
